# Optimizing an MI355X kernel written in HIP

```python
import jax, jax.numpy as jnp
from jax import lax
import numpy as np

D_MODEL = 2048
BATCH = 16
SEQ = 2048
DEPTH = 4

D_MIX = D_MODEL
A_WIDTH = D_MIX // 2
B_WIDTH = D_MIX // 4
C_WIDTH = D_MIX - A_WIDTH - B_WIDTH

V_DIM = 128
NOPE_DIM = 128
ROPE_DIM = 64
A_HEADS = A_WIDTH // V_DIM
Q_LORA = D_MODEL // 4
KV_LORA = D_MODEL // 8
ROPE_THETA = 10000.0
Q_BLOCK = 128

B_HEAD = 64
B_HEADS = B_WIDTH // B_HEAD
DECAY_LORA = 32
ICLR_LORA = 32
GATE_LORA = 96
HEAD_NORM_EPS = 64e-5

C_GROUPS = 8
CONV_K = 3

D_FF = ((8 * D_MODEL // 3 + 255) // 256) * 256
RMS_EPS = 1e-6

A_IN = Q_LORA + KV_LORA + ROPE_DIM
B_IN = 3 * B_WIDTH + DECAY_LORA + ICLR_LORA + GATE_LORA
C_IN = 3 * C_WIDTH
N_IN = A_IN + B_IN + C_IN

kernel_name = "hymba_style_mla_rwkv7_shortconv_macaron"


def rmsnorm(x, g, eps=RMS_EPS):
    xf = x.astype(jnp.float32)
    y = xf * lax.rsqrt(jnp.mean(xf * xf, axis=-1, keepdims=True) + eps)
    return (y * g.astype(jnp.float32)).astype(x.dtype)


def group_rmsnorm(y, g, n_groups, eps=RMS_EPS):
    shp = y.shape
    yg = y.reshape(shp[:-1] + (n_groups, shp[-1] // n_groups)).astype(jnp.float32)
    yg = yg * lax.rsqrt(jnp.mean(yg * yg, axis=-1, keepdims=True) + eps)
    return (yg.reshape(shp) * g.astype(jnp.float32)).astype(y.dtype)


def swiglu(x, w_gate, w_up, w_down):
    return (jax.nn.silu(x @ w_gate) * (x @ w_up)) @ w_down


def rope_angles(positions):
    inv_freq = 1.0 / (ROPE_THETA ** (jnp.arange(0, ROPE_DIM, 2, dtype=jnp.float32) / ROPE_DIM))
    ang = positions.astype(jnp.float32)[..., None] * inv_freq
    return jnp.cos(ang), jnp.sin(ang)


def apply_rope(x, cos, sin):
    half = ROPE_DIM // 2
    xf = x.astype(jnp.float32)
    x1, x2 = xf[..., :half], xf[..., half:]
    return jnp.concatenate([x1 * cos - x2 * sin, x1 * sin + x2 * cos], axis=-1).astype(x.dtype)


def causal_block_attention(q_nope, q_rope, k_nope, k_rope, v):
    B, S, H, _ = q_nope.shape
    scale = (NOPE_DIM + ROPE_DIM) ** -0.5
    kpos = jnp.arange(S)

    def one_block(i):
        start = i * Q_BLOCK
        qn = lax.dynamic_slice_in_dim(q_nope, start, Q_BLOCK, axis=1)
        qr = lax.dynamic_slice_in_dim(q_rope, start, Q_BLOCK, axis=1)
        s = (jnp.einsum('bqhd,bkhd->bhqk', qn, k_nope)
             + jnp.einsum('bqhr,bkr->bhqk', qr, k_rope)).astype(jnp.float32) * scale
        qpos = start + jnp.arange(Q_BLOCK)
        mask = kpos[None, :] <= qpos[:, None]
        s = jnp.where(mask[None, None], s, -1e30)
        p = jax.nn.softmax(s, axis=-1).astype(v.dtype)
        return jnp.einsum('bhqk,bkhd->bqhd', p, v)

    out = lax.map(one_block, jnp.arange(S // Q_BLOCK))
    return jnp.moveaxis(out, 0, 1).reshape(B, S, H, v.shape[-1])


def mla_mixer(pa, cos, sin, q_norm, kv_norm, w_uq, w_ukv, out_norm):
    B, S, _ = pa.shape
    c_q = pa[..., :Q_LORA]
    c_kv = pa[..., Q_LORA:Q_LORA + KV_LORA]
    k_rope = pa[..., Q_LORA + KV_LORA:]
    q = (rmsnorm(c_q, q_norm) @ w_uq).reshape(B, S, A_HEADS, NOPE_DIM + ROPE_DIM)
    kv = (rmsnorm(c_kv, kv_norm) @ w_ukv).reshape(B, S, A_HEADS, NOPE_DIM + V_DIM)
    q_nope = q[..., :NOPE_DIM]
    q_rope = apply_rope(q[..., NOPE_DIM:], cos[:, :, None, :], sin[:, :, None, :])
    k_nope, v = kv[..., :NOPE_DIM], kv[..., NOPE_DIM:]
    k_rope = apply_rope(k_rope, cos, sin)
    o = causal_block_attention(q_nope, q_rope, k_nope, k_rope, v)
    return group_rmsnorm(o.reshape(B, S, A_WIDTH), out_norm, A_HEADS)


def wkv7_scan(r, w, k, v, a, b):
    B, S, H, N = r.shape

    def step(state, inp):
        r_t, w_t, k_t, v_t, a_t, b_t = inp
        sa = jnp.einsum('bhvk,bhk->bhv', state, a_t)
        state = (state * w_t[:, :, None, :]
                 + sa[..., None] * b_t[:, :, None, :]
                 + v_t[..., None] * k_t[:, :, None, :])
        return state, jnp.einsum('bhvk,bhk->bhv', state, r_t)

    xs = tuple(jnp.moveaxis(t, 1, 0) for t in (r, w, k, v, a, b))
    _, y = lax.scan(step, jnp.zeros((B, H, N, N), jnp.float32), xs)
    return jnp.moveaxis(y, 0, 1)


def rwkv7_mixer(pb, shift_mu, decay_w0, decay_up, iclr_a0, iclr_up, gate_up,
                k_k, k_a, r_k, lnx_gain, lnx_bias):
    B, S, _ = pb.shape
    prev = jnp.pad(pb, ((0, 0), (1, 0), (0, 0)))[:, :-1]
    pb = pb + (prev - pb) * shift_mu
    o1, o2, o3 = B_WIDTH, 2 * B_WIDTH, 3 * B_WIDTH
    o4, o5 = o3 + DECAY_LORA, o3 + DECAY_LORA + ICLR_LORA
    r, k, v = pb[..., :o1], pb[..., o1:o2], pb[..., o2:o3]
    w_lo, a_lo, g_lo = pb[..., o3:o4], pb[..., o4:o5], pb[..., o5:]

    w_log = -jax.nn.softplus(-(decay_w0 + jnp.tanh(w_lo) @ decay_up)) - 0.5
    a = jax.nn.sigmoid(iclr_a0 + a_lo @ iclr_up)
    g = jax.nn.sigmoid(g_lo) @ gate_up

    heads = lambda t: t.reshape(B, S, B_HEADS, B_HEAD).astype(jnp.float32)
    kk = heads(k * k_k)
    kk = kk / jnp.maximum(jnp.sqrt(jnp.sum(kk * kk, axis=-1, keepdims=True)), 1e-12)
    k = k * (1.0 + (a - 1.0) * k_a)
    rh, kh, vh, ah = heads(r), heads(k), heads(v), heads(a)
    decay = jnp.exp(-jnp.exp(heads(w_log)))

    y = wkv7_scan(rh, decay, kh, vh, -kk, kk * ah)
    mu = jnp.mean(y, axis=-1, keepdims=True)
    var = jnp.mean(jnp.square(y - mu), axis=-1, keepdims=True)
    yn = ((y - mu) * lax.rsqrt(var + HEAD_NORM_EPS)).reshape(B, S, B_WIDTH)
    yn = yn * lnx_gain.astype(jnp.float32) + lnx_bias.astype(jnp.float32)
    bonus = jnp.sum(rh * kh * r_k.astype(jnp.float32), axis=-1, keepdims=True) * vh
    out = (yn + bonus.reshape(B, S, B_WIDTH)) * g.astype(jnp.float32)
    return out.astype(pb.dtype)


def short_conv_mixer(pc, conv_w, out_norm):
    b_gate = pc[..., :C_WIDTH]
    c_gate = pc[..., C_WIDTH:2 * C_WIDTH]
    h = pc[..., 2 * C_WIDTH:]
    u = c_gate * h
    y = lax.conv_general_dilated(u, conv_w[:, None, :], window_strides=(1,),
                                 padding=[(CONV_K - 1, 0)],
                                 dimension_numbers=('NWC', 'WIO', 'NWC'),
                                 feature_group_count=C_WIDTH)
    return group_rmsnorm(b_gate * y, out_norm, C_GROUPS)


def setup_inputs(seed: int = 0) -> dict:
    key = jax.random.key(seed)
    ks = iter(jax.random.split(key, 40))
    f32 = jnp.float32

    def nrm(shape, scale):
        return scale * jax.random.normal(next(ks), shape, f32)

    def gain(shape):
        return 1.0 + nrm(shape, 0.02)

    L = DEPTH
    x = nrm((BATCH, SEQ, D_MODEL), 1.0)
    positions = (jax.random.randint(next(ks), (BATCH, 1), 0, 1024, jnp.int32)
                 + jnp.arange(SEQ, dtype=jnp.int32)[None, :])
    return {
        "x": x,
        "positions": positions,
        "norm_ffn1": gain((L, D_MODEL)),
        "ffn1_gate": nrm((L, D_MODEL, D_FF), D_MODEL ** -0.5),
        "ffn1_up": nrm((L, D_MODEL, D_FF), D_MODEL ** -0.5),
        "ffn1_down": nrm((L, D_FF, D_MODEL), D_FF ** -0.5),
        "norm_mix": gain((L, D_MODEL)),
        "w_in": nrm((L, D_MODEL, N_IN), D_MODEL ** -0.5),
        "q_norm": gain((L, Q_LORA)),
        "kv_norm": gain((L, KV_LORA)),
        "w_uq": nrm((L, Q_LORA, A_HEADS * (NOPE_DIM + ROPE_DIM)), Q_LORA ** -0.5),
        "w_ukv": nrm((L, KV_LORA, A_HEADS * (NOPE_DIM + V_DIM)), KV_LORA ** -0.5),
        "attn_out_norm": gain((L, A_WIDTH)),
        "shift_mu": jax.random.uniform(next(ks), (L, B_IN), f32),
        "decay_w0": -2.0 + nrm((L, B_WIDTH), 0.5),
        "decay_up": nrm((L, DECAY_LORA, B_WIDTH), 0.5 * DECAY_LORA ** -0.5),
        "iclr_a0": nrm((L, B_WIDTH), 0.1),
        "iclr_up": nrm((L, ICLR_LORA, B_WIDTH), ICLR_LORA ** -0.5),
        "gate_up": nrm((L, GATE_LORA, B_WIDTH), GATE_LORA ** -0.5),
        "k_k": 0.85 + nrm((L, B_WIDTH), 0.02),
        "k_a": gain((L, B_WIDTH)),
        "r_k": nrm((L, B_HEADS, B_HEAD), 0.1),
        "lnx_gain": gain((L, B_WIDTH)),
        "lnx_bias": nrm((L, B_WIDTH), 0.01),
        "conv_w": nrm((L, CONV_K, C_WIDTH), CONV_K ** -0.5),
        "conv_out_norm": gain((L, C_WIDTH)),
        "w_out": nrm((L, D_MIX, D_MODEL), D_MIX ** -0.5),
        "norm_ffn2": gain((L, D_MODEL)),
        "ffn2_gate": nrm((L, D_MODEL, D_FF), D_MODEL ** -0.5),
        "ffn2_up": nrm((L, D_MODEL, D_FF), D_MODEL ** -0.5),
        "ffn2_down": nrm((L, D_FF, D_MODEL), D_FF ** -0.5),
        "norm_final": gain((D_MODEL,)),
    }


def reference(x, positions, norm_ffn1, ffn1_gate, ffn1_up, ffn1_down, norm_mix, w_in,
              q_norm, kv_norm, w_uq, w_ukv, attn_out_norm, shift_mu, decay_w0, decay_up,
              iclr_a0, iclr_up, gate_up, k_k, k_a, r_k, lnx_gain, lnx_bias, conv_w,
              conv_out_norm, w_out, norm_ffn2, ffn2_gate, ffn2_up, ffn2_down, norm_final):
    cos, sin = rope_angles(positions)
    h = x
    for l in range(DEPTH):
        h = h + 0.5 * swiglu(rmsnorm(h, norm_ffn1[l]), ffn1_gate[l], ffn1_up[l], ffn1_down[l])
        p = rmsnorm(h, norm_mix[l]) @ w_in[l]
        pa, pb, pc = p[..., :A_IN], p[..., A_IN:A_IN + B_IN], p[..., A_IN + B_IN:]
        ya = mla_mixer(pa, cos, sin, q_norm[l], kv_norm[l], w_uq[l], w_ukv[l], attn_out_norm[l])
        yb = rwkv7_mixer(pb, shift_mu[l], decay_w0[l], decay_up[l], iclr_a0[l], iclr_up[l],
                         gate_up[l], k_k[l], k_a[l], r_k[l], lnx_gain[l], lnx_bias[l])
        yc = short_conv_mixer(pc, conv_w[l], conv_out_norm[l])
        h = h + jnp.concatenate([ya, yb, yc], axis=-1) @ w_out[l]
        h = h + 0.5 * swiglu(rmsnorm(h, norm_ffn2[l]), ffn2_gate[l], ffn2_up[l], ffn2_down[l])
    return rmsnorm(h, norm_final)
```

```cpp
#include <hip/hip_runtime.h>
#include <stdint.h>
#include <stdio.h>

#ifndef MK_MULTI
#define MK_MULTI 0
#endif

#ifndef MK_SKIP
#define MK_SKIP 0
#endif
#define SKIP(b) ((MK_SKIP >> (b)) & 1)
#ifndef MK_WGM_RES
#define MK_WGM_RES 4
#endif
#ifndef MK_WGM_GU
#define MK_WGM_GU 8
#endif
#ifndef MK_WGM_WIN
#define MK_WGM_WIN 4
#endif
#ifndef MK_REP
#define MK_REP 0
#endif
#define REP(b) ((MK_REP >> (b)) & 1)
#define LAS __attribute__((address_space(3)))
typedef unsigned short bf16_t;
typedef short bf16x8 __attribute__((ext_vector_type(8)));
typedef short s16x4 __attribute__((ext_vector_type(4)));
typedef float f32x4 __attribute__((ext_vector_type(4)));
typedef float f32x2 __attribute__((ext_vector_type(2)));
typedef float f32x16 __attribute__((ext_vector_type(16)));
typedef unsigned u32x4 __attribute__((ext_vector_type(4)));
typedef unsigned u32x2 __attribute__((ext_vector_type(2)));
typedef int i32x4 __attribute__((ext_vector_type(4)));
typedef int i32x8 __attribute__((ext_vector_type(8)));

constexpr int BATCH = 16, SEQ = 2048, MTOK = BATCH * SEQ, DM = 2048, DFF = 5632, DEPTH = 4;
constexpr int NIN = 4064, NINP = 4096;
constexpr int QL = 512, KVL = 256, AH = 8, QKD = 192;
constexpr int NQ = AH * QKD;
constexpr int NKV = AH * 256;
constexpr int BW = 512;
constexpr int PB0 = 832, PC0 = 2528;
constexpr float RMS_EPS = 1e-6f;
constexpr int NTHREADS = 512;

constexpr size_t al256(size_t x) { return (x + 255) & ~(size_t)255; }
constexpr int XCD_BAR_WORDS_C = 3456;
constexpr size_t WS_CTL = 0;
constexpr size_t CTL_BYTES = 65536;
constexpr size_t CW_QUEUE = 16384;
constexpr size_t WS_PARTH = WS_CTL + CTL_BYTES;
constexpr size_t WS_PARTQ = WS_PARTH + (size_t)MTOK * 32 * 4;
constexpr size_t WS_PARTKV = WS_PARTQ + (size_t)MTOK * 8 * 4;
constexpr size_t ZERO_BYTES = CTL_BYTES;
constexpr size_t WS_RSTD = WS_PARTKV + (size_t)MTOK * 4 * 4;
constexpr size_t WS_ROPEC = al256(WS_RSTD + (size_t)MTOK * 4);
constexpr size_t WS_ROPES = WS_ROPEC + (size_t)MTOK * 32 * 4;
constexpr size_t WS_W1GU = WS_ROPES + (size_t)MTOK * 32 * 4;
constexpr size_t SZ_WGU = (size_t)2 * DFF * DM * 2;
constexpr size_t SZ_WD = (size_t)DM * DFF * 2;
constexpr size_t WS_W1D = WS_W1GU + SZ_WGU;
constexpr size_t WS_WIN = WS_W1D + SZ_WD;
constexpr size_t WS_WUQ = WS_WIN + (size_t)NINP * DM * 2;
constexpr size_t WS_WUKV = WS_WUQ + (size_t)NQ * QL * 2;
constexpr size_t WS_WOUT = WS_WUKV + (size_t)NKV * KVL * 2;
constexpr size_t WS_W2GU = WS_WOUT + (size_t)DM * DM * 2;
constexpr size_t WS_W2D = WS_W2GU + SZ_WGU;
constexpr size_t WS_LORA = WS_W2D + SZ_WD;
constexpr size_t WS_HB = al256(WS_LORA + (size_t)512 * 160 * 2);
constexpr size_t WS_X = WS_HB + (size_t)MTOK * DM * 2;
constexpr size_t WS_ACT = WS_X;
constexpr size_t WS_P = WS_X;
constexpr size_t WS_Q = WS_P + (size_t)MTOK * NINP * 2;
constexpr size_t WS_KV = WS_Q + (size_t)MTOK * NQ * 2;
constexpr size_t WS_KR = WS_KV + (size_t)MTOK * NKV * 2;
constexpr size_t WS_SCAN = WS_KR + (size_t)MTOK * 64 * 2;
constexpr int CB_BYTES = 11520;
constexpr int CB_WA = 0, CB_QA = 2048, CB_MT = 4096, CB_Q2 = 4608, CB_BK = 5120, CB_PC = 9216, CB_VT = 9472;
constexpr size_t WS_BV = WS_SCAN + (size_t)BATCH * 8 * (SEQ / 16) * CB_BYTES;
constexpr size_t WS_G = WS_SCAN + (size_t)MTOK * 8 * 6 * 64 * 4;
static_assert(WS_BV + (size_t)MTOK * BW * 4 <= WS_G, "scan region");
constexpr size_t WS_Y = WS_G + (size_t)MTOK * BW * 4;
constexpr size_t WS_MIXEND = WS_Y + (size_t)MTOK * DM * 2;
constexpr size_t WS_ACTEND = WS_ACT + (size_t)MTOK * DFF * 2;
constexpr size_t WS_H8 = al256(WS_MIXEND > WS_ACTEND ? WS_MIXEND : WS_ACTEND);
constexpr size_t WS_RSA = WS_H8 + (size_t)MTOK * DM;
constexpr size_t WS_AMAX = WS_RSA + (size_t)MTOK * 4;
constexpr size_t WS_AMAX2 = WS_AMAX + (size_t)MTOK * 4;
constexpr size_t WS_ASC = WS_AMAX2 + (size_t)MTOK * 4;
constexpr size_t WS_END = WS_ASC + (size_t)MTOK * 4;
constexpr size_t WS_ACT8 = WS_ACT + (size_t)MTOK * DFF * 2;
static_assert(WS_ACT8 + (size_t)MTOK * DFF <= WS_MIXEND, "act8 inside the union");
constexpr size_t CW_WMAX = 32768;

constexpr int STAGE_BYTES_C = 131072;
constexpr int LDS_WORK = 8192 + 8 * 16384;
constexpr int LDS_MISC = LDS_WORK;
constexpr int LDS_BYTES = LDS_WORK + 256;

typedef __bf16 bf16x2_t __attribute__((ext_vector_type(2)));
__device__ __forceinline__ unsigned cvt_pk_bf16(float lo, float hi) { const f32x2 f = {lo, hi}; return __builtin_bit_cast(unsigned, __builtin_convertvector(f, bf16x2_t)); }
__device__ __forceinline__ unsigned pk4_i8(float a, float b, float c, float d) {
    const unsigned ua = __float_as_uint(a + 12582912.0f), ub = __float_as_uint(b + 12582912.0f), uc = __float_as_uint(c + 12582912.0f), ud = __float_as_uint(d + 12582912.0f);
    return __builtin_amdgcn_perm(__builtin_amdgcn_perm(ud, uc, 0x0c0c0400u), __builtin_amdgcn_perm(ub, ua, 0x0c0c0400u), 0x05040100u);
}
__device__ __forceinline__ float bf2f(bf16_t b) { return __uint_as_float(((unsigned)b) << 16); }
__device__ __forceinline__ bf16_t f2bf(float f) { return (bf16_t)(cvt_pk_bf16(f, 0.f) & 0xffffu); }
__device__ __forceinline__ int opaque_tid() { int t = threadIdx.x; asm volatile("" : "+v"(t)); return t; }
__device__ __forceinline__ float wave_sum(float v) {
#pragma unroll
    for (int o = 32; o >= 1; o >>= 1) v += __shfl_xor(v, o);
    return v;
}
__device__ __forceinline__ float rdlane(float v, int l) { return __builtin_bit_cast(float, __builtin_amdgcn_readlane(__builtin_bit_cast(int, v), l)); }
template <int CTRL> __device__ __forceinline__ float dpp_mov(float v) { return __builtin_bit_cast(float, __builtin_amdgcn_update_dpp(0, __builtin_bit_cast(int, v), CTRL, 0xf, 0xf, false)); }
__device__ __forceinline__ float red16(float v) { v += dpp_mov<0xB1>(v); v += dpp_mov<0x4E>(v); v += dpp_mov<0x141>(v); v += dpp_mov<0x140>(v); return v; }
__device__ __forceinline__ float xor16_add(float v) { const unsigned b = __builtin_bit_cast(unsigned, v); const u32x2 r = __builtin_amdgcn_permlane16_swap(b, b, false, false); return __uint_as_float(r.x) + __uint_as_float(r.y); }
__device__ __forceinline__ float xor32_add(float v) { const unsigned b = __builtin_bit_cast(unsigned, v); const u32x2 r = __builtin_amdgcn_permlane32_swap(b, b, false, false); return __uint_as_float(r.x) + __uint_as_float(r.y); }
__device__ __forceinline__ float xor16_max(float v) { const unsigned b = __builtin_bit_cast(unsigned, v); const u32x2 r = __builtin_amdgcn_permlane16_swap(b, b, false, false); return fmaxf(__uint_as_float(r.x), __uint_as_float(r.y)); }
__device__ __forceinline__ float xor32_max(float v) { const unsigned b = __builtin_bit_cast(unsigned, v); const u32x2 r = __builtin_amdgcn_permlane32_swap(b, b, false, false); return fmaxf(__uint_as_float(r.x), __uint_as_float(r.y)); }
__device__ __forceinline__ void fwht8(float (&v)[8]) {
#pragma unroll
    for (int h = 1; h < 8; h <<= 1)
#pragma unroll
        for (int i = 0; i < 8; ++i) if (!(i & h)) { const float a = v[i], b = v[i | h]; v[i] = a + b; v[i | h] = a - b; }
}
__device__ __forceinline__ void fwht8_pk(f32x2 (&p)[4]) {
#pragma unroll
    for (int i = 0; i < 4; ++i) { f32x2 d; asm("v_pk_add_f32 %0, %1, %1 op_sel:[0,1] op_sel_hi:[0,1] neg_hi:[0,1]" : "=v"(d) : "v"(p[i])); p[i] = d; }
    { const f32x2 a = p[0] + p[1], b = p[0] - p[1], c = p[2] + p[3], d = p[2] - p[3]; p[0] = a; p[1] = b; p[2] = c; p[3] = d; }
    { const f32x2 a = p[0] + p[2], b = p[1] + p[3], c = p[0] - p[2], d = p[1] - p[3]; p[0] = a; p[1] = b; p[2] = c; p[3] = d; }
}
__device__ __forceinline__ float wave_sum_fast(float v) { return xor32_add(xor16_add(red16(v))); }
__device__ __forceinline__ float sigmoid_fast(float x) { return __builtin_amdgcn_rcpf(1.0f + __builtin_amdgcn_exp2f(-1.4426950408889634f * x)); }
__device__ __forceinline__ float red8(float v) { v += dpp_mov<0xB1>(v); v += dpp_mov<0x4E>(v); v += dpp_mov<0x141>(v); return v; }
template <int N> __device__ __forceinline__ float sum_part(const float* p) {
    f32x4 a = *(const f32x4*)p;
#pragma unroll
    for (int i = 1; i < N / 4; ++i) a += *(const f32x4*)(p + 4 * i);
    return (a[0] + a[1]) + (a[2] + a[3]);
}

#define XB_TMO      128
#define XB_XCNT(j)  (256  + 64 * (j))
#define XB_XSUB(j)  (1280 + 64 * (j))
#define XB_XGEN(j)  (2304 + 64 * (j))
#define XB_TOP      3328
#define XB_TOPGEN   3392
#define XCD_BAR_WORDS 3456
#define XB_SPIN_CAP (1u << 22)
static_assert(XCD_BAR_WORDS == XCD_BAR_WORDS_C && XCD_BAR_WORDS * 4 <= CW_QUEUE, "ctl layout");

__device__ __forceinline__ unsigned xb_ld(unsigned* p)              { return __hip_atomic_load(p, __ATOMIC_RELAXED, __HIP_MEMORY_SCOPE_AGENT); }
__device__ __forceinline__ unsigned xb_add(unsigned* p, unsigned v) { return __hip_atomic_fetch_add(p, v, __ATOMIC_RELAXED, __HIP_MEMORY_SCOPE_AGENT); }
__device__ __forceinline__ unsigned xb_xcc_id() { return (unsigned)__builtin_amdgcn_s_getreg((3 << 11) | 20) & 0xFu; }
#define XB_SPIN(cond, bar) do { unsigned _sp = 0; while (cond) { __builtin_amdgcn_s_sleep(1); \
    if ((++_sp & 255u) == 0u) { if (xb_ld(&(bar)[XB_TMO])) break; if (_sp > XB_SPIN_CAP) { atomicAdd(&(bar)[XB_TMO], 1u); break; } } } } while (0)

struct XcdBarrier { unsigned* bar; unsigned x; volatile LAS unsigned* st; };

__device__ __forceinline__ XcdBarrier xcd_barrier_post(unsigned* bar, volatile LAS unsigned* st) {
    XcdBarrier b; b.bar = bar; b.x = xb_xcc_id(); b.st = st;
    if (threadIdx.x == 0) (void)xb_add(&bar[XB_XCNT(b.x)], 1u);
    return b;
}
__device__ __forceinline__ void xcd_barrier_complete(unsigned* bar, unsigned x, unsigned& nloc, unsigned& nx) {
    const unsigned G = gridDim.x * gridDim.y * gridDim.z;
    unsigned sum, cnt, mine, sp = 0u;
    for (;;) {
        sum = 0u; cnt = 0u; mine = 0u;
#pragma unroll
        for (unsigned j = 0; j < 16; ++j) { const unsigned c = xb_ld(&bar[XB_XCNT(j)]); sum += c; cnt += (c > 0u) ? 1u : 0u; mine = (j == x) ? c : mine; }
        if (sum == G) break;
        __builtin_amdgcn_s_sleep(1);
        if ((++sp & 255u) == 0u) { if (xb_ld(&bar[XB_TMO])) break; if (sp > XB_SPIN_CAP) { atomicAdd(&bar[XB_TMO], 1u); break; } }
    }
    nloc = mine > 0u ? mine : 1u; nx = cnt > 0u ? cnt : 1u;
}
__device__ __forceinline__ void xcd_barrier(const XcdBarrier& b) {
    asm volatile("s_waitcnt vmcnt(0)" ::: "memory");
    __syncthreads();
    if (threadIdx.x == 0) {
        unsigned* bar = b.bar;
        __builtin_amdgcn_s_waitcnt(0);
        unsigned nloc = b.st[0], nx = b.st[1];
        if (nloc == 0u) { xcd_barrier_complete(bar, b.x, nloc, nx); b.st[0] = nloc; b.st[1] = nx; }
        const unsigned old = xb_add(&bar[XB_XSUB(b.x)], 1u);
        const unsigned gen = old / nloc;
        if (old + 1u == (gen + 1u) * nloc) {
            __builtin_amdgcn_fence(__ATOMIC_RELEASE, "agent");
            asm volatile("s_waitcnt vmcnt(0)" ::: "memory");
            const unsigned og = xb_add(&bar[XB_TOP], 1u);
            const unsigned tg = og / nx;
            if (og + 1u == (tg + 1u) * nx) xb_add(&bar[XB_TOPGEN], 1u);
            else XB_SPIN(xb_ld(&bar[XB_TOPGEN]) == tg, bar);
            __builtin_amdgcn_fence(__ATOMIC_ACQUIRE, "agent");
            xb_add(&bar[XB_XGEN(b.x)], 1u);
            asm volatile("s_waitcnt vmcnt(0)" ::: "memory");
        } else {
            XB_SPIN(xb_ld(&bar[XB_XGEN(b.x)]) == gen, bar);
            __builtin_amdgcn_fence(__ATOMIC_ACQUIRE, "agent");
            asm volatile("s_waitcnt vmcnt(0)" ::: "memory");
        }
    }
    __syncthreads();
}

namespace pg8 {
constexpr int BM = 256, BK = 64, HALF = 128, HTB = HALF * BK * 2, STAGE_BYTES = 8 * HTB, NXCD = 8, WGM = 8;
static_assert(STAGE_BYTES == STAGE_BYTES_C, "stage bytes");
__host__ __device__ __forceinline__ int lds_byte(int r, int c) { const int st = (r >> 4) * 2 + (c >> 5), rr = r & 15, cc = c & 31, ob = rr * 64 + cc * 2; return st * 1024 + (ob ^ (((ob >> 9) & 1) << 5)); }
__host__ __device__ __forceinline__ void stage_rc(int b, int& R, int& C) { const int st = b / 1024, sb = b % 1024, swz = sb ^ (((sb >> 9) & 1) << 5); R = (st >> 1) * 16 + swz / 64; C = (st & 1) * 32 + (swz % 64) / 2; }
__host__ __device__ __forceinline__ int perm32(int rho) { const int n = rho >> 4, i = rho & 15; return 8 * (i >> 2) + 4 * n + (i & 3); }

struct Unit { int pm, pn; };
struct Gemm { const bf16_t* A; const bf16_t* Bt; int M, N, K, lda; int ablk; };

struct StaticOrder {
    int nM, nN, nwg, G, c, wgm;
    __host__ __device__ void init(int M, int N, int G_, int c_, int wgm_ = WGM) { nM = M / BM; nN = N / BM; nwg = nM * nN; G = G_; c = c_; wgm = wgm_; }
    __host__ __device__ bool next(int i, Unit& u) const {
        const long L = (long)i * G + c; if (L >= nwg) return false;
        int wgid = (int)L; { const int q = nwg / NXCD, r = nwg % NXCD, xcd = wgid % NXCD, off = wgid / NXCD; wgid = (xcd < r ? xcd * (q + 1) : r * (q + 1) + (xcd - r) * q) + off; }
        const int nig = wgm * nN, gid = wgid / nig, fm = gid * wgm, gsz = (nM - fm) < wgm ? (nM - fm) : wgm;
        u.pm = fm + ((wgid % nig) % gsz); u.pn = (wgid % nig) / gsz; return true;
    }
};

template <class Epi, bool REPE = false>
__device__ __forceinline__ void gemm_phase(LAS unsigned char* lds, const Gemm g, const StaticOrder& S, const Epi& E, const Epi& E0) {
    const int tid = opaque_tid(), wid = __builtin_amdgcn_readfirstlane(tid >> 6), lane = tid & 63, wr = wid >> 2, wc = wid & 3, fr = lane & 15, fq = lane >> 4;
    const int K = g.K, nt = K / BK, lda = g.lda;
    unsigned voffA[2], voffB[2];
#pragma unroll
    for (int i = 0; i < 2; ++i) { int R, C; stage_rc(tid * 16 + i * 8192, R, C); const int Rb = Epi::PERM ? ((R & ~31) + perm32(R & 31)) : R;
        voffA[i] = g.ablk ? (unsigned)((C >> 5) * (BM * 32) + R * 32 + (C & 31)) * 2u : (unsigned)(R * lda + C) * 2u; voffB[i] = (unsigned)(Rb * BK + C) * 2u; }
    const size_t kstep = (size_t)(BK * 2);
    const size_t hstepA = g.ablk ? (size_t)HALF * 32 * 2 : (size_t)HALF * lda * 2, hstepB = (size_t)HALF * BK * 2;
    const size_t kstepA = g.ablk ? (size_t)(BM * BK * 2) : kstep;
    const size_t kstepB = (size_t)(BM * BK * 2);
    const size_t tstepA = g.ablk ? (size_t)nt * kstepA : 2 * hstepA, tstepB = (size_t)nt * kstepB;
    const unsigned ldsw = (unsigned)wid * 1024u;
    const int aoff = lds_byte(wr * 64 + fr, fq * 8), boff = lds_byte(wc * 32 + fr, fq * 8);
#define PG8_SA(b, h) (((b) * 2 + (h)) * HTB)
#define PG8_SB(b, h) ((4 + (b) * 2 + (h)) * HTB)
#define PG8_STAGE(bufoff, gbase, voff) do { _Pragma("unroll") for (int _i = 0; _i < 2; ++_i) \
        __builtin_amdgcn_global_load_lds((const unsigned*)((const char*)(gbase) + (voff)[_i]), (LAS unsigned*)(lds + (bufoff) + ldsw + _i * 8192), 16, 0, 0); } while (0)
#define PG8_LDA(dst, b, h) do { _Pragma("unroll") for (int m = 0; m < 4; ++m) _Pragma("unroll") for (int k = 0; k < 2; ++k) dst[m][k] = *(const LAS bf16x8*)(lds + PG8_SA(b, h) + aoff + m * 2048 + k * 1024); } while (0)
#define PG8_LDB(dst, b, h) do { _Pragma("unroll") for (int n = 0; n < 2; ++n) _Pragma("unroll") for (int k = 0; k < 2; ++k) dst[n][k] = *(const LAS bf16x8*)(lds + PG8_SB(b, h) + boff + n * 2048 + k * 1024); } while (0)
#define PG8_MMA(ai, bj, At, Bt) do { __builtin_amdgcn_s_setprio(1); \
        if constexpr (Epi::I8) { _Pragma("unroll") for (int m = 0; m < 4; ++m) _Pragma("unroll") for (int n = 0; n < 2; ++n) _Pragma("unroll") for (int k = 0; k < 2; ++k) \
            acc[ai][bj][m][n] = __builtin_bit_cast(f32x4, __builtin_amdgcn_mfma_i32_16x16x64_i8(__builtin_bit_cast(i32x4, Bt[n][k]), __builtin_bit_cast(i32x4, At[m][k]), __builtin_bit_cast(i32x4, acc[ai][bj][m][n]), 0, 0, 0)); } \
        else { _Pragma("unroll") for (int m = 0; m < 4; ++m) _Pragma("unroll") for (int n = 0; n < 2; ++n) _Pragma("unroll") for (int k = 0; k < 2; ++k) \
            acc[ai][bj][m][n] = __builtin_amdgcn_mfma_f32_16x16x32_bf16(Bt[n][k], At[m][k], acc[ai][bj][m][n], 0, 0, 0); } \
        __builtin_amdgcn_s_setprio(0); } while (0)
#define PG8_WAIT_V(n) asm volatile("s_waitcnt vmcnt(" #n ")" ::: "memory")
#define PG8_WAIT_L(n) asm volatile("s_waitcnt lgkmcnt(" #n ")" ::: "memory")
#define PG8_BAR __builtin_amdgcn_s_barrier()
#define PG8_SCHED __builtin_amdgcn_sched_barrier(0)
    Unit cur, nxt; int ui = 0;
    if (!S.next(0, cur)) return;
    float rsn[8];
#pragma unroll
    for (int r = 0; r < 8; ++r) rsn[r] = 0.f;
    if (Epi::PREF) E.rs_first(cur, wr, fr, fq, rsn);
    f32x4 acc[2][2][4][2];
#pragma unroll
    for (int a = 0; a < 2; ++a)
#pragma unroll
        for (int b = 0; b < 2; ++b)
#pragma unroll
            for (int m = 0; m < 4; ++m)
#pragma unroll
                for (int n = 0; n < 2; ++n) acc[a][b][m][n] = (f32x4){0.f, 0.f, 0.f, 0.f};
    bf16x8 At[4][2], B0[2][2], B1[2][2];
    const char* cA = (const char*)g.A + (size_t)cur.pm * tstepA; const char* cB = (const char*)g.Bt + (size_t)cur.pn * tstepB;
    PG8_STAGE(PG8_SB(0, 0), cB, voffB); PG8_STAGE(PG8_SA(0, 0), cA, voffA); PG8_STAGE(PG8_SB(0, 1), cB + hstepB, voffB); PG8_STAGE(PG8_SA(0, 1), cA + hstepA, voffA);
    if (wr == 1) PG8_BAR;
    PG8_WAIT_V(4); PG8_BAR;
    PG8_STAGE(PG8_SB(1, 0), cB + kstepB, voffB); PG8_STAGE(PG8_SA(1, 0), cA + kstepA, voffA); PG8_STAGE(PG8_SB(1, 1), cB + hstepB + kstepB, voffB);
    PG8_WAIT_V(6); PG8_BAR;
    for (;;) {
        const bool has_next = S.next(ui + 1, nxt);
        const char* nA = has_next ? (const char*)g.A + (size_t)nxt.pm * tstepA : cA; const char* nB = has_next ? (const char*)g.Bt + (size_t)nxt.pn * tstepB : cB;
#pragma nounroll
        for (int t = 0; t < nt; t += 2) {
            const bool last = (t == nt - 2);
            const char* a1 = cA + (size_t)(t + 1) * kstepA;
            const char* a2 = last ? nA : cA + (size_t)(t + 2) * kstepA; const char* b2 = last ? nB : cB + (size_t)(t + 2) * kstepB;
            const char* a3 = a2 + kstepA; const char* b3 = b2 + kstepB;
            PG8_LDB(B0, 0, 0); PG8_SCHED; PG8_LDA(At, 0, 0); PG8_STAGE(PG8_SA(1, 1), a1 + hstepA, voffA);
            PG8_WAIT_L(8); PG8_BAR; PG8_WAIT_L(0); PG8_MMA(0, 0, At, B0); PG8_BAR; PG8_SCHED;
            PG8_LDB(B1, 0, 1); PG8_STAGE(PG8_SB(0, 0), b2, voffB);
            PG8_BAR; PG8_WAIT_L(0); PG8_MMA(0, 1, At, B1); PG8_BAR;
            PG8_LDA(At, 0, 1); PG8_STAGE(PG8_SA(0, 0), a2, voffA);
            PG8_BAR; PG8_WAIT_L(0); PG8_MMA(1, 0, At, B0); PG8_BAR; PG8_SCHED;
            PG8_STAGE(PG8_SB(0, 1), b2 + hstepB, voffB);
            PG8_WAIT_V(6); PG8_BAR; PG8_MMA(1, 1, At, B1); PG8_BAR;
            PG8_LDB(B0, 1, 0); PG8_SCHED; PG8_LDA(At, 1, 0); PG8_STAGE(PG8_SA(0, 1), a2 + hstepA, voffA);
            PG8_WAIT_L(8); PG8_BAR; PG8_WAIT_L(0); PG8_MMA(0, 0, At, B0); PG8_BAR; PG8_SCHED;
            PG8_LDB(B1, 1, 1); PG8_STAGE(PG8_SB(1, 0), b3, voffB);
            PG8_BAR; PG8_WAIT_L(0); PG8_MMA(0, 1, At, B1); PG8_BAR;
            PG8_LDA(At, 1, 1); PG8_STAGE(PG8_SA(1, 0), a3, voffA);
            PG8_BAR; PG8_WAIT_L(0); PG8_MMA(1, 0, At, B0); PG8_BAR; PG8_SCHED;
            PG8_STAGE(PG8_SB(1, 1), b3 + hstepB, voffB);
            PG8_WAIT_V(6); PG8_BAR; PG8_MMA(1, 1, At, B1); PG8_BAR;
        }
        if (REPE) { float rs2[8]; _Pragma("unroll") for (int r = 0; r < 8; ++r) rs2[r] = rsn[r]; E0(acc, cur, nxt, false, rs2, wr, wc, fr, fq); }
        E(acc, cur, nxt, has_next, rsn, wr, wc, fr, fq);
        if (!has_next) break;
#pragma unroll
        for (int a = 0; a < 2; ++a)
#pragma unroll
            for (int b = 0; b < 2; ++b)
#pragma unroll
                for (int m = 0; m < 4; ++m)
#pragma unroll
                    for (int n = 0; n < 2; ++n) acc[a][b][m][n] = (f32x4){0.f, 0.f, 0.f, 0.f};
        cur = nxt; cA = nA; cB = nB; ++ui;
    }
    PG8_WAIT_V(0);
    if (wr == 0) PG8_BAR;
    PG8_BAR;
#undef PG8_SA
#undef PG8_SB
#undef PG8_STAGE
#undef PG8_LDA
#undef PG8_LDB
#undef PG8_MMA
#undef PG8_WAIT_V
#undef PG8_WAIT_L
#undef PG8_BAR
#undef PG8_SCHED
}
}

__device__ __forceinline__ float silu_f(float x) { return x * __builtin_amdgcn_rcpf(1.0f + __expf(-x)); }

__device__ __forceinline__ void rstd8_from_part32(const float* part, int row0, int fq, float inv_n, float (&rs)[8]) {
    f32x4 pa[8], pb[8];
#pragma unroll
    for (int r = 0; r < 8; ++r) { const float* p = part + (size_t)(row0 + (r >> 2) * 128 + (r & 3) * 16) * 32 + fq * 8; pa[r] = *(const f32x4*)p; pb[r] = *(const f32x4*)(p + 4); }
#pragma unroll
    for (int r = 0; r < 8; ++r) {
        float sm = ((pa[r][0] + pa[r][1]) + (pa[r][2] + pa[r][3])) + ((pb[r][0] + pb[r][1]) + (pb[r][2] + pb[r][3]));
        sm += __shfl_xor(sm, 16); sm += __shfl_xor(sm, 32);
        rs[r] = rsqrtf(sm * inv_n + RMS_EPS);
    }
}
__device__ __forceinline__ void rstd8_load(const float* rstd, int row0, float (&rs)[8]) {
#pragma unroll
    for (int r = 0; r < 8; ++r) rs[r] = rstd[row0 + (r >> 2) * 128 + (r & 3) * 16];
}
struct EpiGU {
    static constexpr bool PERM = true, PREF = true, I8 = true;
    bf16_t* O; const float* part; const float* rstd; const float* wmax; unsigned* amax;
    __device__ __forceinline__ void rs_first(const pg8::Unit& u, int wr, int fr, int fq, float (&rs)[8]) const { if (rstd) rstd8_load(rstd, u.pm * 256 + wr * 64 + fr, rs); }
    __device__ __forceinline__ void operator()(const f32x4 (&acc)[2][2][4][2], const pg8::Unit& u, const pg8::Unit& nx, bool has_next, float (&rsn)[8], int wr, int wc, int fr_, int fq_) const {
        int fr = fr_, fq = fq_; asm volatile("" : "+v"(fr), "+v"(fq));
        const int row0 = u.pm * 256 + wr * 64 + fr, col0 = u.pn * 128 + wc * 32 + 8 * fq;
        float rsv[8], rsp[8];
        const float wsc = *wmax * (1.0f / 127.0f);
        unsigned mxr[8];
        if (rstd && !PREF) rstd8_load(rstd, row0, rsv);
        else if (rstd) {
#pragma unroll
            for (int r = 0; r < 8; ++r) { rsv[r] = rsn[r]; rsp[r] = rsn[r]; }
            if (has_next) rstd8_load(rstd, nx.pm * 256 + wr * 64 + fr, rsp);
        } else rstd8_from_part32(part, row0, fq, 1.0f / DM, rsv);
#pragma unroll
        for (int ai = 0; ai < 2; ++ai)
#pragma unroll
            for (int m = 0; m < 4; ++m) {
                const int row = row0 + ai * 128 + m * 16;
                const float rs = rsv[ai * 4 + m] * wsc;
                const float c1 = rs * -1.4426950408889634f;
                f32x2 op[4];
#pragma unroll
                for (int n = 0; n < 2; ++n)
#pragma unroll
                    for (int e2 = 0; e2 < 2; ++e2) {
                        const i32x4 gi = __builtin_bit_cast(i32x4, acc[ai][0][m][n]), ui = __builtin_bit_cast(i32x4, acc[ai][1][m][n]);
                        const f32x2 g2 = {(float)gi[2 * e2], (float)gi[2 * e2 + 1]}, u2 = {(float)ui[2 * e2], (float)ui[2 * e2 + 1]};
                        const f32x2 t2 = g2 * c1; f32x2 d2 = {__builtin_amdgcn_exp2f(t2.x), __builtin_amdgcn_exp2f(t2.y)}; d2 = d2 + 1.0f;
                        const f32x2 r2 = {__builtin_amdgcn_rcpf(d2.x), __builtin_amdgcn_rcpf(d2.y)};
                        op[n * 2 + e2] = (g2 * u2) * r2; }
                fwht8_pk(op);
                const float o[8] = {op[0][0], op[0][1], op[1][0], op[1][1], op[2][0], op[2][1], op[3][0], op[3][1]};
                {
                    unsigned mx, m2;
                    asm("v_max3_f32 %0, |%1|, |%2|, |%3|" : "=v"(mx) : "v"(o[0]), "v"(o[1]), "v"(o[2]));
                    asm("v_max3_f32 %0, |%1|, |%2|, |%3|" : "=v"(m2) : "v"(o[3]), "v"(o[4]), "v"(o[5]));
                    asm("v_max3_f32 %0, %1, |%2|, |%3|" : "=v"(mx) : "v"(mx), "v"(o[6]), "v"(o[7]));
                    mx = mx > m2 ? mx : m2;
                    { const u32x2 r = __builtin_amdgcn_permlane16_swap(mx, mx, false, false); mx = r.x > r.y ? r.x : r.y; }
                    { const u32x2 r = __builtin_amdgcn_permlane32_swap(mx, mx, false, false); mx = r.x > r.y ? r.x : r.y; }
                    mxr[ai * 4 + m] = mx;
                }
                u32x4 w; w.x = cvt_pk_bf16(o[0], o[1]); w.y = cvt_pk_bf16(o[2], o[3]); w.z = cvt_pk_bf16(o[4], o[5]); w.w = cvt_pk_bf16(o[6], o[7]);
                __builtin_nontemporal_store(w, (u32x4*)(O + ((((size_t)u.pm * (DFF / 64) + (col0 >> 6)) * 2 + ((col0 >> 5) & 1)) * 256 + (row & 255)) * 32 + (col0 & 31)));
            }
        if (fq == 0) {
#pragma unroll
            for (int r = 0; r < 8; ++r) __hip_atomic_fetch_max(amax + row0 + (r >> 2) * 128 + (r & 3) * 16, mxr[r], __ATOMIC_RELAXED, __HIP_MEMORY_SCOPE_AGENT);
        }
        if (rstd && PREF) {
#pragma unroll
            for (int r = 0; r < 8; ++r) rsn[r] = rsp[r];
        }
    }
};

template <bool I8_> struct EpiResT {
    static constexpr bool PERM = true, PREF = false, I8 = I8_;
    const float* basef; bf16_t* hb; float* part; float scale; const float* asc; const float* wmax;
    __device__ __forceinline__ void rs_first(const pg8::Unit&, int, int, int, float (&)[8]) const {}
    __device__ __forceinline__ void operator()(const f32x4 (&acc)[2][2][4][2], const pg8::Unit& u, const pg8::Unit&, bool, float (&)[8], int wr, int wc, int fr, int fq) const {
        const int row0 = u.pm * 256 + wr * 64 + fr, col0 = u.pn * 256 + wc * 32 + 8 * fq;
        const float wsc = I8 ? scale * (*wmax * (1.0f / 127.0f)) : scale;
#pragma unroll
        for (int ai = 0; ai < 2; ++ai)
#pragma unroll
        for (int mh = 0; mh < 2; ++mh) {
            f32x4 b0[2][2], b1[2][2]; float rowf[2];
#pragma unroll
            for (int m2 = 0; m2 < 2; ++m2) rowf[m2] = I8 ? wsc * asc[row0 + ai * 128 + (mh * 2 + m2) * 16] : scale;
            if (basef) {
#pragma unroll
                for (int m2 = 0; m2 < 2; ++m2)
#pragma unroll
                    for (int bj = 0; bj < 2; ++bj) { const float* p = basef + (size_t)(row0 + ai * 128 + (mh * 2 + m2) * 16) * DM + col0 + bj * 128; b0[m2][bj] = *(const f32x4*)p; b1[m2][bj] = *(const f32x4*)(p + 4); }
            } else {
#pragma unroll
                for (int m2 = 0; m2 < 2; ++m2)
#pragma unroll
                    for (int bj = 0; bj < 2; ++bj) { const u32x4 w = *(const u32x4*)(hb + (size_t)(row0 + ai * 128 + (mh * 2 + m2) * 16) * DM + col0 + bj * 128);
                        b0[m2][bj] = (f32x4){__uint_as_float(w.x << 16), __uint_as_float(w.x & 0xffff0000u), __uint_as_float(w.y << 16), __uint_as_float(w.y & 0xffff0000u)};
                        b1[m2][bj] = (f32x4){__uint_as_float(w.z << 16), __uint_as_float(w.z & 0xffff0000u), __uint_as_float(w.w << 16), __uint_as_float(w.w & 0xffff0000u)}; }
            }
#pragma unroll
            for (int m2 = 0; m2 < 2; ++m2) {
                const int m = mh * 2 + m2;
                const int row = row0 + ai * 128 + m * 16; float sq = 0.f;
#pragma unroll
                for (int bj = 0; bj < 2; ++bj) {
                    const f32x4 a0 = I8 ? __builtin_convertvector(__builtin_bit_cast(i32x4, acc[ai][bj][m][0]), f32x4) : acc[ai][bj][m][0], a1 = I8 ? __builtin_convertvector(__builtin_bit_cast(i32x4, acc[ai][bj][m][1]), f32x4) : acc[ai][bj][m][1];
                    const f32x4 v0 = b0[m2][bj] + a0 * rowf[m2], v1 = b1[m2][bj] + a1 * rowf[m2];
                    u32x4 w; w.x = cvt_pk_bf16(v0[0], v0[1]); w.y = cvt_pk_bf16(v0[2], v0[3]); w.z = cvt_pk_bf16(v1[0], v1[1]); w.w = cvt_pk_bf16(v1[2], v1[3]);
                    *(u32x4*)(hb + (size_t)row * DM + col0 + bj * 128) = w;
                    const float r0 = __uint_as_float(w.x << 16), r1 = __uint_as_float(w.x & 0xffff0000u), r2 = __uint_as_float(w.y << 16), r3 = __uint_as_float(w.y & 0xffff0000u);
                    const float r4 = __uint_as_float(w.z << 16), r5 = __uint_as_float(w.z & 0xffff0000u), r6 = __uint_as_float(w.w << 16), r7 = __uint_as_float(w.w & 0xffff0000u);
                    sq += ((r0 * r0 + r1 * r1) + (r2 * r2 + r3 * r3)) + ((r4 * r4 + r5 * r5) + (r6 * r6 + r7 * r7));
                }
                sq += __shfl_xor(sq, 16); sq += __shfl_xor(sq, 32);
                if (fq == 0) part[(size_t)row * 32 + u.pn * 4 + wc] = sq;
            }
        }
    }
};

template <int MODE> struct EpiScale {
    static constexpr bool PERM = true, PREF = (MODE == 0), I8 = false;
    bf16_t* O; int ldo; const float* part_in; float inv_n; float mul; float* part_q; float* part_kv; const float* rc; const float* rs; const float* rstd;
    __device__ __forceinline__ void rs_first(const pg8::Unit& u, int wr, int fr, int fq, float (&rv)[8]) const { if (MODE == 0 && rstd) rstd8_load(rstd, u.pm * 256 + wr * 64 + fr, rv); }
    __device__ __forceinline__ void operator()(const f32x4 (&acc)[2][2][4][2], const pg8::Unit& u, const pg8::Unit& nx, bool has_next, float (&rsn)[8], int wr, int wc, int fr, int fq) const {
        const int row0 = u.pm * 256 + wr * 64 + fr, col0 = u.pn * 256 + wc * 32 + 8 * fq;
        float rsv[8], rsp[8];
        if (MODE == 0 && rstd) {
#pragma unroll
            for (int r = 0; r < 8; ++r) { rsv[r] = rsn[r]; rsp[r] = rsn[r]; }
            if (has_next) rstd8_load(rstd, nx.pm * 256 + wr * 64 + fr, rsp);
        } else if (MODE == 0) rstd8_from_part32(part_in, row0, fq, inv_n, rsv);
        else if (MODE == 2) {
            f32x4 pa[8], pb[8];
#pragma unroll
            for (int r = 0; r < 8; ++r) { const float* p = part_in + (size_t)(row0 + (r >> 2) * 128 + (r & 3) * 16) * 8; pa[r] = *(const f32x4*)p; pb[r] = *(const f32x4*)(p + 4); }
#pragma unroll
            for (int r = 0; r < 8; ++r) rsv[r] = rsqrtf((((pa[r][0] + pa[r][1]) + (pa[r][2] + pa[r][3])) + ((pb[r][0] + pb[r][1]) + (pb[r][2] + pb[r][3]))) * inv_n + RMS_EPS);
        } else {
            f32x4 pa[8];
#pragma unroll
            for (int r = 0; r < 8; ++r) pa[r] = *(const f32x4*)(part_in + (size_t)(row0 + (r >> 2) * 128 + (r & 3) * 16) * 4);
#pragma unroll
            for (int r = 0; r < 8; ++r) rsv[r] = rsqrtf(((pa[r][0] + pa[r][1]) + (pa[r][2] + pa[r][3])) * inv_n + RMS_EPS);
        }
#pragma unroll
        for (int ai = 0; ai < 2; ++ai)
#pragma unroll
            for (int m = 0; m < 4; ++m) {
                const int row = row0 + ai * 128 + m * 16;
                const float r = rsv[ai * 4 + m] * mul;
                float sq = 0.f;
#pragma unroll
                for (int bj = 0; bj < 2; ++bj) {
                    const int c = col0 + bj * 128;
                    f32x4 v0 = acc[ai][bj][m][0] * r, v1 = acc[ai][bj][m][1] * r;
                    if (MODE == 2) {
                        const int cc = c % QKD;
                        if (cc >= 128) {
                            const int j0 = (cc - 128) >> 1;
                            const f32x4 cs = *(const f32x4*)(rc + (size_t)row * 32 + j0), sn = *(const f32x4*)(rs + (size_t)row * 32 + j0);
                            f32x4 a0, a1;
                            a0[0] = v0[0] * cs[0] - v0[1] * sn[0]; a0[1] = v0[0] * sn[0] + v0[1] * cs[0];
                            a0[2] = v0[2] * cs[1] - v0[3] * sn[1]; a0[3] = v0[2] * sn[1] + v0[3] * cs[1];
                            a1[0] = v1[0] * cs[2] - v1[1] * sn[2]; a1[1] = v1[0] * sn[2] + v1[1] * cs[2];
                            a1[2] = v1[2] * cs[3] - v1[3] * sn[3]; a1[3] = v1[2] * sn[3] + v1[3] * cs[3];
                            v0 = a0; v1 = a1;
                        }
                    }
                    if (MODE == 0) sq += (v0[0] * v0[0] + v0[1] * v0[1]) + (v0[2] * v0[2] + v0[3] * v0[3]) + (v1[0] * v1[0] + v1[1] * v1[1]) + (v1[2] * v1[2] + v1[3] * v1[3]);
                    u32x4 w; w.x = cvt_pk_bf16(v0[0], v0[1]); w.y = cvt_pk_bf16(v0[2], v0[3]); w.z = cvt_pk_bf16(v1[0], v1[1]); w.w = cvt_pk_bf16(v1[2], v1[3]);
                    __builtin_nontemporal_store(w, (u32x4*)(O + (size_t)row * ldo + c));
                }
                if (MODE == 0) {
                    if (u.pn < 3) {
                        sq += __shfl_xor(sq, 16); sq += __shfl_xor(sq, 32);
                        if (fq == 0) { if (u.pn < 2) part_q[(size_t)row * 8 + u.pn * 4 + wc] = sq; else part_kv[(size_t)row * 4 + wc] = sq; }
                    }
                }
            }
        if (MODE == 0 && rstd) {
#pragma unroll
            for (int r = 0; r < 8; ++r) rsn[r] = rsp[r];
        }
    }
};

struct Args { const void* in[32]; float* out; unsigned char* ws; int ph_lo, ph_hi; };

struct Ctx {
    const void* const* in; float* out; unsigned char* ws;
    LAS unsigned char* lds; int G, wg;
    __device__ __forceinline__ const float* fin(int i) const { return (const float*)in[i]; }
    template <class T> __device__ __forceinline__ T* at(size_t off) const { return (T*)(ws + off); }
    __device__ __forceinline__ Ctx fresh() const { Ctx c = *this; int z; asm volatile("s_mov_b32 %0, 0" : "=s"(z)); c.in = in + z; c.out = out + z; c.ws = ws + z; c.G = G + z; c.wg = wg + z; return c; }
};

enum { MAP_ID = 0, MAP_GU = 1, MAP_WIN = 2, MAP_UQ = 3 };
template <int MAP> __device__ __forceinline__ int src_col(int n) {
    if (MAP == MAP_WIN) { if (n >= NIN) return -1; if (n >= 768 && n < 832) { const int jj = n - 768; return 768 + (jj & 1) * 32 + (jj >> 1); } return n; }
    if (MAP == MAP_UQ) { const int h = n / QKD, cc = n % QKD; if (cc < 128) return n; const int jj = cc - 128; return h * QKD + 128 + (jj & 1) * 32 + (jj >> 1); }
    return n;
}
template <int MAP, bool F8 = false, bool HAD = false>
__device__ __forceinline__ void conv_job(const Ctx& C, int& toff, const float* src, const float* src2, int ldsrc, bf16_t* dst, int Ndst, int K, const float* gain, float qs = 1.0f) {
    LAS float* tile = (LAS float*)C.lds;
    const int tid = opaque_tid(), ntn = Ndst / 64, ntk = K / 256, ntiles = ntn * ntk;
    const int tfirst = (C.wg + C.G - toff % C.G) % C.G; toff += ntiles;
    for (int t = tfirst; t < ntiles; t += C.G) {
        const int tn = t % ntn, tk = t / ntn, n0 = tn * 64, k0 = tk * 256;
        {
            const int nl = tid & 63, kl0 = tid >> 6;
            const float* s = src; int col;
            if (MAP == MAP_GU) { const int n = n0 + nl, tt = n >> 8, r = n & 255; s = (r < 128) ? src : src2; col = tt * 128 + (r & 127); }
            else col = src_col<MAP>(n0 + nl);
            float v[32];
            const float* sp = s + (size_t)(k0 + kl0) * ldsrc + (col >= 0 ? col : 0);
#pragma unroll
            for (int i = 0; i < 32; ++i) v[i] = sp[(size_t)(8 * i) * ldsrc];
#pragma unroll
            for (int i = 0; i < 32; ++i) {
                float x = (col >= 0) ? v[i] : 0.f;
                if (gain) x *= gain[k0 + kl0 + 8 * i];
                if (F8) x *= qs;
                tile[(kl0 + 8 * i) * 65 + nl] = x;
            }
        }
        __syncthreads();
        {
            const int nl = tid >> 3, kc = (tid & 7) * 8;
#pragma unroll
            for (int q = 0; q < 4; ++q) {
                float v[8];
#pragma unroll
                for (int e = 0; e < 8; ++e) v[e] = tile[(q * 64 + kc + e) * 65 + nl];
                if (HAD) { fwht8(v);
#pragma unroll
                    for (int e = 0; e < 8; ++e) v[e] *= 0.35355339059327373f; }
                if (F8) {
                    u32x2 w8; w8.x = pk4_i8(v[0], v[1], v[2], v[3]); w8.y = pk4_i8(v[4], v[5], v[6], v[7]);
                    const int n_ = n0 + nl, kt_ = (k0 >> 7) + (q >> 1);
                    *(u32x2*)((unsigned char*)dst + (((size_t)(n_ >> 8) * (K >> 7) + kt_) * 256 + (n_ & 255)) * 128 + (q & 1) * 64 + kc) = w8;
                    continue;
                }
                u32x4 w; w.x = cvt_pk_bf16(v[0], v[1]); w.y = cvt_pk_bf16(v[2], v[3]); w.z = cvt_pk_bf16(v[4], v[5]); w.w = cvt_pk_bf16(v[6], v[7]);
                { const int n_ = n0 + nl, kt_ = (k0 >> 6) + q;
                  *(u32x4*)(dst + (((size_t)(n_ >> 8) * (K >> 6) + kt_) * 256 + (n_ & 255)) * 64 + kc) = w; }
            }
        }
        __syncthreads();
    }
}
template <bool GU, bool HAD>
__device__ __forceinline__ void conv_job_w(const Ctx& C, int& toff, const float* src, const float* src2, int ldsrc, unsigned char* dst, int Ndst, int K, const float* gain, float qs) {
    LAS float* tile = (LAS float*)C.lds;
    const int tid = opaque_tid(), ntn = Ndst / 256, ntk = K / 64, ntiles = ntn * ntk;
    const int tfirst = (C.wg + C.G - toff % C.G) % C.G; toff += ntiles;
    for (int t = tfirst; t < ntiles; t += C.G) {
        const int tn = t % ntn, tk = t / ntn, n0 = tn * 256, k0 = tk * 64;
        {
            const int n4 = tid & 63, kl0 = tid >> 6;
            const float* s = src; int col = n0 + 4 * n4;
            if (GU) { const int r = 4 * n4; s = (r < 128) ? src : src2; col = tn * 128 + (r & 127); }
            f32x4 v[8];
            const float* sp = s + (size_t)(k0 + kl0) * ldsrc + col;
#pragma unroll
            for (int i = 0; i < 8; ++i) v[i] = *(const f32x4*)(sp + (size_t)(8 * i) * ldsrc);
#pragma unroll
            for (int i = 0; i < 8; ++i) { float g = qs; if (gain) g *= gain[k0 + kl0 + 8 * i]; *(LAS f32x4*)(tile + (kl0 + 8 * i) * 260 + 4 * n4) = v[i] * g; }
        }
        __syncthreads();
#pragma unroll
        for (int j = 0; j < 4; ++j) {
            const int p = tid + 512 * j, kg = p & 7, nl = p >> 3;
            float v[8];
#pragma unroll
            for (int e = 0; e < 8; ++e) v[e] = tile[(kg * 8 + e) * 260 + nl];
            if (HAD) { fwht8(v);
#pragma unroll
                for (int e = 0; e < 8; ++e) v[e] *= 0.35355339059327373f; }
            u32x2 w8; w8.x = pk4_i8(v[0], v[1], v[2], v[3]); w8.y = pk4_i8(v[4], v[5], v[6], v[7]);
            const int n_ = n0 + nl, kk = k0 + kg * 8;
            *(u32x2*)(dst + (((size_t)(n_ >> 8) * (K >> 7) + (kk >> 7)) * 256 + (n_ & 255)) * 128 + (kk & 127)) = w8;
        }
        __syncthreads();
    }
}
__device__ __forceinline__ float wmax_scan(const Ctx& C, const float* w, const float* gain, float mx) {
    const int tid = opaque_tid();
    for (int k0 = C.wg; k0 < DM; k0 += 4 * C.G) {
        f32x4 v[4][3];
#pragma unroll
        for (int j = 0; j < 4; ++j) { const int k = k0 + j * C.G; const float* r = w + (size_t)(k < DM ? k : k0) * DFF;
#pragma unroll
            for (int i = 0; i < 3; ++i) { const int c = (i * 512 + tid) * 4; v[j][i] = *(const f32x4*)(r + (c < DFF ? c : 0)); } }
#pragma unroll
        for (int j = 0; j < 4; ++j) { const int k = k0 + j * C.G; float m = 0.f;
#pragma unroll
            for (int i = 0; i < 3; ++i) m = fmaxf(fmaxf(m, fmaxf(__builtin_fabsf(v[j][i][0]), __builtin_fabsf(v[j][i][1]))), fmaxf(__builtin_fabsf(v[j][i][2]), __builtin_fabsf(v[j][i][3])));
            mx = fmaxf(mx, m * __builtin_fabsf(gain[k < DM ? k : k0])); }
    }
    return mx;
}
__device__ __forceinline__ float wmax_scan_rot(const Ctx& C, const float* w) {
    const int tid = opaque_tid(); float mx = 0.f;
    for (int grp = C.wg; grp < DFF / 8; grp += C.G) {
        f32x4 v[8];
#pragma unroll
        for (int j = 0; j < 8; ++j) v[j] = *(const f32x4*)(w + (size_t)(grp * 8 + j) * DM + tid * 4);
#pragma unroll
        for (int c = 0; c < 4; ++c) { float t[8];
#pragma unroll
            for (int j = 0; j < 8; ++j) t[j] = v[j][c];
            fwht8(t);
#pragma unroll
            for (int j = 0; j < 8; ++j) mx = fmaxf(mx, __builtin_fabsf(t[j] * 0.35355339059327373f)); }
    }
    return mx;
}
__device__ __forceinline__ void phase_convert(const Ctx& C, int l, const XcdBarrier& bar) {
    const size_t offGU = (size_t)l * DM * DFF, offD = (size_t)l * DFF * DM; int toff = 0;
    unsigned* wm = C.at<unsigned>(WS_CTL + CW_WMAX) + l * 2;
    {
#pragma unroll
        for (int f = 0; f < 2; ++f) {
            float mx = wmax_scan(C, C.fin(f ? 28 : 3) + offGU, C.fin(f ? 27 : 2) + l * DM, 0.f);
            mx = wmax_scan(C, C.fin(f ? 29 : 4) + offGU, C.fin(f ? 27 : 2) + l * DM, mx);
#pragma unroll
            for (int o = 32; o >= 1; o >>= 1) mx = fmaxf(mx, __shfl_xor(mx, o));
            if ((opaque_tid() & 63) == 0) __hip_atomic_fetch_max(wm + f, __float_as_uint(mx), __ATOMIC_RELAXED, __HIP_MEMORY_SCOPE_AGENT);
            float md = wmax_scan_rot(C, C.fin(f ? 30 : 5) + offD);
#pragma unroll
            for (int o = 32; o >= 1; o >>= 1) md = fmaxf(md, __shfl_xor(md, o));
            if ((opaque_tid() & 63) == 0) __hip_atomic_fetch_max(wm + 8 + f, __float_as_uint(md), __ATOMIC_RELAXED, __HIP_MEMORY_SCOPE_AGENT);
        }
        xcd_barrier(bar);
    }
    const float wmaxd1 = __uint_as_float(__hip_atomic_load(wm + 8, __ATOMIC_RELAXED, __HIP_MEMORY_SCOPE_AGENT)), wmaxd2 = __uint_as_float(__hip_atomic_load(wm + 9, __ATOMIC_RELAXED, __HIP_MEMORY_SCOPE_AGENT));
    const float qd1 = wmaxd1 > 0.f ? 127.0f / wmaxd1 : 0.f, qd2 = wmaxd2 > 0.f ? 127.0f / wmaxd2 : 0.f;
    const float wmax1 = __uint_as_float(__hip_atomic_load(wm + 0, __ATOMIC_RELAXED, __HIP_MEMORY_SCOPE_AGENT)), wmax2 = __uint_as_float(__hip_atomic_load(wm + 1, __ATOMIC_RELAXED, __HIP_MEMORY_SCOPE_AGENT));
    const float qs1 = wmax1 > 0.f ? 127.0f / wmax1 : 0.f, qs2 = wmax2 > 0.f ? 127.0f / wmax2 : 0.f;
    conv_job_w<false, true>(C, toff, C.fin(30) + offD, nullptr, DM, C.at<unsigned char>(WS_W2D), DM, DFF, nullptr, qd2);
    conv_job_w<true, false>(C, toff, C.fin(28) + offGU, C.fin(29) + offGU, DFF, C.at<unsigned char>(WS_W2GU), 2 * DFF, DM, C.fin(27) + l * DM, qs2);
    conv_job_w<false, true>(C, toff, C.fin(5) + offD, nullptr, DM, C.at<unsigned char>(WS_W1D), DM, DFF, nullptr, qd1);
    conv_job_w<true, false>(C, toff, C.fin(3) + offGU, C.fin(4) + offGU, DFF, C.at<unsigned char>(WS_W1GU), 2 * DFF, DM, C.fin(2) + l * DM, qs1);
    conv_job<MAP_WIN>(C, toff, C.fin(7) + (size_t)l * DM * NIN, nullptr, NIN, C.at<bf16_t>(WS_WIN), NINP, DM, C.fin(6) + l * DM);
    conv_job<MAP_UQ>(C, toff, C.fin(10) + (size_t)l * QL * NQ, nullptr, NQ, C.at<bf16_t>(WS_WUQ), NQ, QL, C.fin(8) + l * QL);
    conv_job<MAP_ID>(C, toff, C.fin(11) + (size_t)l * KVL * NKV, nullptr, NKV, C.at<bf16_t>(WS_WUKV), NKV, KVL, C.fin(9) + l * KVL);
    conv_job<MAP_ID>(C, toff, C.fin(26) + (size_t)l * DM * DM, nullptr, DM, C.at<bf16_t>(WS_WOUT), DM, DM, nullptr);
    {
        const int tid = opaque_tid(); bf16_t* Ub = C.at<bf16_t>(WS_LORA);
        const float* dU = C.fin(15) + (size_t)l * 32 * BW; const float* iU = C.fin(17) + (size_t)l * 32 * BW; const float* gU = C.fin(18) + (size_t)l * 96 * BW;
        for (int e = C.wg * NTHREADS + tid; e < 512 * 160; e += C.G * NTHREADS) {
            const int k = e >> 9, n = e & 511;
            const float v = (k < 32) ? dU[k * BW + n] : (k < 64 ? iU[(k - 32) * BW + n] : gU[(k - 64) * BW + n]);
            Ub[n * 160 + k] = f2bf(v);
        }
    }
}

__device__ __forceinline__ void phase_prologue(const Ctx& C) {
    const int tid = opaque_tid(), lane = tid & 63, wv = tid >> 6;
    const float* x = C.fin(0); bf16_t* hb = C.at<bf16_t>(WS_HB); float* part = C.at<float>(WS_PARTH); unsigned char* h8 = C.at<unsigned char>(WS_H8);
    for (int row = C.wg * 8 + wv; row < MTOK; row += C.G * 8) {
        float s = 0.f, mx = 0.f; f32x4 v[8];
#pragma unroll
        for (int i = 0; i < 8; ++i) {
            const size_t off = (size_t)row * DM + (i * 64 + lane) * 4;
            v[i] = *(const f32x4*)(x + off);
            u32x2 w; w.x = cvt_pk_bf16(v[i][0], v[i][1]); w.y = cvt_pk_bf16(v[i][2], v[i][3]);
            *(u32x2*)(hb + off) = w;
            s += (v[i][0] * v[i][0] + v[i][1] * v[i][1]) + (v[i][2] * v[i][2] + v[i][3] * v[i][3]);
            mx = fmaxf(fmaxf(mx, fmaxf(__builtin_fabsf(v[i][0]), __builtin_fabsf(v[i][1]))), fmaxf(__builtin_fabsf(v[i][2]), __builtin_fabsf(v[i][3])));
        }
        s = wave_sum(s);
#pragma unroll
        for (int o = 32; o >= 1; o >>= 1) mx = fmaxf(mx, __shfl_xor(mx, o));
        const float qs = mx > 0.f ? 127.0f / mx : 0.f;
#pragma unroll
        for (int i = 0; i < 8; ++i) *(unsigned*)(h8 + (size_t)row * DM + (i * 64 + lane) * 4) = pk4_i8(v[i][0] * qs, v[i][1] * qs, v[i][2] * qs, v[i][3] * qs);
        if (lane < 32) part[(size_t)row * 32 + lane] = (lane == 0) ? s : 0.f;
        const float rstd = rsqrtf(s * (1.0f / DM) + RMS_EPS);
        if (lane == 0) { C.at<float>(WS_RSTD)[row] = rstd; C.at<float>(WS_RSA)[row] = rstd * (mx * (1.0f / 127.0f)); C.at<unsigned>(WS_AMAX)[row] = 0u; C.at<unsigned>(WS_AMAX2)[row] = 0u; }
    }
    const int* pos = (const int*)C.in[1]; float* rc = C.at<float>(WS_ROPEC); float* rs = C.at<float>(WS_ROPES);
    for (int i = C.wg * NTHREADS + tid; i < MTOK * 32; i += C.G * NTHREADS) {
        const int m = i >> 5, j = i & 31;
        const float inv = 1.0f / powf(10000.0f, (float)(2 * j) * (1.0f / 64.0f));
        const float ang = (float)pos[m] * inv;
        const double ad = (double)ang; const double n = rint(ad * 0.15915494309189535); const float red = (float)(ad - n * 6.283185307179586);
        rc[i] = cosf(red); rs[i] = sinf(red);
    }
}

__device__ __forceinline__ void rstd_pass(const Ctx& C) {
    const int tid = opaque_tid();
    const float* part = C.at<float>(WS_PARTH); float* rstd = C.at<float>(WS_RSTD);
    for (int row = C.wg * 128 + (tid >> 2); row < MTOK; row += C.G * 128) {
        const float* p = part + (size_t)row * 32 + (tid & 3) * 8;
        const f32x4 a = *(const f32x4*)p, b = *(const f32x4*)(p + 4);
        float sm = ((a[0] + a[1]) + (a[2] + a[3])) + ((b[0] + b[1]) + (b[2] + b[3]));
        sm += dpp_mov<0xB1>(sm); sm += dpp_mov<0x4E>(sm);
        if ((tid & 3) == 0) rstd[row] = rsqrtf(sm * (1.0f / DM) + RMS_EPS);
    }
}

__device__ __forceinline__ void quant_pass(const Ctx& C) {
    const int tid = opaque_tid(), lane = tid & 63, wv = tid >> 6;
    const bf16_t* hb = C.at<bf16_t>(WS_HB); unsigned char* h8 = C.at<unsigned char>(WS_H8); float* rsa = C.at<float>(WS_RSA);
    for (int row0 = (C.wg * 8 + wv) * 2; row0 < MTOK; row0 += C.G * 16) {
        u32x4 w[2][4];
#pragma unroll
        for (int r = 0; r < 2; ++r)
#pragma unroll
            for (int i = 0; i < 4; ++i) w[r][i] = __builtin_nontemporal_load((const u32x4*)(hb + (size_t)(row0 + r) * DM + (i * 64 + lane) * 8));
#pragma unroll
        for (int r = 0; r < 2; ++r) {
            float v[4][8]; float s = 0.f, mx = 0.f;
#pragma unroll
            for (int i = 0; i < 4; ++i) {
                v[i][0] = __uint_as_float(w[r][i].x << 16); v[i][1] = __uint_as_float(w[r][i].x & 0xffff0000u); v[i][2] = __uint_as_float(w[r][i].y << 16); v[i][3] = __uint_as_float(w[r][i].y & 0xffff0000u);
                v[i][4] = __uint_as_float(w[r][i].z << 16); v[i][5] = __uint_as_float(w[r][i].z & 0xffff0000u); v[i][6] = __uint_as_float(w[r][i].w << 16); v[i][7] = __uint_as_float(w[r][i].w & 0xffff0000u);
#pragma unroll
                for (int e = 0; e < 8; ++e) { s += v[i][e] * v[i][e]; mx = fmaxf(mx, __builtin_fabsf(v[i][e])); }
            }
            s = wave_sum_fast(s);
#pragma unroll
            for (int o = 32; o >= 1; o >>= 1) mx = fmaxf(mx, __shfl_xor(mx, o));
            const float qs = mx > 0.f ? 127.0f / mx : 0.f;
#pragma unroll
            for (int i = 0; i < 4; ++i) { u32x2 q; q.x = pk4_i8(v[i][0] * qs, v[i][1] * qs, v[i][2] * qs, v[i][3] * qs); q.y = pk4_i8(v[i][4] * qs, v[i][5] * qs, v[i][6] * qs, v[i][7] * qs);
                *(u32x2*)(h8 + (size_t)(row0 + r) * DM + (i * 64 + lane) * 8) = q; }
            if (lane == 0) rsa[row0 + r] = rsqrtf(s * (1.0f / DM) + RMS_EPS) * (mx * (1.0f / 127.0f));
        }
    }
}

__device__ __forceinline__ void actq_pass(const Ctx& C, size_t amax_off, size_t amax_other, const float* wmax) {
    const int tid = opaque_tid(), lane = tid & 63, wv = tid >> 6, pc = lane & 3;
    const bf16_t* act = C.at<bf16_t>(WS_ACT); unsigned char* a8 = C.at<unsigned char>(WS_ACT8);
    for (int item = C.wg; item < (MTOK / 256) * 2; item += C.G) {
        const int pm = item >> 1, hk = item & 1;
        int rr[2]; float qs[2];
#pragma unroll
        for (int sg = 0; sg < 2; ++sg) {
            rr[sg] = wv * 32 + sg * 16 + (lane >> 2); const int row = pm * 256 + rr[sg];
            const float mx = __uint_as_float(C.at<unsigned>(amax_off)[row]);
            qs[sg] = mx > 0.f ? 127.0f / mx : 0.f;
            if (hk == 0 && pc == 0) {
                const float rs = C.at<float>(WS_RSA)[row] * (*wmax * (1.0f / 127.0f));
                C.at<float>(WS_ASC)[row] = mx * (1.0f / 127.0f) * (rs * rs * 0.35355339059327373f); C.at<unsigned>(amax_other)[row] = 0u; }
        }
#pragma nounroll
        for (int kt0 = hk * (DFF / 128); kt0 < (hk + 1) * (DFF / 128); kt0 += 4) {
            u32x4 w[4][2][2];
#pragma unroll
            for (int t = 0; t < 4; ++t)
#pragma unroll
                for (int jh = 0; jh < 2; ++jh)
#pragma unroll
                    for (int sg = 0; sg < 2; ++sg) w[t][jh][sg] = __builtin_nontemporal_load((const u32x4*)(act + ((((size_t)pm * (DFF / 64) + kt0 + t) * 2 + jh) * 256 + rr[sg]) * 32 + pc * 8));
#pragma unroll
            for (int t = 0; t < 4; ++t) {
                const int kt = kt0 + t;
                unsigned char* blk = a8 + (((size_t)pm * (DFF / 128) + (kt >> 1)) * 2 + (kt & 1)) * (256 * 64);
#pragma unroll
                for (int sg = 0; sg < 2; ++sg)
#pragma unroll
                    for (int jh = 0; jh < 2; ++jh) {
                        const u32x4 x = w[t][jh][sg]; const float q = qs[sg];
                        u32x2 o;
                        o.x = pk4_i8(__uint_as_float(x.x << 16) * q, __uint_as_float(x.x & 0xffff0000u) * q, __uint_as_float(x.y << 16) * q, __uint_as_float(x.y & 0xffff0000u) * q);
                        o.y = pk4_i8(__uint_as_float(x.z << 16) * q, __uint_as_float(x.z & 0xffff0000u) * q, __uint_as_float(x.w << 16) * q, __uint_as_float(x.w & 0xffff0000u) * q);
                        *(u32x2*)(blk + rr[sg] * 64 + jh * 32 + pc * 8) = o;
                    }
            }
        }
    }
}

__device__ __forceinline__ void prep_phase(const Ctx& C, int l) {
    const int tid = opaque_tid(), lane = tid & 63, wv = __builtin_amdgcn_readfirstlane(tid >> 6);
    const bf16_t* P = C.at<bf16_t>(WS_P);
    LAS bf16_t* Lin = (LAS bf16_t*)C.lds;
    LAS float* Lout = (LAS float*)(C.lds + 8192);
    const float* mu = C.fin(13) + l * 1696;
    const int c = tid;
    const float w0 = C.fin(14)[l * BW + c], a0 = C.fin(16)[l * BW + c], kkc = C.fin(19)[l * BW + c], kac = C.fin(20)[l * BW + c];
    const float mur = mu[c], muk = mu[512 + c], muv = mu[1024 + c];
    const float rkc = C.fin(21)[l * BW + c];
    const float cw0 = C.fin(24)[l * 1536 + c], cw1 = C.fin(24)[l * 1536 + 512 + c], cw2 = C.fin(24)[l * 1536 + 1024 + c], gn = C.fin(25)[l * BW + c];
    const int n = lane & 15, kg = lane >> 4;
#pragma nounroll
    for (int item = C.wg; item < MTOK / 16; item += C.G) {
        const int tid = opaque_tid(), lane = tid & 63, c = tid, n = lane & 15, kg = lane >> 4;
        const int b = item >> 7, t0 = (item & 127) * 16;
        const size_t m0 = (size_t)b * SEQ + t0;
        bf16x8 bfr[4][5];
        {
            const bf16_t* Ub = C.at<bf16_t>(WS_LORA) + (size_t)(wv * 64 + n) * 160 + kg * 8;
#pragma unroll
            for (int nt = 0; nt < 4; ++nt)
#pragma unroll
                for (int ks = 0; ks < 5; ++ks) bfr[nt][ks] = *(const bf16x8*)(Ub + nt * 16 * 160 + ks * 32);
        }
        for (int e = tid; e < 2560; e += NTHREADS) {
            const int tt = e / 160, j = e - tt * 160, col = 2368 + j;
            const float cur = bf2f(P[(m0 + tt) * NINP + col]);
            const float prev = (t0 + tt > 0) ? bf2f(P[(m0 + tt - 1) * NINP + col]) : 0.f;
            float xs = cur + (prev - cur) * mu[1536 + j];
            if (j < 32) xs = tanhf(xs); else if (j >= 64) xs = sigmoid_fast(xs);
            Lin[tt * 168 + j] = f2bf(xs);
        }
        __syncthreads();
        {
            bf16x8 af[5];
#pragma unroll
            for (int ks = 0; ks < 5; ++ks) af[ks] = *(const LAS bf16x8*)(Lin + n * 168 + ks * 32 + kg * 8);
#pragma unroll
            for (int nt = 0; nt < 4; ++nt) {
                const f32x4 z = {0.f, 0.f, 0.f, 0.f};
                const f32x4 cw = __builtin_amdgcn_mfma_f32_16x16x32_bf16(af[0], bfr[nt][0], z, 0, 0, 0);
                const f32x4 ca = __builtin_amdgcn_mfma_f32_16x16x32_bf16(af[1], bfr[nt][1], z, 0, 0, 0);
                f32x4 cg = __builtin_amdgcn_mfma_f32_16x16x32_bf16(af[2], bfr[nt][2], z, 0, 0, 0);
                cg = __builtin_amdgcn_mfma_f32_16x16x32_bf16(af[3], bfr[nt][3], cg, 0, 0, 0);
                cg = __builtin_amdgcn_mfma_f32_16x16x32_bf16(af[4], bfr[nt][4], cg, 0, 0, 0);
                const int ch = wv * 64 + nt * 16 + n;
#pragma unroll
                for (int j = 0; j < 4; ++j) { const int tok = kg * 4 + j;
                    Lout[tok * 512 + ch] = cw[j]; Lout[8192 + tok * 512 + ch] = ca[j]; Lout[16384 + tok * 512 + ch] = cg[j]; }
            }
        }
        __syncthreads();
        unsigned tA[8], tB[8], tK[8], tR[8], tV[8]; float PCv;
        {
            float pr = 0.f, pk = 0.f, pv = 0.f, um2 = 0.f, um1 = 0.f;
            if (t0 > 0) { const bf16_t* pp = P + (m0 - 1) * NINP + c; pr = bf2f(pp[PB0]); pk = bf2f(pp[PB0 + 512]); pv = bf2f(pp[PB0 + 1024]);
                um1 = bf2f(pp[PC0 + 512]) * bf2f(pp[PC0 + 1024]); const bf16_t* p2 = pp - NINP; um2 = bf2f(p2[PC0 + 512]) * bf2f(p2[PC0 + 1024]); }
            bf16_t* Gp = C.at<bf16_t>(WS_G) + m0 * BW + c;
            bf16_t* Bvp = C.at<bf16_t>(WS_BV) + m0 * BW + c;
            bf16_t* Y = C.at<bf16_t>(WS_Y) + m0 * DM + 1536 + c;
            float Pc = 1.0f;
            float sA[2], sB[2], sK[2], sR[2], sV[2];
#pragma unroll
            for (int hb8 = 0; hb8 < 2; ++hb8) {
                bf16_t raw[8][6];
#pragma unroll
                for (int i = 0; i < 8; ++i) { const bf16_t* pp = P + (m0 + hb8 * 8 + i) * NINP + c;
                    raw[i][0] = pp[PB0]; raw[i][1] = pp[PB0 + 512]; raw[i][2] = pp[PB0 + 1024]; raw[i][3] = pp[PC0]; raw[i][4] = pp[PC0 + 512]; raw[i][5] = pp[PC0 + 1024]; }
#pragma unroll
                for (int i = 0; i < 8; ++i) {
                    const int tt = hb8 * 8 + i;
                    const float cr = bf2f(raw[i][0]), ck = bf2f(raw[i][1]), cv = bf2f(raw[i][2]);
                    const float r = cr + (pr - cr) * mur, k = ck + (pk - ck) * muk, v = cv + (pv - cv) * muv;
                    pr = cr; pk = ck; pv = cv;
                    const float decay = __builtin_amdgcn_exp2f(-0.6065306597126334f * 1.4426950408889634f * sigmoid_fast(w0 + Lout[tt * 512 + c]));
                    const float a = sigmoid_fast(a0 + Lout[8192 + tt * 512 + c]);
                    float kk = k * kkc;
                    const float ss = wave_sum_fast(kk * kk);
                    kk = kk * __builtin_amdgcn_rsqf(fmaxf(ss, 1e-24f));
                    const float kmod = k * (1.0f + (a - 1.0f) * kac);
                    const float bonus = wave_sum_fast(r * kmod * rkc);
                    Bvp[(size_t)tt * BW] = f2bf(bonus * v);
                    Gp[(size_t)tt * BW] = f2bf(Lout[16384 + tt * 512 + c]);
                    const float Pprev = Pc; Pc = Pc * decay; const float invP = __builtin_amdgcn_rcpf(Pc);
                    sA[i & 1] = -kk * Pprev; sB[i & 1] = kk * a * invP; sK[i & 1] = kmod * invP; sR[i & 1] = r * Pc; sV[i & 1] = v;
                    if (i & 1) { tA[tt >> 1] = cvt_pk_bf16(sA[0], sA[1]); tB[tt >> 1] = cvt_pk_bf16(sB[0], sB[1]); tK[tt >> 1] = cvt_pk_bf16(sK[0], sK[1]); tR[tt >> 1] = cvt_pk_bf16(sR[0], sR[1]); tV[tt >> 1] = cvt_pk_bf16(sV[0], sV[1]); }
                    const float bg = bf2f(raw[i][3]), u = bf2f(raw[i][4]) * bf2f(raw[i][5]);
                    const float yv = cw0 * um2 + cw1 * um1 + cw2 * u;
                    um2 = um1; um1 = u;
                    const float z = bg * yv;
                    const float s2 = wave_sum_fast(z * z);
                    Y[(size_t)tt * DM] = f2bf(z * __builtin_amdgcn_rsqf(s2 * (1.0f / 64.0f) + RMS_EPS) * gn);
                }
            }
            PCv = Pc;
        }
        {
            const int tt = tid >> 5, i = tid & 31; const size_t m = m0 + tt;
            const unsigned pr2 = *(const unsigned*)(P + m * NINP + 768 + 2 * i);
            const float x1 = __uint_as_float(pr2 << 16), x2 = __uint_as_float(pr2 & 0xffff0000u);
            const float cs = C.at<float>(WS_ROPEC)[m * 32 + i], sn = C.at<float>(WS_ROPES)[m * 32 + i];
            *(unsigned*)(C.at<bf16_t>(WS_KR) + m * 64 + 2 * i) = cvt_pk_bf16(x1 * cs - x2 * sn, x1 * sn + x2 * cs);
        }
        __syncthreads();
        {
            LAS unsigned char* HB = C.lds + 8192 + wv * 16384;
            LAS bf16_t* tl = (LAS bf16_t*)HB;
            LAS float* mats = (LAS float*)(HB + 8192);
#pragma unroll
            for (int p2 = 0; p2 < 8; ++p2) {
                tl[(2 * p2) * 64 + lane] = (bf16_t)(tA[p2] & 0xffffu); tl[(2 * p2 + 1) * 64 + lane] = (bf16_t)(tA[p2] >> 16);
                tl[1024 + (2 * p2) * 64 + lane] = (bf16_t)(tB[p2] & 0xffffu); tl[1024 + (2 * p2 + 1) * 64 + lane] = (bf16_t)(tB[p2] >> 16);
                tl[2048 + (2 * p2) * 64 + lane] = (bf16_t)(tK[p2] & 0xffffu); tl[2048 + (2 * p2 + 1) * 64 + lane] = (bf16_t)(tK[p2] >> 16);
                tl[3072 + (2 * p2) * 64 + lane] = (bf16_t)(tR[p2] & 0xffffu); tl[3072 + (2 * p2 + 1) * 64 + lane] = (bf16_t)(tR[p2] >> 16);
            }
            {
                bf16x8 fa[2], fb[2], fk[2], fr[2];
#pragma unroll
                for (int ks = 0; ks < 2; ++ks) { const int o = n * 64 + ks * 32 + kg * 8;
                    fa[ks] = *(const LAS bf16x8*)(tl + o); fb[ks] = *(const LAS bf16x8*)(tl + 1024 + o); fk[ks] = *(const LAS bf16x8*)(tl + 2048 + o); fr[ks] = *(const LAS bf16x8*)(tl + 3072 + o); }
                const f32x4 z = {0.f, 0.f, 0.f, 0.f};
                f32x4 gN = __builtin_amdgcn_mfma_f32_16x16x32_bf16(fb[0], fa[0], z, 0, 0, 0); gN = __builtin_amdgcn_mfma_f32_16x16x32_bf16(fb[1], fa[1], gN, 0, 0, 0);
                f32x4 gM = __builtin_amdgcn_mfma_f32_16x16x32_bf16(fk[0], fa[0], z, 0, 0, 0); gM = __builtin_amdgcn_mfma_f32_16x16x32_bf16(fk[1], fa[1], gM, 0, 0, 0);
                f32x4 gB = __builtin_amdgcn_mfma_f32_16x16x32_bf16(fb[0], fr[0], z, 0, 0, 0); gB = __builtin_amdgcn_mfma_f32_16x16x32_bf16(fb[1], fr[1], gB, 0, 0, 0);
                f32x4 gK = __builtin_amdgcn_mfma_f32_16x16x32_bf16(fk[0], fr[0], z, 0, 0, 0); gK = __builtin_amdgcn_mfma_f32_16x16x32_bf16(fk[1], fr[1], gK, 0, 0, 0);
#pragma unroll
                for (int j = 0; j < 4; ++j) { const int i = 4 * kg + j; if (!(i < n)) { gN[j] = 0.f; gM[j] = 0.f; } if (!(i <= n)) { gB[j] = 0.f; gK[j] = 0.f; } }
                *(LAS f32x4*)(mats + n * 16 + 4 * kg) = gN; *(LAS f32x4*)(mats + 256 + n * 16 + 4 * kg) = gM;
                *(LAS f32x4*)(mats + 512 + n * 16 + 4 * kg) = gB; *(LAS f32x4*)(mats + 768 + n * 16 + 4 * kg) = gK;
            }
            float Tr[16], TEr[16];
#pragma unroll
            for (int t = 0; t < 16; ++t) {
                float nr[16];
#pragma unroll
                for (int q4 = 0; q4 < 4; ++q4) { const f32x4 x = *(const LAS f32x4*)(mats + t * 16 + 4 * q4); nr[4 * q4] = x[0]; nr[4 * q4 + 1] = x[1]; nr[4 * q4 + 2] = x[2]; nr[4 * q4 + 3] = x[3]; }
                float acc = (n == t) ? 1.0f : 0.0f;
#pragma unroll
                for (int s2 = 0; s2 < t; ++s2) acc += Tr[s2] * nr[s2];
                Tr[t] = acc;
                asm volatile("" ::: "memory");
            }
#pragma unroll
            for (int t = 0; t < 16; ++t) {
                float er[16];
#pragma unroll
                for (int q4 = 0; q4 < 4; ++q4) { const f32x4 x = *(const LAS f32x4*)(mats + 512 + t * 16 + 4 * q4); er[4 * q4] = x[0]; er[4 * q4 + 1] = x[1]; er[4 * q4 + 2] = x[2]; er[4 * q4 + 3] = x[3]; }
                float acc = 0.f;
#pragma unroll
                for (int s2 = 0; s2 <= t; ++s2) acc += Tr[s2] * er[s2];
                TEr[t] = acc;
                asm volatile("" ::: "memory");
            }
            LAS float* Tt = mats + 1024; LAS float* TEt = mats + 1280;
#pragma unroll
            for (int t = 0; t < 16; ++t) { Tt[t * 16 + n] = Tr[t]; TEt[t * 16 + n] = TEr[t]; }
            float Mr[16];
#pragma unroll
            for (int s2 = 0; s2 < 16; ++s2) Mr[s2] = mats[256 + s2 * 16 + n];
            unsigned char* CBg = C.ws + WS_SCAN + ((size_t)(b * 8 + wv) * (SEQ / 16) + (t0 >> 4)) * CB_BYTES;
            bf16_t* WAg = (bf16_t*)(CBg + CB_WA); bf16_t* QAg = (bf16_t*)(CBg + CB_QA); bf16_t* MTg = (bf16_t*)(CBg + CB_MT); bf16_t* Q2g = (bf16_t*)(CBg + CB_Q2);
            const int wks = lane >> 5, wq = (lane >> 2) & 3, we = 4 * ((lane >> 4) & 1) + (lane & 3);
#pragma unroll
            for (int t = 0; t < 16; ++t) {
                float trw[16], tew[16];
#pragma unroll
                for (int q4 = 0; q4 < 4; ++q4) { const f32x4 x = *(const LAS f32x4*)(Tt + t * 16 + 4 * q4), y = *(const LAS f32x4*)(TEt + t * 16 + 4 * q4);
                    trw[4 * q4] = x[0]; trw[4 * q4 + 1] = x[1]; trw[4 * q4 + 2] = x[2]; trw[4 * q4 + 3] = x[3]; tew[4 * q4] = y[0]; tew[4 * q4 + 1] = y[1]; tew[4 * q4 + 2] = y[2]; tew[4 * q4 + 3] = y[3]; }
                float w1 = 0.f, q1 = (t & 1) ? __uint_as_float(tR[t >> 1] & 0xffff0000u) : __uint_as_float(tR[t >> 1] << 16), mtv = 0.f, q2v = mats[768 + t * 16 + n];
#pragma unroll
                for (int s2 = 0; s2 <= t; ++s2) { const float as = (s2 & 1) ? __uint_as_float(tA[s2 >> 1] & 0xffff0000u) : __uint_as_float(tA[s2 >> 1] << 16);
                    w1 += as * trw[s2]; q1 += as * tew[s2]; mtv += Mr[s2] * trw[s2]; q2v += Mr[s2] * tew[s2]; }
                const int wi = ((wks * 16 + t) * 4 + wq) * 8 + we;
                WAg[wi] = f2bf(w1); QAg[wi] = f2bf(q1);
                if (lane < 16) { MTg[t * 16 + lane] = f2bf(mtv); Q2g[t * 16 + lane] = f2bf(q2v); }
                asm volatile("" ::: "memory");
            }
            {
                u32x4* BKg = (u32x4*)(CBg + CB_BK + lane * 64);
#pragma unroll
                for (int g4 = 0; g4 < 4; ++g4) {
                    const float b0 = __uint_as_float(tB[2 * g4] << 16) * PCv, b1 = __uint_as_float(tB[2 * g4] & 0xffff0000u) * PCv, b2 = __uint_as_float(tB[2 * g4 + 1] << 16) * PCv, b3 = __uint_as_float(tB[2 * g4 + 1] & 0xffff0000u) * PCv;
                    const float k0 = __uint_as_float(tK[2 * g4] << 16) * PCv, k1 = __uint_as_float(tK[2 * g4] & 0xffff0000u) * PCv, k2 = __uint_as_float(tK[2 * g4 + 1] << 16) * PCv, k3 = __uint_as_float(tK[2 * g4 + 1] & 0xffff0000u) * PCv;
                    u32x4 w; w.x = cvt_pk_bf16(b0, b1); w.y = cvt_pk_bf16(b2, b3); w.z = cvt_pk_bf16(k0, k1); w.w = cvt_pk_bf16(k2, k3);
                    BKg[g4] = w;
                }
                ((float*)(CBg + CB_PC))[lane] = PCv;
                u32x4* VTg = (u32x4*)(CBg + CB_VT + lane * 32);
                VTg[0] = (u32x4){tV[0], tV[1], tV[2], tV[3]}; VTg[1] = (u32x4){tV[4], tV[5], tV[6], tV[7]};
            }
        }
        __syncthreads();
    }
}

constexpr int SC_GRP = 2, SC_STG = SC_GRP * CB_BYTES;
constexpr int SC_YB = SC_GRP * 16 * 64;
struct ScanPostConst { f32x4 gain0, gain1, bias0, bias1; };
struct ScanPostIn { u32x4 bw, gw; };
__device__ __forceinline__ ScanPostIn scan_post_load(const bf16_t* Bvp, const bf16_t* Gp, size_t tok0, int tl0, int lane) {
    const int tl = tl0 + (lane >> 3), q = lane & 7; const size_t tok = tok0 + tl; ScanPostIn r;
    r.bw = *(const u32x4*)(Bvp + tok * BW + q * 8); r.gw = *(const u32x4*)(Gp + tok * BW + q * 8);
    return r;
}
__device__ __forceinline__ f32x4 bf4_lo(const u32x4& w) { return (f32x4){__uint_as_float(w.x << 16), __uint_as_float(w.x & 0xffff0000u), __uint_as_float(w.y << 16), __uint_as_float(w.y & 0xffff0000u)}; }
__device__ __forceinline__ f32x4 bf4_hi(const u32x4& w) { return (f32x4){__uint_as_float(w.z << 16), __uint_as_float(w.z & 0xffff0000u), __uint_as_float(w.w << 16), __uint_as_float(w.w & 0xffff0000u)}; }
__device__ __forceinline__ void scan_post(LAS float* yb, const ScanPostIn& I, bf16_t* Yp, size_t tok0, int tl0, int lane, const ScanPostConst& K) {
    const int tl = tl0 + (lane >> 3), q = lane & 7; const size_t tok = tok0 + tl;
    const f32x4 y0 = *(const LAS f32x4*)(yb + tl * 64 + q * 8), y1 = *(const LAS f32x4*)(yb + tl * 64 + q * 8 + 4);
    const f32x4 ys = y0 + y1;
    const float mean = red8((ys[0] + ys[1]) + (ys[2] + ys[3])) * (1.0f / 64.0f);
    const f32x4 d0 = y0 - mean, d1 = y1 - mean;
    const f32x4 dq = d0 * d0 + d1 * d1;
    const float var = red8((dq[0] + dq[1]) + (dq[2] + dq[3])) * (1.0f / 64.0f);
    const float rstd = __builtin_amdgcn_rsqf(var + 64e-5f);
    const f32x4 o0 = (d0 * rstd * K.gain0 + K.bias0 + bf4_lo(I.bw)) * bf4_lo(I.gw), o1 = (d1 * rstd * K.gain1 + K.bias1 + bf4_hi(I.bw)) * bf4_hi(I.gw);
    u32x4 w; w.x = cvt_pk_bf16(o0[0], o0[1]); w.y = cvt_pk_bf16(o0[2], o0[3]); w.z = cvt_pk_bf16(o1[0], o1[1]); w.w = cvt_pk_bf16(o1[2], o1[3]);
    *(u32x4*)(Yp + tok * DM + q * 8) = w;
}
__device__ __forceinline__ void scan_unit(const Ctx& C, int l, int bh) {
    const int tid = opaque_tid(), lane = tid & 63, wv = __builtin_amdgcn_readfirstlane(tid >> 6);
    LAS unsigned char* stg = C.lds;
    LAS float* ybuf = (LAS float*)(C.lds + 2 * SC_STG);
    const unsigned char* src = C.ws + WS_SCAN + (size_t)bh * (SEQ / 16) * CB_BYTES;
    const int b = bh >> 3, h = bh & 7;
    constexpr int NGRP = SEQ / 16 / SC_GRP;
    for (int i = tid; i < SC_STG / 16; i += NTHREADS) *(LAS u32x4*)(stg + i * 16) = *(const u32x4*)(src + (size_t)i * 16);
    __syncthreads();
    if (wv < 4) {
        const int vq = lane & 15, q = lane >> 4;
        f32x4 S[4];
#pragma unroll
        for (int m = 0; m < 4; ++m) S[m] = (f32x4){0.f, 0.f, 0.f, 0.f};
        const bf16x8 zf = {0, 0, 0, 0, 0, 0, 0, 0};
#pragma nounroll
        for (int g = 0; g < NGRP; ++g) {
            LAS unsigned char* sb = stg + (g & 1) * SC_STG;
            LAS float* yb = ybuf + (g & 1) * SC_YB;
#pragma unroll
            for (int cc = 0; cc < SC_GRP; ++cc) {
                LAS unsigned char* cb = sb + cc * CB_BYTES;
                const bf16x8 wa0 = *(const LAS bf16x8*)(cb + CB_WA + ((0 * 16 + vq) * 4 + q) * 16), wa1 = *(const LAS bf16x8*)(cb + CB_WA + ((1 * 16 + vq) * 4 + q) * 16);
                const bf16x8 qa0 = *(const LAS bf16x8*)(cb + CB_QA + ((0 * 16 + vq) * 4 + q) * 16), qa1 = *(const LAS bf16x8*)(cb + CB_QA + ((1 * 16 + vq) * 4 + q) * 16);
                const int qc = q & 1;
                bf16x8 mtf = *(const LAS bf16x8*)(cb + CB_MT + vq * 32 + qc * 16), q2f = *(const LAS bf16x8*)(cb + CB_Q2 + vq * 32 + qc * 16);
                bf16x8 bvf = *(const LAS bf16x8*)(cb + CB_VT + (16 * wv + vq) * 32 + qc * 16);
                if (q >= 2) { mtf = zf; q2f = zf; bvf = zf; }
                const u32x2 vpart = *(const LAS u32x2*)(cb + CB_VT + (16 * wv + vq) * 32 + q * 8);
                bf16x8 bk[4]; f32x4 pc[4];
#pragma unroll
                for (int m = 0; m < 4; ++m) { bk[m] = *(const LAS bf16x8*)(cb + CB_BK + ((16 * m + vq) * 4 + q) * 16); pc[m] = *(const LAS f32x4*)(cb + CB_PC + (16 * m + 4 * q) * 4); }
                bf16x8 bh[2], bl[2];
#pragma unroll
                for (int ks = 0; ks < 2; ++ks) {
                    const f32x4 s0 = S[2 * ks], s1 = S[2 * ks + 1];
                    u32x4 hp; hp.x = cvt_pk_bf16(s0[0], s0[1]); hp.y = cvt_pk_bf16(s0[2], s0[3]); hp.z = cvt_pk_bf16(s1[0], s1[1]); hp.w = cvt_pk_bf16(s1[2], s1[3]);
                    const float l0 = s0[0] - __uint_as_float(hp.x << 16), l1 = s0[1] - __uint_as_float(hp.x & 0xffff0000u), l2 = s0[2] - __uint_as_float(hp.y << 16), l3 = s0[3] - __uint_as_float(hp.y & 0xffff0000u);
                    const float l4 = s1[0] - __uint_as_float(hp.z << 16), l5 = s1[1] - __uint_as_float(hp.z & 0xffff0000u), l6 = s1[2] - __uint_as_float(hp.w << 16), l7 = s1[3] - __uint_as_float(hp.w & 0xffff0000u);
                    u32x4 lp; lp.x = cvt_pk_bf16(l0, l1); lp.y = cvt_pk_bf16(l2, l3); lp.z = cvt_pk_bf16(l4, l5); lp.w = cvt_pk_bf16(l6, l7);
                    bh[ks] = __builtin_bit_cast(bf16x8, hp); bl[ks] = __builtin_bit_cast(bf16x8, lp);
                }
                const f32x4 z = {0.f, 0.f, 0.f, 0.f};
                f32x4 U = __builtin_amdgcn_mfma_f32_16x16x32_bf16(mtf, bvf, z, 0, 0, 0);
                U = __builtin_amdgcn_mfma_f32_16x16x32_bf16(wa0, bl[0], U, 0, 0, 0); U = __builtin_amdgcn_mfma_f32_16x16x32_bf16(wa1, bl[1], U, 0, 0, 0);
                U = __builtin_amdgcn_mfma_f32_16x16x32_bf16(wa0, bh[0], U, 0, 0, 0); U = __builtin_amdgcn_mfma_f32_16x16x32_bf16(wa1, bh[1], U, 0, 0, 0);
                f32x4 Yt = __builtin_amdgcn_mfma_f32_16x16x32_bf16(q2f, bvf, z, 0, 0, 0);
                Yt = __builtin_amdgcn_mfma_f32_16x16x32_bf16(qa0, bl[0], Yt, 0, 0, 0); Yt = __builtin_amdgcn_mfma_f32_16x16x32_bf16(qa1, bl[1], Yt, 0, 0, 0);
                Yt = __builtin_amdgcn_mfma_f32_16x16x32_bf16(qa0, bh[0], Yt, 0, 0, 0); Yt = __builtin_amdgcn_mfma_f32_16x16x32_bf16(qa1, bh[1], Yt, 0, 0, 0);
                u32x4 up; up.x = cvt_pk_bf16(U[0], U[1]); up.y = cvt_pk_bf16(U[2], U[3]); up.z = vpart.x; up.w = vpart.y;
                const bf16x8 bu = __builtin_bit_cast(bf16x8, up);
#pragma unroll
                for (int m = 0; m < 4; ++m) S[m] = __builtin_amdgcn_mfma_f32_16x16x32_bf16(bk[m], bu, S[m] * pc[m], 0, 0, 0);
#pragma unroll
                for (int j = 0; j < 4; ++j) yb[(cc * 16 + 4 * q + j) * 64 + 16 * wv + vq] = Yt[j];
            }
            __syncthreads();
        }
    } else {
        const int hw = wv - 4, ht = tid - 256;
        ScanPostConst PC;
        { const int o = l * BW + h * 64 + (lane & 7) * 8;
          PC.gain0 = *(const f32x4*)(C.fin(22) + o); PC.gain1 = *(const f32x4*)(C.fin(22) + o + 4); PC.bias0 = *(const f32x4*)(C.fin(23) + o); PC.bias1 = *(const f32x4*)(C.fin(23) + o + 4); }
        const bf16_t* Gp = C.at<bf16_t>(WS_G) + (size_t)b * SEQ * BW + h * 64;
        const bf16_t* Bvp = C.at<bf16_t>(WS_BV) + (size_t)b * SEQ * BW + h * 64;
        bf16_t* Yp = C.at<bf16_t>(WS_Y) + (size_t)b * SEQ * DM + 1024 + h * 64;
        constexpr int NL = (SC_STG / 16 + 255) / 256;
        u32x4 tmp[4][NL]; ScanPostIn pin[4];
#define SCH_LOAD(gg, set) do { if ((gg) < NGRP) { const unsigned char* s2_ = src + (size_t)(gg) * SC_STG; \
            _Pragma("unroll") for (int i = 0; i < NL; ++i) { const int o_ = (ht + 256 * i) * 16; if (o_ < SC_STG) tmp[set][i] = *(const u32x4*)(s2_ + o_); } } } while (0)
#define SCH_STORE(gg, set) do { if ((gg) < NGRP) { LAS unsigned char* d2_ = stg + ((gg) & 1) * SC_STG; \
            _Pragma("unroll") for (int i = 0; i < NL; ++i) { const int o_ = (ht + 256 * i) * 16; if (o_ < SC_STG) *(LAS u32x4*)(d2_ + o_) = tmp[set][i]; } } } while (0)
#define SCH_PLOAD(gg, set) do { if ((gg) < NGRP) pin[set] = scan_post_load(Bvp, Gp, (size_t)(gg) * (SC_GRP * 16), hw * 8, lane); } while (0)
#define SCH_POST(gg, set) do { if ((gg) >= 0) scan_post(ybuf + ((gg) & 1) * SC_YB, pin[set], Yp, (size_t)(gg) * (SC_GRP * 16), hw * 8, lane, PC); } while (0)
#define SCH_ITER(g_, k) do { SCH_STORE((g_) + 1, ((k) + 1) & 3); SCH_LOAD((g_) + 4, (k)); SCH_PLOAD((g_) + 2, ((k) + 2) & 3); SCH_POST((g_) - 1, ((k) + 3) & 3); __syncthreads(); } while (0)
        SCH_LOAD(1, 1); SCH_LOAD(2, 2); SCH_LOAD(3, 3); SCH_PLOAD(0, 0); SCH_PLOAD(1, 1);
#pragma nounroll
        for (int g = 0; g < NGRP; g += 4) { SCH_ITER(g, 0); SCH_ITER(g + 1, 1); SCH_ITER(g + 2, 2); SCH_ITER(g + 3, 3); }
        SCH_POST(NGRP - 1, (NGRP - 1) & 3);
#undef SCH_LOAD
#undef SCH_STORE
#undef SCH_PLOAD
#undef SCH_POST
#undef SCH_ITER
    }
    __syncthreads();
}

constexpr int KSTR = 400, VSTR = 320;
constexpr int KBUF = 64 * KSTR, VBUF = 64 * VSTR;
constexpr int ASTG = KBUF + VBUF;
struct AttnDma { unsigned off[6]; unsigned strd[6]; };
__device__ __forceinline__ void attn_dma_init(AttnDma& D, size_t tk, int h, int w, int lane) {
#pragma unroll
    for (int i = 0; i < 6; ++i) {
        const int wi = w + 8 * i, ci = wi * 64 + lane; size_t off; unsigned st = 64u * NKV * 2u;
        if (ci < 1600) { const int r = ci / 25, ch = ci - r * 25;
            if (ch < 16) off = ((tk + r) * NKV + h * 256 + ch * 8) * 2;
            else if (ch < 24) { off = (size_t)MTOK * NKV * 2 + ((tk + r) * 64 + (ch - 16) * 8) * 2; st = 64u * 64u * 2u; }
            else off = ((tk + r) * NKV + h * 256) * 2; }
        else { const int cv = ci - 1600, r = cv / 20, ch = cv - r * 20;
            off = ((tk + r) * NKV + h * 256 + 128 + (ch < 16 ? ch : 0) * 8) * 2; }
        D.off[i] = (unsigned)off; D.strd[i] = st;
    }
}
__device__ __forceinline__ void attn_dma_issue(LAS unsigned char* lds, const bf16_t* KV, AttnDma& D, int stg, int w) {
    const char* kvb = (const char*)KV;
#pragma unroll
    for (int i = 0; i < 6; ++i) {
        const int wi = w + 8 * i;
        if (wi < 45) __builtin_amdgcn_global_load_lds((const unsigned*)(kvb + D.off[i]), (LAS unsigned*)(lds + stg * ASTG + wi * 1024), 16, 0, 0);
        D.off[i] += D.strd[i];
    }
}
template <int CUR>
__device__ __forceinline__ void attn_tile(LAS unsigned char* lds, const bf16_t* KV, AttnDma& dma, int j, int ntiles, int mytiles, int w, int hh, int qi, int kaddr, int vaddr,
                                          const bf16x8 (&qf)[12], f32x16 (&o)[4], float& mrun, float& lrun) {
    if (j + 1 < ntiles) attn_dma_issue(lds, KV, dma, CUR ^ 1, w);
    if (j < mytiles) {
        f32x16 sc[2];
#pragma unroll
        for (int kb = 0; kb < 2; ++kb) {
#pragma unroll
            for (int i = 0; i < 16; ++i) sc[kb][i] = 0.f;
#pragma unroll
            for (int s = 0; s < 12; ++s) {
                const bf16x8 a = *(const LAS bf16x8*)(lds + CUR * ASTG + kaddr + kb * 32 * KSTR + s * 32);
                sc[kb] = __builtin_amdgcn_mfma_f32_32x32x16_bf16(a, qf[s], sc[kb], 0, 0, 0);
            }
        }
        if (j == mytiles - 1) {
#pragma unroll
            for (int kb = 0; kb < 2; ++kb)
#pragma unroll
                for (int i = 0; i < 16; ++i) { const int key = j * 64 + kb * 32 + (i & 3) + 8 * (i >> 2) + 4 * hh; if (key > qi) sc[kb][i] = -INFINITY; }
        }
        float mx = sc[0][0];
#pragma unroll
        for (int kb = 0; kb < 2; ++kb)
#pragma unroll
            for (int i = 0; i < 16; ++i) mx = fmaxf(mx, sc[kb][i]);
        mx = fmaxf(mx, __shfl_xor(mx, 32));
        const bool bump = mx > mrun + 8.0f;
        const float mnew = bump ? mx : mrun;
        if (__builtin_amdgcn_ballot_w64(bump) != 0ull) {
            const float alpha = __builtin_amdgcn_exp2f(mrun - mnew);
            lrun *= alpha;
#pragma unroll
            for (int d = 0; d < 4; ++d)
#pragma unroll
                for (int i = 0; i < 16; ++i) o[d][i] *= alpha;
        }
        mrun = mnew;
        f32x2 ps2 = {0.f, 0.f}; const f32x2 mn2 = {mnew, mnew};
#pragma unroll
        for (int kb = 0; kb < 2; ++kb)
#pragma unroll
            for (int i = 0; i < 16; i += 2) { const f32x2 dlt = (f32x2){sc[kb][i], sc[kb][i + 1]} - mn2; f32x2 p; p.x = __builtin_amdgcn_exp2f(dlt.x); p.y = __builtin_amdgcn_exp2f(dlt.y); sc[kb][i] = p.x; sc[kb][i + 1] = p.y; ps2 += p; }
        lrun += ps2.x + ps2.y;
        bf16x8 pfr[4];
#pragma unroll
        for (int g = 0; g < 4; ++g) { const int kb = g >> 1, s2 = g & 1;
            u32x4 pk; pk.x = cvt_pk_bf16(sc[kb][8 * s2 + 0], sc[kb][8 * s2 + 1]); pk.y = cvt_pk_bf16(sc[kb][8 * s2 + 2], sc[kb][8 * s2 + 3]);
            pk.z = cvt_pk_bf16(sc[kb][8 * s2 + 4], sc[kb][8 * s2 + 5]); pk.w = cvt_pk_bf16(sc[kb][8 * s2 + 6], sc[kb][8 * s2 + 7]);
            pfr[g] = __builtin_bit_cast(bf16x8, pk); }
        const unsigned vb = (unsigned)(size_t)(lds + CUR * ASTG) + (unsigned)vaddr;
        s16x4 RA[8], RB[8];
#define ATT_TR8(R, G) asm volatile("ds_read_b64_tr_b16 %0, %8 offset:%9\n\tds_read_b64_tr_b16 %1, %8 offset:%10\n\tds_read_b64_tr_b16 %2, %8 offset:%11\n\tds_read_b64_tr_b16 %3, %8 offset:%12\n\t" \
                                   "ds_read_b64_tr_b16 %4, %8 offset:%13\n\tds_read_b64_tr_b16 %5, %8 offset:%14\n\tds_read_b64_tr_b16 %6, %8 offset:%15\n\tds_read_b64_tr_b16 %7, %8 offset:%16" \
            : "=&v"(R[0]), "=&v"(R[1]), "=&v"(R[2]), "=&v"(R[3]), "=&v"(R[4]), "=&v"(R[5]), "=&v"(R[6]), "=&v"(R[7]) \
            : "v"(vb), "n"((G) * 16 * VSTR), "n"((G) * 16 * VSTR + 8 * VSTR), "n"((G) * 16 * VSTR + 64), "n"((G) * 16 * VSTR + 64 + 8 * VSTR), \
              "n"((G) * 16 * VSTR + 128), "n"((G) * 16 * VSTR + 128 + 8 * VSTR), "n"((G) * 16 * VSTR + 192), "n"((G) * 16 * VSTR + 192 + 8 * VSTR))
#define ATT_TRWAIT(R, N) asm volatile("s_waitcnt lgkmcnt(" #N ")" : "+v"(R[0]), "+v"(R[1]), "+v"(R[2]), "+v"(R[3]), "+v"(R[4]), "+v"(R[5]), "+v"(R[6]), "+v"(R[7]))
#define ATT_PV(R, G) do { _Pragma("unroll") for (int d = 0; d < 4; ++d) { const bf16x8 vf = __builtin_shufflevector(R[2 * d], R[2 * d + 1], 0, 1, 2, 3, 4, 5, 6, 7); \
            o[d] = __builtin_amdgcn_mfma_f32_32x32x16_bf16(vf, pfr[G], o[d], 0, 0, 0); } } while (0)
        ATT_TR8(RA, 0);
        ATT_TR8(RB, 1); ATT_TRWAIT(RA, 8); ATT_PV(RA, 0);
        ATT_TR8(RA, 2); ATT_TRWAIT(RB, 8); ATT_PV(RB, 1);
        ATT_TR8(RB, 3); ATT_TRWAIT(RA, 8); ATT_PV(RA, 2);
        ATT_TRWAIT(RB, 0); ATT_PV(RB, 3);
#undef ATT_TR8
#undef ATT_TRWAIT
#undef ATT_PV
    }
    asm volatile("s_waitcnt vmcnt(0)" ::: "memory");
    __builtin_amdgcn_s_barrier();
}
__device__ __forceinline__ void attn_unit(const Ctx& C, int l, int b, int h, int qb) {
    const int tid = opaque_tid(), lane = tid & 63, w = __builtin_amdgcn_readfirstlane(tid >> 6), ql = lane & 31, hh = lane >> 5;
    LAS unsigned char* lds = C.lds;
    const int q0 = qb * 256;
    const size_t tok0 = (size_t)b * SEQ;
    const bf16_t* KV = C.at<bf16_t>(WS_KV);
    static_assert(WS_KR == WS_KV + (size_t)MTOK * NKV * 2, "kr must follow kv");
    static_assert((size_t)MTOK * NKV * 2 + (size_t)MTOK * 64 * 2 < 0xffffffffull, "32-bit DMA offsets");
    AttnDma dma; attn_dma_init(dma, tok0, h, w, lane);
    attn_dma_issue(lds, KV, dma, 0, w);
    bf16x8 qf[12];
    {
        const bf16_t* qp = C.at<bf16_t>(WS_Q) + (tok0 + q0 + w * 32 + ql) * NQ + h * QKD + hh * 8;
#pragma unroll
        for (int s = 0; s < 12; ++s) qf[s] = *(const bf16x8*)(qp + 16 * s);
    }
    f32x16 o[4];
#pragma unroll
    for (int d = 0; d < 4; ++d)
#pragma unroll
        for (int i = 0; i < 16; ++i) o[d][i] = 0.f;
    float mrun = -1e30f, lrun = 0.f;
    const int ntiles = 4 * qb + 4, mytiles = 4 * qb + (w >> 1) + 1;
    asm volatile("s_waitcnt vmcnt(0)" ::: "memory");
    __syncthreads();
    const int qi = q0 + w * 32 + ql;
    const int kaddr = ql * KSTR + hh * 16;
    const int vaddr = KBUF + (4 * hh + ((lane & 15) >> 2)) * VSTR + (16 * ((lane >> 4) & 1) + 4 * (lane & 3)) * 2;
#pragma nounroll
    for (int j = 0; j < ntiles; j += 2) {
        attn_tile<0>(lds, KV, dma, j, ntiles, mytiles, w, hh, qi, kaddr, vaddr, qf, o, mrun, lrun);
        attn_tile<1>(lds, KV, dma, j + 1, ntiles, mytiles, w, hh, qi, kaddr, vaddr, qf, o, mrun, lrun);
    }
    __syncthreads();
    const float ltot = lrun + __shfl_xor(lrun, 32);
    const float inv = 1.0f / ltot;
    float ss = 0.f;
#pragma unroll
    for (int d = 0; d < 4; ++d)
#pragma unroll
        for (int i = 0; i < 16; ++i) { o[d][i] *= inv; ss += o[d][i] * o[d][i]; }
    ss += __shfl_xor(ss, 32);
    const float rn = rsqrtf(ss * (1.0f / 128.0f) + RMS_EPS);
    const float* gn = C.fin(12) + l * 1024 + h * 128;
    bf16_t* yp = C.at<bf16_t>(WS_Y) + (tok0 + q0 + w * 32 + ql) * DM + h * 128;
#pragma unroll
    for (int d = 0; d < 4; ++d)
#pragma unroll
        for (int g4 = 0; g4 < 4; ++g4) {
            const int dd = 32 * d + 8 * g4 + 4 * hh;
            const f32x4 gv = *(const f32x4*)(gn + dd);
            u32x2 wv2; wv2.x = cvt_pk_bf16(o[d][4 * g4 + 0] * rn * gv[0], o[d][4 * g4 + 1] * rn * gv[1]); wv2.y = cvt_pk_bf16(o[d][4 * g4 + 2] * rn * gv[2], o[d][4 * g4 + 3] * rn * gv[3]);
            *(u32x2*)(yp + dd) = wv2;
        }
}

__device__ __forceinline__ void phase_final(const Ctx& C) {
    const int tid = opaque_tid(), lane = tid & 63, wv = tid >> 6;
    const float* part = C.at<float>(WS_PARTH); const float* gn = C.fin(31); const bf16_t* hb = C.at<bf16_t>(WS_HB);
    for (int row = C.wg * 8 + wv; row < MTOK; row += C.G * 8) {
        const float rs = rsqrtf(sum_part<32>(part + (size_t)row * 32) * (1.0f / DM) + RMS_EPS);
#pragma unroll
        for (int i = 0; i < 4; ++i) {
            const int col = (i * 64 + lane) * 8; const size_t off = (size_t)row * DM + col;
            const u32x4 w = *(const u32x4*)(hb + off); const f32x4 g0 = *(const f32x4*)(gn + col), g1 = *(const f32x4*)(gn + col + 4);
            const f32x4 v0 = {__uint_as_float(w.x << 16), __uint_as_float(w.x & 0xffff0000u), __uint_as_float(w.y << 16), __uint_as_float(w.y & 0xffff0000u)};
            const f32x4 v1 = {__uint_as_float(w.z << 16), __uint_as_float(w.z & 0xffff0000u), __uint_as_float(w.w << 16), __uint_as_float(w.w & 0xffff0000u)};
            *(f32x4*)(C.out + off) = v0 * rs * g0; *(f32x4*)(C.out + off + 4) = v1 * rs * g1;
        }
    }
}

constexpr int N_PHASES = 2 + 9 * DEPTH;
__global__ void __launch_bounds__(NTHREADS, 2) fwd_kernel(Args args) {
    extern __shared__ __attribute__((aligned(16))) unsigned char lds_raw[];
    Ctx C0; C0.in = args.in; C0.out = args.out; C0.ws = args.ws; C0.lds = (LAS unsigned char*)lds_raw; C0.G = gridDim.x; C0.wg = blockIdx.x;
    volatile LAS unsigned* misc = (volatile LAS unsigned*)(C0.lds + LDS_MISC);
    if (threadIdx.x < 16) misc[threadIdx.x] = 0u;
    __syncthreads();
    const int lo = args.ph_lo, hi = args.ph_hi;
    constexpr bool one_launch = !MK_MULTI;
    XcdBarrier bar; bar.bar = (unsigned*)(C0.ws + WS_CTL); bar.x = 0; bar.st = misc;
    if (hi - lo > 1) bar = xcd_barrier_post((unsigned*)(C0.ws + WS_CTL), misc);
#define IN(k) (lo <= (k) && (k) < hi)
#define SEAM(k) do { if (IN((k) + 1)) { xcd_barrier(bar); if (REP(10)) xcd_barrier(bar); } } while (0)

    if (IN(0)) { if (!SKIP(0)) {
#pragma nounroll
        for (int rep = 0; rep <= REP(12); ++rep) { phase_prologue(C0.fresh()); phase_convert(C0.fresh(), 0, bar); } } SEAM(0); }

    for (int it = 0; it < 3 * DEPTH; ++it) {
        const int l = it / 3, kind = it - 3 * l;
        const int pb = 1 + 9 * l;
        if (kind != 1) {
            const int id = pb + (kind == 0 ? 0 : 6);
            if (IN(id)) {
                const Ctx C = C0.fresh();
                pg8::Gemm g{C.at<bf16_t>(WS_H8), C.at<bf16_t>(kind == 0 ? WS_W1GU : WS_W2GU), MTOK, 2 * DFF, DM / 2, DM / 2, 0};
                pg8::StaticOrder S; S.init(MTOK, 2 * DFF, C.G, C.wg, MK_WGM_GU);
                EpiGU E{C.at<bf16_t>(WS_ACT), C.at<float>(WS_PARTH), C.at<float>(WS_RSA), C.at<float>(WS_CTL + CW_WMAX) + l * 2 + (kind == 0 ? 0 : 1), C.at<unsigned>(kind == 0 ? WS_AMAX : WS_AMAX2)};
#pragma nounroll
                for (int rep = 0; rep <= REP(1); ++rep)
                if (!SKIP(1)) pg8::gemm_phase<EpiGU, REP(8)>(C.lds, g, S, E, E);
                xcd_barrier(bar); actq_pass(C0.fresh(), kind == 0 ? WS_AMAX : WS_AMAX2, kind == 0 ? WS_AMAX2 : WS_AMAX, C0.at<float>(WS_CTL + CW_WMAX) + l * 2 + (kind == 0 ? 0 : 1));
                SEAM(id);
            }
        }
        {
            const int id = pb + (kind == 0 ? 1 : (kind == 1 ? 5 : 7));
            if (IN(id)) {
                const Ctx C = C0.fresh();
                pg8::StaticOrder S; S.init(MTOK, DM, C.G, C.wg, MK_WGM_RES);
                const float* basef = (it == 0) ? C.fin(0) : nullptr;
                if (kind == 1) {
                    pg8::Gemm g{C.at<bf16_t>(WS_Y), C.at<bf16_t>(WS_WOUT), MTOK, DM, DM, DM, 0};
                    EpiResT<false> E{basef, C.at<bf16_t>(WS_HB), C.at<float>(WS_PARTH), 1.0f, nullptr, nullptr};
                    if (!SKIP(2)) pg8::gemm_phase<EpiResT<false>>(C.lds, g, S, E, E);
                } else {
                    pg8::Gemm g{C.at<bf16_t>(WS_ACT8), C.at<bf16_t>(kind == 0 ? WS_W1D : WS_W2D), MTOK, DM, DFF / 2, 64, 1};
                    EpiResT<true> E{basef, C.at<bf16_t>(WS_HB), C.at<float>(WS_PARTH), 0.5f, C.at<float>(WS_ASC), C.at<float>(WS_CTL + CW_WMAX) + 8 + l * 2 + (kind == 0 ? 0 : 1)};
#pragma nounroll
                    for (int rep = 0; rep <= REP(2); ++rep)
                    if (!SKIP(2)) pg8::gemm_phase<EpiResT<true>>(C.lds, g, S, E, E);
                }
                if (one_launch && it != 3 * DEPTH - 1) { xcd_barrier(bar); if (kind == 0) rstd_pass(C0.fresh()); else quant_pass(C0.fresh()); }
                SEAM(id);
            }
        }
        if (kind == 0) {
            if (IN(pb + 2)) {
                const Ctx C = C0.fresh();
                pg8::Gemm g{C.at<bf16_t>(WS_HB), C.at<bf16_t>(WS_WIN), MTOK, NINP, DM, DM, 0};
                pg8::StaticOrder S; S.init(MTOK, NINP, C.G, C.wg, MK_WGM_WIN);
                EpiScale<0> E{C.at<bf16_t>(WS_P), NINP, C.at<float>(WS_PARTH), 1.0f / DM, 1.0f, C.at<float>(WS_PARTQ), C.at<float>(WS_PARTKV), nullptr, nullptr, one_launch ? C.at<float>(WS_RSTD) : nullptr};
#pragma nounroll
                for (int rep = 0; rep <= REP(3); ++rep)
                if (!SKIP(3)) pg8::gemm_phase<EpiScale<0>>(C.lds, g, S, E, E);
                SEAM(pb + 2);
            }
            if (IN(pb + 3)) {
                {
                    const Ctx C = C0.fresh();
                    pg8::Gemm g{C.at<bf16_t>(WS_P), C.at<bf16_t>(WS_WUQ), MTOK, NQ, QL, NINP, 0};
                    pg8::StaticOrder S; S.init(MTOK, NQ, C.G, C.wg);
                    EpiScale<2> E{C.at<bf16_t>(WS_Q), NQ, C.at<float>(WS_PARTQ), 1.0f / QL, 0.07216878364870322f * 1.4426950408889634f, nullptr, nullptr, C.at<float>(WS_ROPEC), C.at<float>(WS_ROPES), nullptr};
#pragma nounroll
                    for (int rep = 0; rep <= REP(4); ++rep)
                    if (!SKIP(4)) pg8::gemm_phase<EpiScale<2>>(C.lds, g, S, E, E);
                }
                {
                    const Ctx C = C0.fresh();
                    pg8::Gemm g{C.at<bf16_t>(WS_P) + QL, C.at<bf16_t>(WS_WUKV), MTOK, NKV, KVL, NINP, 0};
                    pg8::StaticOrder S; S.init(MTOK, NKV, C.G, C.wg);
                    EpiScale<1> E{C.at<bf16_t>(WS_KV), NKV, C.at<float>(WS_PARTKV), 1.0f / KVL, 1.0f, nullptr, nullptr, nullptr, nullptr, nullptr};
#pragma nounroll
                    for (int rep = 0; rep <= REP(4); ++rep)
                    if (!SKIP(5)) pg8::gemm_phase<EpiScale<1>>(C.lds, g, S, E, E);
                }
#pragma nounroll
                for (int rep = 0; rep <= REP(5); ++rep)
                if (!SKIP(6)) prep_phase(C0.fresh(), l);
                SEAM(pb + 3);
            }
            if (IN(pb + 4)) {
                unsigned* qctr = (unsigned*)(C0.fresh().ws + WS_CTL + CW_QUEUE) + 64 * l;
                if (REP(6)) { if ((int)C0.wg < 128) scan_unit(C0.fresh(), l, C0.wg); xcd_barrier(bar); }
                if (REP(7)) { for (int pi = C0.wg; pi < 1024; pi += C0.G) { const int bh = pi & 127, qb = (pi >> 7) & 1 ? (pi >> 8) : 7 - (pi >> 8); attn_unit(C0.fresh(), l, bh >> 3, bh & 7, qb); } xcd_barrier(bar); }
#pragma nounroll
                for (int rep = 0; rep <= REP(11); ++rep, qctr += 256)
                for (;;) {
                    if (threadIdx.x == 0) misc[4] = xb_add(qctr, 1u);
                    __syncthreads();
                    const int item = (int)misc[4];
                    __syncthreads();
                    if (item >= 128 + 1024) break;
                    if (item < 128) { if (!SKIP(7)) scan_unit(C0.fresh(), l, item); }
                    else { const int idx = item - 128, bh = idx & 127, qb = 7 - (idx >> 7);
                        if (!SKIP(8)) attn_unit(C0.fresh(), l, bh >> 3, bh & 7, qb); }
                }
                SEAM(pb + 4);
            }
        }
        if (kind == 2) {
            if (IN(pb + 8)) { if (l + 1 < DEPTH && !SKIP(9)) { phase_convert(C0.fresh(), l + 1, bar); if (REP(0)) phase_convert(C0.fresh(), l + 1, bar); } SEAM(pb + 8); }
        }
    }
    if (IN(N_PHASES - 1) && !SKIP(10)) {
#pragma nounroll
        for (int rep = 0; rep <= REP(12); ++rep) phase_final(C0.fresh()); }
#undef IN
#undef SEAM
}

extern "C" void kernel_launch(void* const* d_in, const int* in_sizes, int n_in, void* d_out, int out_size, void* d_ws, size_t ws_size, hipStream_t stream) {
    static int grid = 0;
    if (grid == 0) {
        if (n_in != 32 || out_size != MTOK * DM || ws_size < WS_END) { fprintf(stderr, "kernel_launch: unexpected shapes (n_in %d, out %d, ws %zu, need %zu)\n", n_in, out_size, ws_size, (size_t)WS_END); grid = -1; return; }
        int dev = 0, cus = 0, per_cu = 0;
        if (hipGetDevice(&dev) != hipSuccess || hipDeviceGetAttribute(&cus, hipDeviceAttributeMultiprocessorCount, dev) != hipSuccess) { grid = -1; return; }
        if (hipFuncSetAttribute((const void*)fwd_kernel, hipFuncAttributeMaxDynamicSharedMemorySize, LDS_BYTES) != hipSuccess) { fprintf(stderr, "kernel_launch: hipFuncSetAttribute failed\n"); grid = -1; return; }
        if (hipOccupancyMaxActiveBlocksPerMultiprocessor(&per_cu, (const void*)fwd_kernel, NTHREADS, LDS_BYTES) != hipSuccess || per_cu < 1) { fprintf(stderr, "kernel_launch: occupancy query says %d\n", per_cu); }
        (void)hipGetLastError();
        grid = cus;
    }
    if (grid < 0) return;
    (void)hipMemsetAsync((char*)d_ws + WS_CTL, 0, ZERO_BYTES, stream);
    Args a{};
    for (int i = 0; i < 32; ++i) a.in[i] = d_in[i];
    a.out = (float*)d_out; a.ws = (unsigned char*)d_ws;
#if MK_MULTI
    for (int p = 0; p < N_PHASES; ++p) { a.ph_lo = p; a.ph_hi = p + 1; hipLaunchKernelGGL(fwd_kernel, dim3(grid), dim3(NTHREADS), LDS_BYTES, stream, a); }
#else
    a.ph_lo = 0; a.ph_hi = N_PHASES;
    hipLaunchKernelGGL(fwd_kernel, dim3(grid), dim3(NTHREADS), LDS_BYTES, stream, a);
#endif
}
```

```cpp
#include <hip/hip_runtime.h>
#include <stdint.h>
#include <stdio.h>

#ifndef MK_MULTI
#define MK_MULTI 0
#endif

#ifndef MK_SKIP
#define MK_SKIP 0
#endif
#define SKIP(b) ((MK_SKIP >> (b)) & 1)
#ifndef MK_WGM_RES
#define MK_WGM_RES 4
#endif
#ifndef MK_WGM_GU
#define MK_WGM_GU 8
#endif
#ifndef MK_WGM_WIN
#define MK_WGM_WIN 4
#endif
#ifndef MK_REP
#define MK_REP 0
#endif
#define REP(b) ((MK_REP >> (b)) & 1)
#define LAS __attribute__((address_space(3)))
typedef unsigned short bf16_t;
typedef short bf16x8 __attribute__((ext_vector_type(8)));
typedef short s16x4 __attribute__((ext_vector_type(4)));
typedef float f32x4 __attribute__((ext_vector_type(4)));
typedef float f32x2 __attribute__((ext_vector_type(2)));
typedef float f32x16 __attribute__((ext_vector_type(16)));
typedef unsigned u32x4 __attribute__((ext_vector_type(4)));
typedef unsigned u32x2 __attribute__((ext_vector_type(2)));
typedef int i32x4 __attribute__((ext_vector_type(4)));
typedef int i32x8 __attribute__((ext_vector_type(8)));

constexpr int BATCH = 16, SEQ = 2048, MTOK = BATCH * SEQ, DM = 2048, DFF = 5632, DEPTH = 4;
constexpr int NIN = 4064, NINP = 4096;
constexpr int QL = 512, KVL = 256, AH = 8, QKD = 192;
constexpr int NQ = AH * QKD;
constexpr int NKV = AH * 256;
constexpr int BW = 512;
constexpr int PB0 = 832, PC0 = 2528;
constexpr float RMS_EPS = 1e-6f;
constexpr int NTHREADS = 512;

constexpr size_t al256(size_t x) { return (x + 255) & ~(size_t)255; }
constexpr int XCD_BAR_WORDS_C = 3456;
constexpr size_t WS_CTL = 0;
constexpr size_t CTL_BYTES = 65536;
constexpr size_t CW_QUEUE = 16384;
constexpr size_t WS_PARTH = WS_CTL + CTL_BYTES;
constexpr size_t WS_PARTQ = WS_PARTH + (size_t)MTOK * 32 * 4;
constexpr size_t WS_PARTKV = WS_PARTQ + (size_t)MTOK * 8 * 4;
constexpr size_t ZERO_BYTES = CTL_BYTES;
constexpr size_t WS_RSTD = WS_PARTKV + (size_t)MTOK * 4 * 4;
constexpr size_t WS_ROPEC = al256(WS_RSTD + (size_t)MTOK * 4);
constexpr size_t WS_ROPES = WS_ROPEC + (size_t)MTOK * 32 * 4;
constexpr size_t WS_W1GU = WS_ROPES + (size_t)MTOK * 32 * 4;
constexpr size_t SZ_WGU = (size_t)2 * DFF * DM * 2;
constexpr size_t SZ_WD = (size_t)DM * DFF * 2;
constexpr size_t WS_W1D = WS_W1GU + SZ_WGU;
constexpr size_t WS_WIN = WS_W1D + SZ_WD;
constexpr size_t WS_WUQ = WS_WIN + (size_t)NINP * DM * 2;
constexpr size_t WS_WUKV = WS_WUQ + (size_t)NQ * QL * 2;
constexpr size_t WS_WOUT = WS_WUKV + (size_t)NKV * KVL * 2;
constexpr size_t WS_W2GU = WS_WOUT + (size_t)DM * DM * 2;
constexpr size_t WS_W2D = WS_W2GU + SZ_WGU;
constexpr size_t WS_LORA = WS_W2D + SZ_WD;
constexpr size_t WS_HB = al256(WS_LORA + (size_t)512 * 160 * 2);
constexpr size_t WS_X = WS_HB + (size_t)MTOK * DM * 2;
constexpr size_t WS_ACT = WS_X;
constexpr size_t WS_P = WS_X;
constexpr size_t WS_Q = WS_P + (size_t)MTOK * NINP * 2;
constexpr size_t WS_KV = WS_Q + (size_t)MTOK * NQ * 2;
constexpr size_t WS_KR = WS_KV + (size_t)MTOK * NKV * 2;
constexpr size_t WS_SCAN = WS_KR + (size_t)MTOK * 64 * 2;
constexpr int CB_BYTES = 11520;
constexpr int CB_WA = 0, CB_QA = 2048, CB_MT = 4096, CB_Q2 = 4608, CB_BK = 5120, CB_PC = 9216, CB_VT = 9472;
constexpr size_t WS_BV = WS_SCAN + (size_t)BATCH * 8 * (SEQ / 16) * CB_BYTES;
constexpr size_t WS_G = WS_SCAN + (size_t)MTOK * 8 * 6 * 64 * 4;
static_assert(WS_BV + (size_t)MTOK * BW * 4 <= WS_G, "scan region");
constexpr size_t WS_Y = WS_G + (size_t)MTOK * BW * 4;
constexpr size_t WS_MIXEND = WS_Y + (size_t)MTOK * DM * 2;
constexpr size_t WS_ACTEND = WS_ACT + (size_t)MTOK * DFF * 2;
constexpr size_t WS_H8 = al256(WS_MIXEND > WS_ACTEND ? WS_MIXEND : WS_ACTEND);
constexpr size_t WS_RSA = WS_H8 + (size_t)MTOK * DM;
constexpr size_t WS_AMAX = WS_RSA + (size_t)MTOK * 4;
constexpr size_t WS_AMAX2 = WS_AMAX + (size_t)MTOK * 4;
constexpr size_t WS_ASC = WS_AMAX2 + (size_t)MTOK * 4;
constexpr size_t WS_END = WS_ASC + (size_t)MTOK * 4;
constexpr size_t WS_ACT8 = WS_ACT + (size_t)MTOK * DFF * 2;
static_assert(WS_ACT8 + (size_t)MTOK * DFF <= WS_MIXEND, "act8 inside the union");
constexpr size_t CW_WMAX = 32768;

constexpr int STAGE_BYTES_C = 131072;
constexpr int LDS_WORK = 8192 + 8 * 16384;
constexpr int LDS_MISC = LDS_WORK;
constexpr int LDS_BYTES = LDS_WORK + 256;

typedef __bf16 bf16x2_t __attribute__((ext_vector_type(2)));
__device__ __forceinline__ unsigned cvt_pk_bf16(float lo, float hi) { const f32x2 f = {lo, hi}; return __builtin_bit_cast(unsigned, __builtin_convertvector(f, bf16x2_t)); }
__device__ __forceinline__ unsigned pk4_i8(float a, float b, float c, float d) {
    const unsigned ua = __float_as_uint(a + 12582912.0f), ub = __float_as_uint(b + 12582912.0f), uc = __float_as_uint(c + 12582912.0f), ud = __float_as_uint(d + 12582912.0f);
    return __builtin_amdgcn_perm(__builtin_amdgcn_perm(ud, uc, 0x0c0c0400u), __builtin_amdgcn_perm(ub, ua, 0x0c0c0400u), 0x05040100u);
}
__device__ __forceinline__ float bf2f(bf16_t b) { return __uint_as_float(((unsigned)b) << 16); }
__device__ __forceinline__ bf16_t f2bf(float f) { return (bf16_t)(cvt_pk_bf16(f, 0.f) & 0xffffu); }
__device__ __forceinline__ int opaque_tid() { int t = threadIdx.x; asm volatile("" : "+v"(t)); return t; }
__device__ __forceinline__ float wave_sum(float v) {
#pragma unroll
    for (int o = 32; o >= 1; o >>= 1) v += __shfl_xor(v, o);
    return v;
}
__device__ __forceinline__ float rdlane(float v, int l) { return __builtin_bit_cast(float, __builtin_amdgcn_readlane(__builtin_bit_cast(int, v), l)); }
template <int CTRL> __device__ __forceinline__ float dpp_mov(float v) { return __builtin_bit_cast(float, __builtin_amdgcn_update_dpp(0, __builtin_bit_cast(int, v), CTRL, 0xf, 0xf, false)); }
__device__ __forceinline__ float red16(float v) { v += dpp_mov<0xB1>(v); v += dpp_mov<0x4E>(v); v += dpp_mov<0x141>(v); v += dpp_mov<0x140>(v); return v; }
__device__ __forceinline__ float xor16_add(float v) { const unsigned b = __builtin_bit_cast(unsigned, v); const u32x2 r = __builtin_amdgcn_permlane16_swap(b, b, false, false); return __uint_as_float(r.x) + __uint_as_float(r.y); }
__device__ __forceinline__ float xor32_add(float v) { const unsigned b = __builtin_bit_cast(unsigned, v); const u32x2 r = __builtin_amdgcn_permlane32_swap(b, b, false, false); return __uint_as_float(r.x) + __uint_as_float(r.y); }
__device__ __forceinline__ float xor16_max(float v) { const unsigned b = __builtin_bit_cast(unsigned, v); const u32x2 r = __builtin_amdgcn_permlane16_swap(b, b, false, false); return fmaxf(__uint_as_float(r.x), __uint_as_float(r.y)); }
__device__ __forceinline__ float xor32_max(float v) { const unsigned b = __builtin_bit_cast(unsigned, v); const u32x2 r = __builtin_amdgcn_permlane32_swap(b, b, false, false); return fmaxf(__uint_as_float(r.x), __uint_as_float(r.y)); }
__device__ __forceinline__ void fwht8(float (&v)[8]) {
#pragma unroll
    for (int h = 1; h < 8; h <<= 1)
#pragma unroll
        for (int i = 0; i < 8; ++i) if (!(i & h)) { const float a = v[i], b = v[i | h]; v[i] = a + b; v[i | h] = a - b; }
}
__device__ __forceinline__ void fwht8_pk(f32x2 (&p)[4]) {
#pragma unroll
    for (int i = 0; i < 4; ++i) { f32x2 d; asm("v_pk_add_f32 %0, %1, %1 op_sel:[0,1] op_sel_hi:[0,1] neg_hi:[0,1]" : "=v"(d) : "v"(p[i])); p[i] = d; }
    { const f32x2 a = p[0] + p[1], b = p[0] - p[1], c = p[2] + p[3], d = p[2] - p[3]; p[0] = a; p[1] = b; p[2] = c; p[3] = d; }
    { const f32x2 a = p[0] + p[2], b = p[1] + p[3], c = p[0] - p[2], d = p[1] - p[3]; p[0] = a; p[1] = b; p[2] = c; p[3] = d; }
}
__device__ __forceinline__ float wave_sum_fast(float v) { return xor32_add(xor16_add(red16(v))); }
__device__ __forceinline__ float sigmoid_fast(float x) { return __builtin_amdgcn_rcpf(1.0f + __builtin_amdgcn_exp2f(-1.4426950408889634f * x)); }
__device__ __forceinline__ float red8(float v) { v += dpp_mov<0xB1>(v); v += dpp_mov<0x4E>(v); v += dpp_mov<0x141>(v); return v; }
template <int N> __device__ __forceinline__ float sum_part(const float* p) {
    f32x4 a = *(const f32x4*)p;
#pragma unroll
    for (int i = 1; i < N / 4; ++i) a += *(const f32x4*)(p + 4 * i);
    return (a[0] + a[1]) + (a[2] + a[3]);
}

#define XB_TMO      128
#define XB_XCNT(j)  (256  + 64 * (j))
#define XB_XSUB(j)  (1280 + 64 * (j))
#define XB_XGEN(j)  (2304 + 64 * (j))
#define XB_TOP      3328
#define XB_TOPGEN   3392
#define XCD_BAR_WORDS 3456
#define XB_SPIN_CAP (1u << 22)
static_assert(XCD_BAR_WORDS == XCD_BAR_WORDS_C && XCD_BAR_WORDS * 4 <= CW_QUEUE, "ctl layout");

__device__ __forceinline__ unsigned xb_ld(unsigned* p)              { return __hip_atomic_load(p, __ATOMIC_RELAXED, __HIP_MEMORY_SCOPE_AGENT); }
__device__ __forceinline__ unsigned xb_add(unsigned* p, unsigned v) { return __hip_atomic_fetch_add(p, v, __ATOMIC_RELAXED, __HIP_MEMORY_SCOPE_AGENT); }
__device__ __forceinline__ unsigned xb_xcc_id() { return (unsigned)__builtin_amdgcn_s_getreg((3 << 11) | 20) & 0xFu; }
#define XB_SPIN(cond, bar) do { unsigned _sp = 0; while (cond) { __builtin_amdgcn_s_sleep(1); \
    if ((++_sp & 255u) == 0u) { if (xb_ld(&(bar)[XB_TMO])) break; if (_sp > XB_SPIN_CAP) { atomicAdd(&(bar)[XB_TMO], 1u); break; } } } } while (0)

struct XcdBarrier { unsigned* bar; unsigned x; volatile LAS unsigned* st; };

__device__ __forceinline__ XcdBarrier xcd_barrier_post(unsigned* bar, volatile LAS unsigned* st) {
    XcdBarrier b; b.bar = bar; b.x = xb_xcc_id(); b.st = st;
    if (threadIdx.x == 0) (void)xb_add(&bar[XB_XCNT(b.x)], 1u);
    return b;
}
__device__ __forceinline__ void xcd_barrier_complete(unsigned* bar, unsigned x, unsigned& nloc, unsigned& nx) {
    const unsigned G = gridDim.x * gridDim.y * gridDim.z;
    unsigned sum, cnt, mine, sp = 0u;
    for (;;) {
        sum = 0u; cnt = 0u; mine = 0u;
#pragma unroll
        for (unsigned j = 0; j < 16; ++j) { const unsigned c = xb_ld(&bar[XB_XCNT(j)]); sum += c; cnt += (c > 0u) ? 1u : 0u; mine = (j == x) ? c : mine; }
        if (sum == G) break;
        __builtin_amdgcn_s_sleep(1);
        if ((++sp & 255u) == 0u) { if (xb_ld(&bar[XB_TMO])) break; if (sp > XB_SPIN_CAP) { atomicAdd(&bar[XB_TMO], 1u); break; } }
    }
    nloc = mine > 0u ? mine : 1u; nx = cnt > 0u ? cnt : 1u;
}
__device__ __forceinline__ void xcd_barrier(const XcdBarrier& b) {
    asm volatile("s_waitcnt vmcnt(0)" ::: "memory");
    __syncthreads();
    if (threadIdx.x == 0) {
        unsigned* bar = b.bar;
        __builtin_amdgcn_s_waitcnt(0);
        unsigned nloc = b.st[0], nx = b.st[1];
        if (nloc == 0u) { xcd_barrier_complete(bar, b.x, nloc, nx); b.st[0] = nloc; b.st[1] = nx; }
        const unsigned old = xb_add(&bar[XB_XSUB(b.x)], 1u);
        const unsigned gen = old / nloc;
        if (old + 1u == (gen + 1u) * nloc) {
            __builtin_amdgcn_fence(__ATOMIC_RELEASE, "agent");
            asm volatile("s_waitcnt vmcnt(0)" ::: "memory");
            const unsigned og = xb_add(&bar[XB_TOP], 1u);
            const unsigned tg = og / nx;
            if (og + 1u == (tg + 1u) * nx) xb_add(&bar[XB_TOPGEN], 1u);
            else XB_SPIN(xb_ld(&bar[XB_TOPGEN]) == tg, bar);
            __builtin_amdgcn_fence(__ATOMIC_ACQUIRE, "agent");
            xb_add(&bar[XB_XGEN(b.x)], 1u);
            asm volatile("s_waitcnt vmcnt(0)" ::: "memory");
        } else {
            XB_SPIN(xb_ld(&bar[XB_XGEN(b.x)]) == gen, bar);
            __builtin_amdgcn_fence(__ATOMIC_ACQUIRE, "agent");
            asm volatile("s_waitcnt vmcnt(0)" ::: "memory");
        }
    }
    __syncthreads();
}

namespace pg8 {
constexpr int BM = 256, BK = 64, HALF = 128, HTB = HALF * BK * 2, STAGE_BYTES = 8 * HTB, NXCD = 8, WGM = 8;
static_assert(STAGE_BYTES == STAGE_BYTES_C, "stage bytes");
__host__ __device__ __forceinline__ int lds_byte(int r, int c) { const int st = (r >> 4) * 2 + (c >> 5), rr = r & 15, cc = c & 31, ob = rr * 64 + cc * 2; return st * 1024 + (ob ^ (((ob >> 9) & 1) << 5)); }
__host__ __device__ __forceinline__ void stage_rc(int b, int& R, int& C) { const int st = b / 1024, sb = b % 1024, swz = sb ^ (((sb >> 9) & 1) << 5); R = (st >> 1) * 16 + swz / 64; C = (st & 1) * 32 + (swz % 64) / 2; }
__host__ __device__ __forceinline__ int perm32(int rho) { const int n = rho >> 4, i = rho & 15; return 8 * (i >> 2) + 4 * n + (i & 3); }

struct Unit { int pm, pn; };
struct Gemm { const bf16_t* A; const bf16_t* Bt; int M, N, K, lda; int ablk; };

struct StaticOrder {
    int nM, nN, nwg, G, c, wgm;
    __host__ __device__ void init(int M, int N, int G_, int c_, int wgm_ = WGM) { nM = M / BM; nN = N / BM; nwg = nM * nN; G = G_; c = c_; wgm = wgm_; }
    __host__ __device__ bool next(int i, Unit& u) const {
        const long L = (long)i * G + c; if (L >= nwg) return false;
        int wgid = (int)L; { const int q = nwg / NXCD, r = nwg % NXCD, xcd = wgid % NXCD, off = wgid / NXCD; wgid = (xcd < r ? xcd * (q + 1) : r * (q + 1) + (xcd - r) * q) + off; }
        const int nig = wgm * nN, gid = wgid / nig, fm = gid * wgm, gsz = (nM - fm) < wgm ? (nM - fm) : wgm;
        u.pm = fm + ((wgid % nig) % gsz); u.pn = (wgid % nig) / gsz; return true;
    }
};

template <class Epi, bool REPE = false>
__device__ __forceinline__ void gemm_phase(LAS unsigned char* lds, const Gemm g, const StaticOrder& S, const Epi& E, const Epi& E0) {
    const int tid = opaque_tid(), wid = __builtin_amdgcn_readfirstlane(tid >> 6), lane = tid & 63, wr = wid >> 2, wc = wid & 3, fr = lane & 15, fq = lane >> 4;
    const int K = g.K, nt = K / BK, lda = g.lda;
    unsigned voffA[2], voffB[2];
#pragma unroll
    for (int i = 0; i < 2; ++i) { int R, C; stage_rc(tid * 16 + i * 8192, R, C); const int Rb = Epi::PERM ? ((R & ~31) + perm32(R & 31)) : R;
        voffA[i] = g.ablk ? (unsigned)((C >> 5) * (BM * 32) + R * 32 + (C & 31)) * 2u : (unsigned)(R * lda + C) * 2u; voffB[i] = (unsigned)(Rb * BK + C) * 2u; }
    const size_t kstep = (size_t)(BK * 2);
    const size_t hstepA = g.ablk ? (size_t)HALF * 32 * 2 : (size_t)HALF * lda * 2, hstepB = (size_t)HALF * BK * 2;
    const size_t kstepA = g.ablk ? (size_t)(BM * BK * 2) : kstep;
    const size_t kstepB = (size_t)(BM * BK * 2);
    const size_t tstepA = g.ablk ? (size_t)nt * kstepA : 2 * hstepA, tstepB = (size_t)nt * kstepB;
    const unsigned ldsw = (unsigned)wid * 1024u;
    const int aoff = lds_byte(wr * 64 + fr, fq * 8), boff = lds_byte(wc * 32 + fr, fq * 8);
#define PG8_SA(b, h) (((b) * 2 + (h)) * HTB)
#define PG8_SB(b, h) ((4 + (b) * 2 + (h)) * HTB)
#define PG8_STAGE(bufoff, gbase, voff) do { _Pragma("unroll") for (int _i = 0; _i < 2; ++_i) \
        __builtin_amdgcn_global_load_lds((const unsigned*)((const char*)(gbase) + (voff)[_i]), (LAS unsigned*)(lds + (bufoff) + ldsw + _i * 8192), 16, 0, 0); } while (0)
#define PG8_LDA(dst, b, h) do { _Pragma("unroll") for (int m = 0; m < 4; ++m) _Pragma("unroll") for (int k = 0; k < 2; ++k) dst[m][k] = *(const LAS bf16x8*)(lds + PG8_SA(b, h) + aoff + m * 2048 + k * 1024); } while (0)
#define PG8_LDB(dst, b, h) do { _Pragma("unroll") for (int n = 0; n < 2; ++n) _Pragma("unroll") for (int k = 0; k < 2; ++k) dst[n][k] = *(const LAS bf16x8*)(lds + PG8_SB(b, h) + boff + n * 2048 + k * 1024); } while (0)
#define PG8_MMA(ai, bj, At, Bt) do { __builtin_amdgcn_s_setprio(1); \
        if constexpr (Epi::I8) { _Pragma("unroll") for (int m = 0; m < 4; ++m) _Pragma("unroll") for (int n = 0; n < 2; ++n) _Pragma("unroll") for (int k = 0; k < 2; ++k) \
            acc[ai][bj][m][n] = __builtin_bit_cast(f32x4, __builtin_amdgcn_mfma_i32_16x16x64_i8(__builtin_bit_cast(i32x4, Bt[n][k]), __builtin_bit_cast(i32x4, At[m][k]), __builtin_bit_cast(i32x4, acc[ai][bj][m][n]), 0, 0, 0)); } \
        else { _Pragma("unroll") for (int m = 0; m < 4; ++m) _Pragma("unroll") for (int n = 0; n < 2; ++n) _Pragma("unroll") for (int k = 0; k < 2; ++k) \
            acc[ai][bj][m][n] = __builtin_amdgcn_mfma_f32_16x16x32_bf16(Bt[n][k], At[m][k], acc[ai][bj][m][n], 0, 0, 0); } \
        __builtin_amdgcn_s_setprio(0); } while (0)
#define PG8_WAIT_V(n) asm volatile("s_waitcnt vmcnt(" #n ")" ::: "memory")
#define PG8_WAIT_L(n) asm volatile("s_waitcnt lgkmcnt(" #n ")" ::: "memory")
#define PG8_BAR __builtin_amdgcn_s_barrier()
#define PG8_SCHED __builtin_amdgcn_sched_barrier(0)
    Unit cur, nxt; int ui = 0;
    if (!S.next(0, cur)) return;
    float rsn[8];
#pragma unroll
    for (int r = 0; r < 8; ++r) rsn[r] = 0.f;
    if (Epi::PREF) E.rs_first(cur, wr, fr, fq, rsn);
    f32x4 acc[2][2][4][2];
#pragma unroll
    for (int a = 0; a < 2; ++a)
#pragma unroll
        for (int b = 0; b < 2; ++b)
#pragma unroll
            for (int m = 0; m < 4; ++m)
#pragma unroll
                for (int n = 0; n < 2; ++n) acc[a][b][m][n] = (f32x4){0.f, 0.f, 0.f, 0.f};
    bf16x8 At[4][2], B0[2][2], B1[2][2];
    const char* cA = (const char*)g.A + (size_t)cur.pm * tstepA; const char* cB = (const char*)g.Bt + (size_t)cur.pn * tstepB;
    PG8_STAGE(PG8_SB(0, 0), cB, voffB); PG8_STAGE(PG8_SA(0, 0), cA, voffA); PG8_STAGE(PG8_SB(0, 1), cB + hstepB, voffB); PG8_STAGE(PG8_SA(0, 1), cA + hstepA, voffA);
    if (wr == 1) PG8_BAR;
    PG8_WAIT_V(4); PG8_BAR;
    PG8_STAGE(PG8_SB(1, 0), cB + kstepB, voffB); PG8_STAGE(PG8_SA(1, 0), cA + kstepA, voffA); PG8_STAGE(PG8_SB(1, 1), cB + hstepB + kstepB, voffB);
    PG8_WAIT_V(6); PG8_BAR;
    for (;;) {
        const bool has_next = S.next(ui + 1, nxt);
        const char* nA = has_next ? (const char*)g.A + (size_t)nxt.pm * tstepA : cA; const char* nB = has_next ? (const char*)g.Bt + (size_t)nxt.pn * tstepB : cB;
#pragma nounroll
        for (int t = 0; t < nt; t += 2) {
            const bool last = (t == nt - 2);
            const char* a1 = cA + (size_t)(t + 1) * kstepA;
            const char* a2 = last ? nA : cA + (size_t)(t + 2) * kstepA; const char* b2 = last ? nB : cB + (size_t)(t + 2) * kstepB;
            const char* a3 = a2 + kstepA; const char* b3 = b2 + kstepB;
            PG8_LDB(B0, 0, 0); PG8_SCHED; PG8_LDA(At, 0, 0); PG8_STAGE(PG8_SA(1, 1), a1 + hstepA, voffA);
            PG8_WAIT_L(8); PG8_BAR; PG8_WAIT_L(0); PG8_MMA(0, 0, At, B0); PG8_BAR; PG8_SCHED;
            PG8_LDB(B1, 0, 1); PG8_STAGE(PG8_SB(0, 0), b2, voffB);
            PG8_BAR; PG8_WAIT_L(0); PG8_MMA(0, 1, At, B1); PG8_BAR;
            PG8_LDA(At, 0, 1); PG8_STAGE(PG8_SA(0, 0), a2, voffA);
            PG8_BAR; PG8_WAIT_L(0); PG8_MMA(1, 0, At, B0); PG8_BAR; PG8_SCHED;
            PG8_STAGE(PG8_SB(0, 1), b2 + hstepB, voffB);
            PG8_WAIT_V(6); PG8_BAR; PG8_MMA(1, 1, At, B1); PG8_BAR;
            PG8_LDB(B0, 1, 0); PG8_SCHED; PG8_LDA(At, 1, 0); PG8_STAGE(PG8_SA(0, 1), a2 + hstepA, voffA);
            PG8_WAIT_L(8); PG8_BAR; PG8_WAIT_L(0); PG8_MMA(0, 0, At, B0); PG8_BAR; PG8_SCHED;
            PG8_LDB(B1, 1, 1); PG8_STAGE(PG8_SB(1, 0), b3, voffB);
            PG8_BAR; PG8_WAIT_L(0); PG8_MMA(0, 1, At, B1); PG8_BAR;
            PG8_LDA(At, 1, 1); PG8_STAGE(PG8_SA(1, 0), a3, voffA);
            PG8_BAR; PG8_WAIT_L(0); PG8_MMA(1, 0, At, B0); PG8_BAR; PG8_SCHED;
            PG8_STAGE(PG8_SB(1, 1), b3 + hstepB, voffB);
            PG8_WAIT_V(6); PG8_BAR; PG8_MMA(1, 1, At, B1); PG8_BAR;
        }
        if (REPE) { float rs2[8]; _Pragma("unroll") for (int r = 0; r < 8; ++r) rs2[r] = rsn[r]; E0(acc, cur, nxt, false, rs2, wr, wc, fr, fq); }
        E(acc, cur, nxt, has_next, rsn, wr, wc, fr, fq);
        if (!has_next) break;
#pragma unroll
        for (int a = 0; a < 2; ++a)
#pragma unroll
            for (int b = 0; b < 2; ++b)
#pragma unroll
                for (int m = 0; m < 4; ++m)
#pragma unroll
                    for (int n = 0; n < 2; ++n) acc[a][b][m][n] = (f32x4){0.f, 0.f, 0.f, 0.f};
        cur = nxt; cA = nA; cB = nB; ++ui;
    }
    PG8_WAIT_V(0);
    if (wr == 0) PG8_BAR;
    PG8_BAR;
#undef PG8_SA
#undef PG8_SB
#undef PG8_STAGE
#undef PG8_LDA
#undef PG8_LDB
#undef PG8_MMA
#undef PG8_WAIT_V
#undef PG8_WAIT_L
#undef PG8_BAR
#undef PG8_SCHED
}
}

__device__ __forceinline__ float silu_f(float x) { return x * __builtin_amdgcn_rcpf(1.0f + __expf(-x)); }

__device__ __forceinline__ void rstd8_from_part32(const float* part, int row0, int fq, float inv_n, float (&rs)[8]) {
    f32x4 pa[8], pb[8];
#pragma unroll
    for (int r = 0; r < 8; ++r) { const float* p = part + (size_t)(row0 + (r >> 2) * 128 + (r & 3) * 16) * 32 + fq * 8; pa[r] = *(const f32x4*)p; pb[r] = *(const f32x4*)(p + 4); }
#pragma unroll
    for (int r = 0; r < 8; ++r) {
        float sm = ((pa[r][0] + pa[r][1]) + (pa[r][2] + pa[r][3])) + ((pb[r][0] + pb[r][1]) + (pb[r][2] + pb[r][3]));
        sm += __shfl_xor(sm, 16); sm += __shfl_xor(sm, 32);
        rs[r] = rsqrtf(sm * inv_n + RMS_EPS);
    }
}
__device__ __forceinline__ void rstd8_load(const float* rstd, int row0, float (&rs)[8]) {
#pragma unroll
    for (int r = 0; r < 8; ++r) rs[r] = rstd[row0 + (r >> 2) * 128 + (r & 3) * 16];
}
struct EpiGU {
    static constexpr bool PERM = true, PREF = true, I8 = true;
    bf16_t* O; const float* part; const float* rstd; const float* wmax; unsigned* amax;
    __device__ __forceinline__ void rs_first(const pg8::Unit& u, int wr, int fr, int fq, float (&rs)[8]) const { if (rstd) rstd8_load(rstd, u.pm * 256 + wr * 64 + fr, rs); }
    __device__ __forceinline__ void operator()(const f32x4 (&acc)[2][2][4][2], const pg8::Unit& u, const pg8::Unit& nx, bool has_next, float (&rsn)[8], int wr, int wc, int fr_, int fq_) const {
        int fr = fr_, fq = fq_; asm volatile("" : "+v"(fr), "+v"(fq));
        const int row0 = u.pm * 256 + wr * 64 + fr, col0 = u.pn * 128 + wc * 32 + 8 * fq;
        float rsv[8], rsp[8];
        const float wsc = *wmax * (1.0f / 127.0f);
        unsigned mxr[8];
        if (rstd && !PREF) rstd8_load(rstd, row0, rsv);
        else if (rstd) {
#pragma unroll
            for (int r = 0; r < 8; ++r) { rsv[r] = rsn[r]; rsp[r] = rsn[r]; }
            if (has_next) rstd8_load(rstd, nx.pm * 256 + wr * 64 + fr, rsp);
        } else rstd8_from_part32(part, row0, fq, 1.0f / DM, rsv);
#pragma unroll
        for (int ai = 0; ai < 2; ++ai)
#pragma unroll
            for (int m = 0; m < 4; ++m) {
                const int row = row0 + ai * 128 + m * 16;
                const float rs = rsv[ai * 4 + m] * wsc;
                const float c1 = rs * -1.4426950408889634f;
                f32x2 op[4];
#pragma unroll
                for (int n = 0; n < 2; ++n)
#pragma unroll
                    for (int e2 = 0; e2 < 2; ++e2) {
                        const i32x4 gi = __builtin_bit_cast(i32x4, acc[ai][0][m][n]), ui = __builtin_bit_cast(i32x4, acc[ai][1][m][n]);
                        const f32x2 g2 = {(float)gi[2 * e2], (float)gi[2 * e2 + 1]}, u2 = {(float)ui[2 * e2], (float)ui[2 * e2 + 1]};
                        const f32x2 t2 = g2 * c1; f32x2 d2 = {__builtin_amdgcn_exp2f(t2.x), __builtin_amdgcn_exp2f(t2.y)}; d2 = d2 + 1.0f;
                        const f32x2 r2 = {__builtin_amdgcn_rcpf(d2.x), __builtin_amdgcn_rcpf(d2.y)};
                        op[n * 2 + e2] = (g2 * u2) * r2; }
                fwht8_pk(op);
                const float o[8] = {op[0][0], op[0][1], op[1][0], op[1][1], op[2][0], op[2][1], op[3][0], op[3][1]};
                {
                    unsigned mx, m2;
                    asm("v_max3_f32 %0, |%1|, |%2|, |%3|" : "=v"(mx) : "v"(o[0]), "v"(o[1]), "v"(o[2]));
                    asm("v_max3_f32 %0, |%1|, |%2|, |%3|" : "=v"(m2) : "v"(o[3]), "v"(o[4]), "v"(o[5]));
                    asm("v_max3_f32 %0, %1, |%2|, |%3|" : "=v"(mx) : "v"(mx), "v"(o[6]), "v"(o[7]));
                    mx = mx > m2 ? mx : m2;
                    { const u32x2 r = __builtin_amdgcn_permlane16_swap(mx, mx, false, false); mx = r.x > r.y ? r.x : r.y; }
                    { const u32x2 r = __builtin_amdgcn_permlane32_swap(mx, mx, false, false); mx = r.x > r.y ? r.x : r.y; }
                    mxr[ai * 4 + m] = mx;
                }
                u32x4 w; w.x = cvt_pk_bf16(o[0], o[1]); w.y = cvt_pk_bf16(o[2], o[3]); w.z = cvt_pk_bf16(o[4], o[5]); w.w = cvt_pk_bf16(o[6], o[7]);
                __builtin_nontemporal_store(w, (u32x4*)(O + ((((size_t)u.pm * (DFF / 64) + (col0 >> 6)) * 2 + ((col0 >> 5) & 1)) * 256 + (row & 255)) * 32 + (col0 & 31)));
            }
        if (fq == 0) {
#pragma unroll
            for (int r = 0; r < 8; ++r) __hip_atomic_fetch_max(amax + row0 + (r >> 2) * 128 + (r & 3) * 16, mxr[r], __ATOMIC_RELAXED, __HIP_MEMORY_SCOPE_AGENT);
        }
        if (rstd && PREF) {
#pragma unroll
            for (int r = 0; r < 8; ++r) rsn[r] = rsp[r];
        }
    }
};

template <bool I8_> struct EpiResT {
    static constexpr bool PERM = true, PREF = false, I8 = I8_;
    const float* basef; bf16_t* hb; float* part; float scale; const float* asc; const float* wmax;
    __device__ __forceinline__ void rs_first(const pg8::Unit&, int, int, int, float (&)[8]) const {}
    __device__ __forceinline__ void operator()(const f32x4 (&acc)[2][2][4][2], const pg8::Unit& u, const pg8::Unit&, bool, float (&)[8], int wr, int wc, int fr, int fq) const {
        const int row0 = u.pm * 256 + wr * 64 + fr, col0 = u.pn * 256 + wc * 32 + 8 * fq;
        const float wsc = I8 ? scale * (*wmax * (1.0f / 127.0f)) : scale;
#pragma unroll
        for (int ai = 0; ai < 2; ++ai)
#pragma unroll
        for (int mh = 0; mh < 2; ++mh) {
            f32x4 b0[2][2], b1[2][2]; float rowf[2];
#pragma unroll
            for (int m2 = 0; m2 < 2; ++m2) rowf[m2] = I8 ? wsc * asc[row0 + ai * 128 + (mh * 2 + m2) * 16] : scale;
            if (basef) {
#pragma unroll
                for (int m2 = 0; m2 < 2; ++m2)
#pragma unroll
                    for (int bj = 0; bj < 2; ++bj) { const float* p = basef + (size_t)(row0 + ai * 128 + (mh * 2 + m2) * 16) * DM + col0 + bj * 128; b0[m2][bj] = *(const f32x4*)p; b1[m2][bj] = *(const f32x4*)(p + 4); }
            } else {
#pragma unroll
                for (int m2 = 0; m2 < 2; ++m2)
#pragma unroll
                    for (int bj = 0; bj < 2; ++bj) { const u32x4 w = *(const u32x4*)(hb + (size_t)(row0 + ai * 128 + (mh * 2 + m2) * 16) * DM + col0 + bj * 128);
                        b0[m2][bj] = (f32x4){__uint_as_float(w.x << 16), __uint_as_float(w.x & 0xffff0000u), __uint_as_float(w.y << 16), __uint_as_float(w.y & 0xffff0000u)};
                        b1[m2][bj] = (f32x4){__uint_as_float(w.z << 16), __uint_as_float(w.z & 0xffff0000u), __uint_as_float(w.w << 16), __uint_as_float(w.w & 0xffff0000u)}; }
            }
#pragma unroll
            for (int m2 = 0; m2 < 2; ++m2) {
                const int m = mh * 2 + m2;
                const int row = row0 + ai * 128 + m * 16; float sq = 0.f;
#pragma unroll
                for (int bj = 0; bj < 2; ++bj) {
                    const f32x4 a0 = I8 ? __builtin_convertvector(__builtin_bit_cast(i32x4, acc[ai][bj][m][0]), f32x4) : acc[ai][bj][m][0], a1 = I8 ? __builtin_convertvector(__builtin_bit_cast(i32x4, acc[ai][bj][m][1]), f32x4) : acc[ai][bj][m][1];
                    const f32x4 v0 = b0[m2][bj] + a0 * rowf[m2], v1 = b1[m2][bj] + a1 * rowf[m2];
                    u32x4 w; w.x = cvt_pk_bf16(v0[0], v0[1]); w.y = cvt_pk_bf16(v0[2], v0[3]); w.z = cvt_pk_bf16(v1[0], v1[1]); w.w = cvt_pk_bf16(v1[2], v1[3]);
                    *(u32x4*)(hb + (size_t)row * DM + col0 + bj * 128) = w;
                    const float r0 = __uint_as_float(w.x << 16), r1 = __uint_as_float(w.x & 0xffff0000u), r2 = __uint_as_float(w.y << 16), r3 = __uint_as_float(w.y & 0xffff0000u);
                    const float r4 = __uint_as_float(w.z << 16), r5 = __uint_as_float(w.z & 0xffff0000u), r6 = __uint_as_float(w.w << 16), r7 = __uint_as_float(w.w & 0xffff0000u);
                    sq += ((r0 * r0 + r1 * r1) + (r2 * r2 + r3 * r3)) + ((r4 * r4 + r5 * r5) + (r6 * r6 + r7 * r7));
                }
                sq += __shfl_xor(sq, 16); sq += __shfl_xor(sq, 32);
                if (fq == 0) part[(size_t)row * 32 + u.pn * 4 + wc] = sq;
            }
        }
    }
};

template <int MODE> struct EpiScale {
    static constexpr bool PERM = true, PREF = (MODE == 0), I8 = false;
    bf16_t* O; int ldo; const float* part_in; float inv_n; float mul; float* part_q; float* part_kv; const float* rc; const float* rs; const float* rstd;
    __device__ __forceinline__ void rs_first(const pg8::Unit& u, int wr, int fr, int fq, float (&rv)[8]) const { if (MODE == 0 && rstd) rstd8_load(rstd, u.pm * 256 + wr * 64 + fr, rv); }
    __device__ __forceinline__ void operator()(const f32x4 (&acc)[2][2][4][2], const pg8::Unit& u, const pg8::Unit& nx, bool has_next, float (&rsn)[8], int wr, int wc, int fr, int fq) const {
        const int row0 = u.pm * 256 + wr * 64 + fr, col0 = u.pn * 256 + wc * 32 + 8 * fq;
        float rsv[8], rsp[8];
        if (MODE == 0 && rstd) {
#pragma unroll
            for (int r = 0; r < 8; ++r) { rsv[r] = rsn[r]; rsp[r] = rsn[r]; }
            if (has_next) rstd8_load(rstd, nx.pm * 256 + wr * 64 + fr, rsp);
        } else if (MODE == 0) rstd8_from_part32(part_in, row0, fq, inv_n, rsv);
        else if (MODE == 2) {
            f32x4 pa[8], pb[8];
#pragma unroll
            for (int r = 0; r < 8; ++r) { const float* p = part_in + (size_t)(row0 + (r >> 2) * 128 + (r & 3) * 16) * 8; pa[r] = *(const f32x4*)p; pb[r] = *(const f32x4*)(p + 4); }
#pragma unroll
            for (int r = 0; r < 8; ++r) rsv[r] = rsqrtf((((pa[r][0] + pa[r][1]) + (pa[r][2] + pa[r][3])) + ((pb[r][0] + pb[r][1]) + (pb[r][2] + pb[r][3]))) * inv_n + RMS_EPS);
        } else {
            f32x4 pa[8];
#pragma unroll
            for (int r = 0; r < 8; ++r) pa[r] = *(const f32x4*)(part_in + (size_t)(row0 + (r >> 2) * 128 + (r & 3) * 16) * 4);
#pragma unroll
            for (int r = 0; r < 8; ++r) rsv[r] = rsqrtf(((pa[r][0] + pa[r][1]) + (pa[r][2] + pa[r][3])) * inv_n + RMS_EPS);
        }
#pragma unroll
        for (int ai = 0; ai < 2; ++ai)
#pragma unroll
            for (int m = 0; m < 4; ++m) {
                const int row = row0 + ai * 128 + m * 16;
                const float r = rsv[ai * 4 + m] * mul;
                float sq = 0.f;
#pragma unroll
                for (int bj = 0; bj < 2; ++bj) {
                    const int c = col0 + bj * 128;
                    f32x4 v0 = acc[ai][bj][m][0] * r, v1 = acc[ai][bj][m][1] * r;
                    if (MODE == 2) {
                        const int cc = c % QKD;
                        if (cc >= 128) {
                            const int j0 = (cc - 128) >> 1;
                            const f32x4 cs = *(const f32x4*)(rc + (size_t)row * 32 + j0), sn = *(const f32x4*)(rs + (size_t)row * 32 + j0);
                            f32x4 a0, a1;
                            a0[0] = v0[0] * cs[0] - v0[1] * sn[0]; a0[1] = v0[0] * sn[0] + v0[1] * cs[0];
                            a0[2] = v0[2] * cs[1] - v0[3] * sn[1]; a0[3] = v0[2] * sn[1] + v0[3] * cs[1];
                            a1[0] = v1[0] * cs[2] - v1[1] * sn[2]; a1[1] = v1[0] * sn[2] + v1[1] * cs[2];
                            a1[2] = v1[2] * cs[3] - v1[3] * sn[3]; a1[3] = v1[2] * sn[3] + v1[3] * cs[3];
                            v0 = a0; v1 = a1;
                        }
                    }
                    if (MODE == 0) sq += (v0[0] * v0[0] + v0[1] * v0[1]) + (v0[2] * v0[2] + v0[3] * v0[3]) + (v1[0] * v1[0] + v1[1] * v1[1]) + (v1[2] * v1[2] + v1[3] * v1[3]);
                    u32x4 w; w.x = cvt_pk_bf16(v0[0], v0[1]); w.y = cvt_pk_bf16(v0[2], v0[3]); w.z = cvt_pk_bf16(v1[0], v1[1]); w.w = cvt_pk_bf16(v1[2], v1[3]);
                    if (MODE == 0) __builtin_nontemporal_store(w, (u32x4*)(O + (size_t)row * ldo + c)); else *(u32x4*)(O + (size_t)row * ldo + c) = w;
                }
                if (MODE == 0) {
                    if (u.pn < 3) {
                        sq += __shfl_xor(sq, 16); sq += __shfl_xor(sq, 32);
                        if (fq == 0) { if (u.pn < 2) part_q[(size_t)row * 8 + u.pn * 4 + wc] = sq; else part_kv[(size_t)row * 4 + wc] = sq; }
                    }
                }
            }
        if (MODE == 0 && rstd) {
#pragma unroll
            for (int r = 0; r < 8; ++r) rsn[r] = rsp[r];
        }
    }
};

struct Args { const void* in[32]; float* out; unsigned char* ws; int ph_lo, ph_hi; };

struct Ctx {
    const void* const* in; float* out; unsigned char* ws;
    LAS unsigned char* lds; int G, wg;
    __device__ __forceinline__ const float* fin(int i) const { return (const float*)in[i]; }
    template <class T> __device__ __forceinline__ T* at(size_t off) const { return (T*)(ws + off); }
    __device__ __forceinline__ Ctx fresh() const { Ctx c = *this; int z; asm volatile("s_mov_b32 %0, 0" : "=s"(z)); c.in = in + z; c.out = out + z; c.ws = ws + z; c.G = G + z; c.wg = wg + z; return c; }
};

enum { MAP_ID = 0, MAP_GU = 1, MAP_WIN = 2, MAP_UQ = 3 };
template <int MAP> __device__ __forceinline__ int src_col(int n) {
    if (MAP == MAP_WIN) { if (n >= NIN) return -1; if (n >= 768 && n < 832) { const int jj = n - 768; return 768 + (jj & 1) * 32 + (jj >> 1); } return n; }
    if (MAP == MAP_UQ) { const int h = n / QKD, cc = n % QKD; if (cc < 128) return n; const int jj = cc - 128; return h * QKD + 128 + (jj & 1) * 32 + (jj >> 1); }
    return n;
}
template <int MAP, bool F8 = false, bool HAD = false>
__device__ __forceinline__ void conv_job(const Ctx& C, int& toff, const float* src, const float* src2, int ldsrc, bf16_t* dst, int Ndst, int K, const float* gain, float qs = 1.0f) {
    LAS float* tile = (LAS float*)C.lds;
    const int tid = opaque_tid(), ntn = Ndst / 64, ntk = K / 256, ntiles = ntn * ntk;
    const int tfirst = (C.wg + C.G - toff % C.G) % C.G; toff += ntiles;
    for (int t = tfirst; t < ntiles; t += C.G) {
        const int tn = t % ntn, tk = t / ntn, n0 = tn * 64, k0 = tk * 256;
        {
            const int nl = tid & 63, kl0 = tid >> 6;
            const float* s = src; int col;
            if (MAP == MAP_GU) { const int n = n0 + nl, tt = n >> 8, r = n & 255; s = (r < 128) ? src : src2; col = tt * 128 + (r & 127); }
            else col = src_col<MAP>(n0 + nl);
            float v[32];
            const float* sp = s + (size_t)(k0 + kl0) * ldsrc + (col >= 0 ? col : 0);
#pragma unroll
            for (int i = 0; i < 32; ++i) v[i] = sp[(size_t)(8 * i) * ldsrc];
#pragma unroll
            for (int i = 0; i < 32; ++i) {
                float x = (col >= 0) ? v[i] : 0.f;
                if (gain) x *= gain[k0 + kl0 + 8 * i];
                if (F8) x *= qs;
                tile[(kl0 + 8 * i) * 65 + nl] = x;
            }
        }
        __syncthreads();
        {
            const int nl = tid >> 3, kc = (tid & 7) * 8;
#pragma unroll
            for (int q = 0; q < 4; ++q) {
                float v[8];
#pragma unroll
                for (int e = 0; e < 8; ++e) v[e] = tile[(q * 64 + kc + e) * 65 + nl];
                if (HAD) { fwht8(v);
#pragma unroll
                    for (int e = 0; e < 8; ++e) v[e] *= 0.35355339059327373f; }
                if (F8) {
                    u32x2 w8; w8.x = pk4_i8(v[0], v[1], v[2], v[3]); w8.y = pk4_i8(v[4], v[5], v[6], v[7]);
                    const int n_ = n0 + nl, kt_ = (k0 >> 7) + (q >> 1);
                    *(u32x2*)((unsigned char*)dst + (((size_t)(n_ >> 8) * (K >> 7) + kt_) * 256 + (n_ & 255)) * 128 + (q & 1) * 64 + kc) = w8;
                    continue;
                }
                u32x4 w; w.x = cvt_pk_bf16(v[0], v[1]); w.y = cvt_pk_bf16(v[2], v[3]); w.z = cvt_pk_bf16(v[4], v[5]); w.w = cvt_pk_bf16(v[6], v[7]);
                { const int n_ = n0 + nl, kt_ = (k0 >> 6) + q;
                  *(u32x4*)(dst + (((size_t)(n_ >> 8) * (K >> 6) + kt_) * 256 + (n_ & 255)) * 64 + kc) = w; }
            }
        }
        __syncthreads();
    }
}
template <bool GU, bool HAD>
__device__ __forceinline__ void conv_job_w(const Ctx& C, int& toff, const float* src, const float* src2, int ldsrc, unsigned char* dst, int Ndst, int K, const float* gain, float qs) {
    LAS float* tile = (LAS float*)C.lds;
    const int tid = opaque_tid(), ntn = Ndst / 256, ntk = K / 64, ntiles = ntn * ntk;
    const int tfirst = (C.wg + C.G - toff % C.G) % C.G; toff += ntiles;
    for (int t = tfirst; t < ntiles; t += C.G) {
        const int tn = t % ntn, tk = t / ntn, n0 = tn * 256, k0 = tk * 64;
        {
            const int n4 = tid & 63, kl0 = tid >> 6;
            const float* s = src; int col = n0 + 4 * n4;
            if (GU) { const int r = 4 * n4; s = (r < 128) ? src : src2; col = tn * 128 + (r & 127); }
            f32x4 v[8];
            const float* sp = s + (size_t)(k0 + kl0) * ldsrc + col;
#pragma unroll
            for (int i = 0; i < 8; ++i) v[i] = *(const f32x4*)(sp + (size_t)(8 * i) * ldsrc);
#pragma unroll
            for (int i = 0; i < 8; ++i) { float g = qs; if (gain) g *= gain[k0 + kl0 + 8 * i]; *(LAS f32x4*)(tile + (kl0 + 8 * i) * 260 + 4 * n4) = v[i] * g; }
        }
        __syncthreads();
#pragma unroll
        for (int j = 0; j < 4; ++j) {
            const int p = tid + 512 * j, kg = p & 7, nl = p >> 3;
            float v[8];
#pragma unroll
            for (int e = 0; e < 8; ++e) v[e] = tile[(kg * 8 + e) * 260 + nl];
            if (HAD) { fwht8(v);
#pragma unroll
                for (int e = 0; e < 8; ++e) v[e] *= 0.35355339059327373f; }
            u32x2 w8; w8.x = pk4_i8(v[0], v[1], v[2], v[3]); w8.y = pk4_i8(v[4], v[5], v[6], v[7]);
            const int n_ = n0 + nl, kk = k0 + kg * 8;
            *(u32x2*)(dst + (((size_t)(n_ >> 8) * (K >> 7) + (kk >> 7)) * 256 + (n_ & 255)) * 128 + (kk & 127)) = w8;
        }
        __syncthreads();
    }
}
__device__ __forceinline__ float wmax_scan(const Ctx& C, const float* w, const float* gain, float mx) {
    const int tid = opaque_tid();
    for (int k0 = C.wg; k0 < DM; k0 += 4 * C.G) {
        f32x4 v[4][3];
#pragma unroll
        for (int j = 0; j < 4; ++j) { const int k = k0 + j * C.G; const float* r = w + (size_t)(k < DM ? k : k0) * DFF;
#pragma unroll
            for (int i = 0; i < 3; ++i) { const int c = (i * 512 + tid) * 4; v[j][i] = *(const f32x4*)(r + (c < DFF ? c : 0)); } }
#pragma unroll
        for (int j = 0; j < 4; ++j) { const int k = k0 + j * C.G; float m = 0.f;
#pragma unroll
            for (int i = 0; i < 3; ++i) m = fmaxf(fmaxf(m, fmaxf(__builtin_fabsf(v[j][i][0]), __builtin_fabsf(v[j][i][1]))), fmaxf(__builtin_fabsf(v[j][i][2]), __builtin_fabsf(v[j][i][3])));
            mx = fmaxf(mx, m * __builtin_fabsf(gain[k < DM ? k : k0])); }
    }
    return mx;
}
__device__ __forceinline__ float wmax_scan_rot(const Ctx& C, const float* w) {
    const int tid = opaque_tid(); float mx = 0.f;
    for (int grp = C.wg; grp < DFF / 8; grp += C.G) {
        f32x4 v[8];
#pragma unroll
        for (int j = 0; j < 8; ++j) v[j] = *(const f32x4*)(w + (size_t)(grp * 8 + j) * DM + tid * 4);
#pragma unroll
        for (int c = 0; c < 4; ++c) { float t[8];
#pragma unroll
            for (int j = 0; j < 8; ++j) t[j] = v[j][c];
            fwht8(t);
#pragma unroll
            for (int j = 0; j < 8; ++j) mx = fmaxf(mx, __builtin_fabsf(t[j] * 0.35355339059327373f)); }
    }
    return mx;
}
__device__ __forceinline__ void phase_convert(const Ctx& C, int l, const XcdBarrier& bar) {
    const size_t offGU = (size_t)l * DM * DFF, offD = (size_t)l * DFF * DM; int toff = 0;
    unsigned* wm = C.at<unsigned>(WS_CTL + CW_WMAX) + l * 2;
    {
#pragma unroll
        for (int f = 0; f < 2; ++f) {
            float mx = wmax_scan(C, C.fin(f ? 28 : 3) + offGU, C.fin(f ? 27 : 2) + l * DM, 0.f);
            mx = wmax_scan(C, C.fin(f ? 29 : 4) + offGU, C.fin(f ? 27 : 2) + l * DM, mx);
#pragma unroll
            for (int o = 32; o >= 1; o >>= 1) mx = fmaxf(mx, __shfl_xor(mx, o));
            if ((opaque_tid() & 63) == 0) __hip_atomic_fetch_max(wm + f, __float_as_uint(mx), __ATOMIC_RELAXED, __HIP_MEMORY_SCOPE_AGENT);
            float md = wmax_scan_rot(C, C.fin(f ? 30 : 5) + offD);
#pragma unroll
            for (int o = 32; o >= 1; o >>= 1) md = fmaxf(md, __shfl_xor(md, o));
            if ((opaque_tid() & 63) == 0) __hip_atomic_fetch_max(wm + 8 + f, __float_as_uint(md), __ATOMIC_RELAXED, __HIP_MEMORY_SCOPE_AGENT);
        }
        xcd_barrier(bar);
    }
    const float wmaxd1 = __uint_as_float(__hip_atomic_load(wm + 8, __ATOMIC_RELAXED, __HIP_MEMORY_SCOPE_AGENT)), wmaxd2 = __uint_as_float(__hip_atomic_load(wm + 9, __ATOMIC_RELAXED, __HIP_MEMORY_SCOPE_AGENT));
    const float qd1 = wmaxd1 > 0.f ? 127.0f / wmaxd1 : 0.f, qd2 = wmaxd2 > 0.f ? 127.0f / wmaxd2 : 0.f;
    const float wmax1 = __uint_as_float(__hip_atomic_load(wm + 0, __ATOMIC_RELAXED, __HIP_MEMORY_SCOPE_AGENT)), wmax2 = __uint_as_float(__hip_atomic_load(wm + 1, __ATOMIC_RELAXED, __HIP_MEMORY_SCOPE_AGENT));
    const float qs1 = wmax1 > 0.f ? 127.0f / wmax1 : 0.f, qs2 = wmax2 > 0.f ? 127.0f / wmax2 : 0.f;
    conv_job_w<false, true>(C, toff, C.fin(30) + offD, nullptr, DM, C.at<unsigned char>(WS_W2D), DM, DFF, nullptr, qd2);
    conv_job_w<true, false>(C, toff, C.fin(28) + offGU, C.fin(29) + offGU, DFF, C.at<unsigned char>(WS_W2GU), 2 * DFF, DM, C.fin(27) + l * DM, qs2);
    conv_job_w<false, true>(C, toff, C.fin(5) + offD, nullptr, DM, C.at<unsigned char>(WS_W1D), DM, DFF, nullptr, qd1);
    conv_job_w<true, false>(C, toff, C.fin(3) + offGU, C.fin(4) + offGU, DFF, C.at<unsigned char>(WS_W1GU), 2 * DFF, DM, C.fin(2) + l * DM, qs1);
    conv_job<MAP_WIN>(C, toff, C.fin(7) + (size_t)l * DM * NIN, nullptr, NIN, C.at<bf16_t>(WS_WIN), NINP, DM, C.fin(6) + l * DM);
    conv_job<MAP_UQ>(C, toff, C.fin(10) + (size_t)l * QL * NQ, nullptr, NQ, C.at<bf16_t>(WS_WUQ), NQ, QL, C.fin(8) + l * QL);
    conv_job<MAP_ID>(C, toff, C.fin(11) + (size_t)l * KVL * NKV, nullptr, NKV, C.at<bf16_t>(WS_WUKV), NKV, KVL, C.fin(9) + l * KVL);
    conv_job<MAP_ID>(C, toff, C.fin(26) + (size_t)l * DM * DM, nullptr, DM, C.at<bf16_t>(WS_WOUT), DM, DM, nullptr);
    {
        const int tid = opaque_tid(); bf16_t* Ub = C.at<bf16_t>(WS_LORA);
        const float* dU = C.fin(15) + (size_t)l * 32 * BW; const float* iU = C.fin(17) + (size_t)l * 32 * BW; const float* gU = C.fin(18) + (size_t)l * 96 * BW;
        for (int e = C.wg * NTHREADS + tid; e < 512 * 160; e += C.G * NTHREADS) {
            const int k = e >> 9, n = e & 511;
            const float v = (k < 32) ? dU[k * BW + n] : (k < 64 ? iU[(k - 32) * BW + n] : gU[(k - 64) * BW + n]);
            Ub[n * 160 + k] = f2bf(v);
        }
    }
}

__device__ __forceinline__ void phase_prologue(const Ctx& C) {
    const int tid = opaque_tid(), lane = tid & 63, wv = tid >> 6;
    const float* x = C.fin(0); bf16_t* hb = C.at<bf16_t>(WS_HB); float* part = C.at<float>(WS_PARTH); unsigned char* h8 = C.at<unsigned char>(WS_H8);
    for (int row = C.wg * 8 + wv; row < MTOK; row += C.G * 8) {
        float s = 0.f, mx = 0.f; f32x4 v[8];
#pragma unroll
        for (int i = 0; i < 8; ++i) {
            const size_t off = (size_t)row * DM + (i * 64 + lane) * 4;
            v[i] = *(const f32x4*)(x + off);
            u32x2 w; w.x = cvt_pk_bf16(v[i][0], v[i][1]); w.y = cvt_pk_bf16(v[i][2], v[i][3]);
            *(u32x2*)(hb + off) = w;
            s += (v[i][0] * v[i][0] + v[i][1] * v[i][1]) + (v[i][2] * v[i][2] + v[i][3] * v[i][3]);
            mx = fmaxf(fmaxf(mx, fmaxf(__builtin_fabsf(v[i][0]), __builtin_fabsf(v[i][1]))), fmaxf(__builtin_fabsf(v[i][2]), __builtin_fabsf(v[i][3])));
        }
        s = wave_sum(s);
#pragma unroll
        for (int o = 32; o >= 1; o >>= 1) mx = fmaxf(mx, __shfl_xor(mx, o));
        const float qs = mx > 0.f ? 127.0f / mx : 0.f;
#pragma unroll
        for (int i = 0; i < 8; ++i) *(unsigned*)(h8 + (size_t)row * DM + (i * 64 + lane) * 4) = pk4_i8(v[i][0] * qs, v[i][1] * qs, v[i][2] * qs, v[i][3] * qs);
        if (lane < 32) part[(size_t)row * 32 + lane] = (lane == 0) ? s : 0.f;
        const float rstd = rsqrtf(s * (1.0f / DM) + RMS_EPS);
        if (lane == 0) { C.at<float>(WS_RSTD)[row] = rstd; C.at<float>(WS_RSA)[row] = rstd * (mx * (1.0f / 127.0f)); C.at<unsigned>(WS_AMAX)[row] = 0u; C.at<unsigned>(WS_AMAX2)[row] = 0u; }
    }
    const int* pos = (const int*)C.in[1]; float* rc = C.at<float>(WS_ROPEC); float* rs = C.at<float>(WS_ROPES);
    for (int i = C.wg * NTHREADS + tid; i < MTOK * 32; i += C.G * NTHREADS) {
        const int m = i >> 5, j = i & 31;
        const float inv = 1.0f / powf(10000.0f, (float)(2 * j) * (1.0f / 64.0f));
        const float ang = (float)pos[m] * inv;
        const double ad = (double)ang; const double n = rint(ad * 0.15915494309189535); const float red = (float)(ad - n * 6.283185307179586);
        rc[i] = cosf(red); rs[i] = sinf(red);
    }
}

__device__ __forceinline__ void rstd_pass(const Ctx& C) {
    const int tid = opaque_tid();
    const float* part = C.at<float>(WS_PARTH); float* rstd = C.at<float>(WS_RSTD);
    for (int row = C.wg * 128 + (tid >> 2); row < MTOK; row += C.G * 128) {
        const float* p = part + (size_t)row * 32 + (tid & 3) * 8;
        const f32x4 a = *(const f32x4*)p, b = *(const f32x4*)(p + 4);
        float sm = ((a[0] + a[1]) + (a[2] + a[3])) + ((b[0] + b[1]) + (b[2] + b[3]));
        sm += dpp_mov<0xB1>(sm); sm += dpp_mov<0x4E>(sm);
        if ((tid & 3) == 0) rstd[row] = rsqrtf(sm * (1.0f / DM) + RMS_EPS);
    }
}

__device__ __forceinline__ void quant_pass(const Ctx& C) {
    const int tid = opaque_tid(), lane = tid & 63, wv = tid >> 6;
    const bf16_t* hb = C.at<bf16_t>(WS_HB); unsigned char* h8 = C.at<unsigned char>(WS_H8); float* rsa = C.at<float>(WS_RSA);
    for (int row0 = (C.wg * 8 + wv) * 2; row0 < MTOK; row0 += C.G * 16) {
        u32x4 w[2][4];
#pragma unroll
        for (int r = 0; r < 2; ++r)
#pragma unroll
            for (int i = 0; i < 4; ++i) w[r][i] = *(const u32x4*)(hb + (size_t)(row0 + r) * DM + (i * 64 + lane) * 8);
#pragma unroll
        for (int r = 0; r < 2; ++r) {
            float v[4][8]; float s = 0.f, mx = 0.f;
#pragma unroll
            for (int i = 0; i < 4; ++i) {
                v[i][0] = __uint_as_float(w[r][i].x << 16); v[i][1] = __uint_as_float(w[r][i].x & 0xffff0000u); v[i][2] = __uint_as_float(w[r][i].y << 16); v[i][3] = __uint_as_float(w[r][i].y & 0xffff0000u);
                v[i][4] = __uint_as_float(w[r][i].z << 16); v[i][5] = __uint_as_float(w[r][i].z & 0xffff0000u); v[i][6] = __uint_as_float(w[r][i].w << 16); v[i][7] = __uint_as_float(w[r][i].w & 0xffff0000u);
#pragma unroll
                for (int e = 0; e < 8; ++e) { s += v[i][e] * v[i][e]; mx = fmaxf(mx, __builtin_fabsf(v[i][e])); }
            }
            s = wave_sum_fast(s);
#pragma unroll
            for (int o = 32; o >= 1; o >>= 1) mx = fmaxf(mx, __shfl_xor(mx, o));
            const float qs = mx > 0.f ? 127.0f / mx : 0.f;
#pragma unroll
            for (int i = 0; i < 4; ++i) { u32x2 q; q.x = pk4_i8(v[i][0] * qs, v[i][1] * qs, v[i][2] * qs, v[i][3] * qs); q.y = pk4_i8(v[i][4] * qs, v[i][5] * qs, v[i][6] * qs, v[i][7] * qs);
                *(u32x2*)(h8 + (size_t)(row0 + r) * DM + (i * 64 + lane) * 8) = q; }
            if (lane == 0) rsa[row0 + r] = rsqrtf(s * (1.0f / DM) + RMS_EPS) * (mx * (1.0f / 127.0f));
        }
    }
}

__device__ __forceinline__ void actq_pass(const Ctx& C, size_t amax_off, size_t amax_other, const float* wmax) {
    const int tid = opaque_tid(), lane = tid & 63, wv = tid >> 6, pc = lane & 3;
    const bf16_t* act = C.at<bf16_t>(WS_ACT); unsigned char* a8 = C.at<unsigned char>(WS_ACT8);
    for (int item = C.wg; item < (MTOK / 256) * 2; item += C.G) {
        const int pm = item >> 1, hk = item & 1;
        int rr[2]; float qs[2];
#pragma unroll
        for (int sg = 0; sg < 2; ++sg) {
            rr[sg] = wv * 32 + sg * 16 + (lane >> 2); const int row = pm * 256 + rr[sg];
            const float mx = __uint_as_float(C.at<unsigned>(amax_off)[row]);
            qs[sg] = mx > 0.f ? 127.0f / mx : 0.f;
            if (hk == 0 && pc == 0) {
                const float rs = C.at<float>(WS_RSA)[row] * (*wmax * (1.0f / 127.0f));
                C.at<float>(WS_ASC)[row] = mx * (1.0f / 127.0f) * (rs * rs * 0.35355339059327373f); C.at<unsigned>(amax_other)[row] = 0u; }
        }
#pragma nounroll
        for (int kt0 = hk * (DFF / 128); kt0 < (hk + 1) * (DFF / 128); kt0 += 4) {
            u32x4 w[4][2][2];
#pragma unroll
            for (int t = 0; t < 4; ++t)
#pragma unroll
                for (int jh = 0; jh < 2; ++jh)
#pragma unroll
                    for (int sg = 0; sg < 2; ++sg) w[t][jh][sg] = __builtin_nontemporal_load((const u32x4*)(act + ((((size_t)pm * (DFF / 64) + kt0 + t) * 2 + jh) * 256 + rr[sg]) * 32 + pc * 8));
#pragma unroll
            for (int t = 0; t < 4; ++t) {
                const int kt = kt0 + t;
                unsigned char* blk = a8 + (((size_t)pm * (DFF / 128) + (kt >> 1)) * 2 + (kt & 1)) * (256 * 64);
#pragma unroll
                for (int sg = 0; sg < 2; ++sg)
#pragma unroll
                    for (int jh = 0; jh < 2; ++jh) {
                        const u32x4 x = w[t][jh][sg]; const float q = qs[sg];
                        u32x2 o;
                        o.x = pk4_i8(__uint_as_float(x.x << 16) * q, __uint_as_float(x.x & 0xffff0000u) * q, __uint_as_float(x.y << 16) * q, __uint_as_float(x.y & 0xffff0000u) * q);
                        o.y = pk4_i8(__uint_as_float(x.z << 16) * q, __uint_as_float(x.z & 0xffff0000u) * q, __uint_as_float(x.w << 16) * q, __uint_as_float(x.w & 0xffff0000u) * q);
                        *(u32x2*)(blk + rr[sg] * 64 + jh * 32 + pc * 8) = o;
                    }
            }
        }
    }
}

__device__ __forceinline__ void prep_phase(const Ctx& C, int l) {
    const int tid = opaque_tid(), lane = tid & 63, wv = __builtin_amdgcn_readfirstlane(tid >> 6);
    const bf16_t* P = C.at<bf16_t>(WS_P);
    LAS bf16_t* Lin = (LAS bf16_t*)C.lds;
    LAS float* Lout = (LAS float*)(C.lds + 8192);
    const float* mu = C.fin(13) + l * 1696;
    const int c = tid;
    const float w0 = C.fin(14)[l * BW + c], a0 = C.fin(16)[l * BW + c], kkc = C.fin(19)[l * BW + c], kac = C.fin(20)[l * BW + c];
    const float mur = mu[c], muk = mu[512 + c], muv = mu[1024 + c];
    const float rkc = C.fin(21)[l * BW + c];
    const float cw0 = C.fin(24)[l * 1536 + c], cw1 = C.fin(24)[l * 1536 + 512 + c], cw2 = C.fin(24)[l * 1536 + 1024 + c], gn = C.fin(25)[l * BW + c];
    const int n = lane & 15, kg = lane >> 4;
#pragma nounroll
    for (int item = C.wg; item < MTOK / 16; item += C.G) {
        const int tid = opaque_tid(), lane = tid & 63, c = tid, n = lane & 15, kg = lane >> 4;
        const int b = item >> 7, t0 = (item & 127) * 16;
        const size_t m0 = (size_t)b * SEQ + t0;
        bf16x8 bfr[4][5];
        {
            const bf16_t* Ub = C.at<bf16_t>(WS_LORA) + (size_t)(wv * 64 + n) * 160 + kg * 8;
#pragma unroll
            for (int nt = 0; nt < 4; ++nt)
#pragma unroll
                for (int ks = 0; ks < 5; ++ks) bfr[nt][ks] = *(const bf16x8*)(Ub + nt * 16 * 160 + ks * 32);
        }
        for (int e = tid; e < 2560; e += NTHREADS) {
            const int tt = e / 160, j = e - tt * 160, col = 2368 + j;
            const float cur = bf2f(P[(m0 + tt) * NINP + col]);
            const float prev = (t0 + tt > 0) ? bf2f(P[(m0 + tt - 1) * NINP + col]) : 0.f;
            float xs = cur + (prev - cur) * mu[1536 + j];
            if (j < 32) xs = tanhf(xs); else if (j >= 64) xs = sigmoid_fast(xs);
            Lin[tt * 168 + j] = f2bf(xs);
        }
        __syncthreads();
        {
            bf16x8 af[5];
#pragma unroll
            for (int ks = 0; ks < 5; ++ks) af[ks] = *(const LAS bf16x8*)(Lin + n * 168 + ks * 32 + kg * 8);
#pragma unroll
            for (int nt = 0; nt < 4; ++nt) {
                const f32x4 z = {0.f, 0.f, 0.f, 0.f};
                const f32x4 cw = __builtin_amdgcn_mfma_f32_16x16x32_bf16(af[0], bfr[nt][0], z, 0, 0, 0);
                const f32x4 ca = __builtin_amdgcn_mfma_f32_16x16x32_bf16(af[1], bfr[nt][1], z, 0, 0, 0);
                f32x4 cg = __builtin_amdgcn_mfma_f32_16x16x32_bf16(af[2], bfr[nt][2], z, 0, 0, 0);
                cg = __builtin_amdgcn_mfma_f32_16x16x32_bf16(af[3], bfr[nt][3], cg, 0, 0, 0);
                cg = __builtin_amdgcn_mfma_f32_16x16x32_bf16(af[4], bfr[nt][4], cg, 0, 0, 0);
                const int ch = wv * 64 + nt * 16 + n;
#pragma unroll
                for (int j = 0; j < 4; ++j) { const int tok = kg * 4 + j;
                    Lout[tok * 512 + ch] = cw[j]; Lout[8192 + tok * 512 + ch] = ca[j]; Lout[16384 + tok * 512 + ch] = cg[j]; }
            }
        }
        __syncthreads();
        unsigned tA[8], tB[8], tK[8], tR[8], tV[8]; float PCv;
        {
            float pr = 0.f, pk = 0.f, pv = 0.f, um2 = 0.f, um1 = 0.f;
            if (t0 > 0) { const bf16_t* pp = P + (m0 - 1) * NINP + c; pr = bf2f(pp[PB0]); pk = bf2f(pp[PB0 + 512]); pv = bf2f(pp[PB0 + 1024]);
                um1 = bf2f(pp[PC0 + 512]) * bf2f(pp[PC0 + 1024]); const bf16_t* p2 = pp - NINP; um2 = bf2f(p2[PC0 + 512]) * bf2f(p2[PC0 + 1024]); }
            bf16_t* Gp = C.at<bf16_t>(WS_G) + m0 * BW + c;
            bf16_t* Bvp = C.at<bf16_t>(WS_BV) + m0 * BW + c;
            bf16_t* Y = C.at<bf16_t>(WS_Y) + m0 * DM + 1536 + c;
            float Pc = 1.0f;
            float sA[2], sB[2], sK[2], sR[2], sV[2];
#pragma unroll
            for (int hb8 = 0; hb8 < 2; ++hb8) {
                bf16_t raw[8][6];
#pragma unroll
                for (int i = 0; i < 8; ++i) { const bf16_t* pp = P + (m0 + hb8 * 8 + i) * NINP + c;
                    raw[i][0] = pp[PB0]; raw[i][1] = pp[PB0 + 512]; raw[i][2] = pp[PB0 + 1024]; raw[i][3] = pp[PC0]; raw[i][4] = pp[PC0 + 512]; raw[i][5] = pp[PC0 + 1024]; }
#pragma unroll
                for (int i = 0; i < 8; ++i) {
                    const int tt = hb8 * 8 + i;
                    const float cr = bf2f(raw[i][0]), ck = bf2f(raw[i][1]), cv = bf2f(raw[i][2]);
                    const float r = cr + (pr - cr) * mur, k = ck + (pk - ck) * muk, v = cv + (pv - cv) * muv;
                    pr = cr; pk = ck; pv = cv;
                    const float decay = __builtin_amdgcn_exp2f(-0.6065306597126334f * 1.4426950408889634f * sigmoid_fast(w0 + Lout[tt * 512 + c]));
                    const float a = sigmoid_fast(a0 + Lout[8192 + tt * 512 + c]);
                    float kk = k * kkc;
                    const float ss = wave_sum_fast(kk * kk);
                    kk = kk * __builtin_amdgcn_rsqf(fmaxf(ss, 1e-24f));
                    const float kmod = k * (1.0f + (a - 1.0f) * kac);
                    const float bonus = wave_sum_fast(r * kmod * rkc);
                    Bvp[(size_t)tt * BW] = f2bf(bonus * v);
                    Gp[(size_t)tt * BW] = f2bf(Lout[16384 + tt * 512 + c]);
                    const float Pprev = Pc; Pc = Pc * decay; const float invP = __builtin_amdgcn_rcpf(Pc);
                    sA[i & 1] = -kk * Pprev; sB[i & 1] = kk * a * invP; sK[i & 1] = kmod * invP; sR[i & 1] = r * Pc; sV[i & 1] = v;
                    if (i & 1) { tA[tt >> 1] = cvt_pk_bf16(sA[0], sA[1]); tB[tt >> 1] = cvt_pk_bf16(sB[0], sB[1]); tK[tt >> 1] = cvt_pk_bf16(sK[0], sK[1]); tR[tt >> 1] = cvt_pk_bf16(sR[0], sR[1]); tV[tt >> 1] = cvt_pk_bf16(sV[0], sV[1]); }
                    const float bg = bf2f(raw[i][3]), u = bf2f(raw[i][4]) * bf2f(raw[i][5]);
                    const float yv = cw0 * um2 + cw1 * um1 + cw2 * u;
                    um2 = um1; um1 = u;
                    const float z = bg * yv;
                    const float s2 = wave_sum_fast(z * z);
                    Y[(size_t)tt * DM] = f2bf(z * __builtin_amdgcn_rsqf(s2 * (1.0f / 64.0f) + RMS_EPS) * gn);
                }
            }
            PCv = Pc;
        }
        {
            const int tt = tid >> 5, i = tid & 31; const size_t m = m0 + tt;
            const unsigned pr2 = *(const unsigned*)(P + m * NINP + 768 + 2 * i);
            const float x1 = __uint_as_float(pr2 << 16), x2 = __uint_as_float(pr2 & 0xffff0000u);
            const float cs = C.at<float>(WS_ROPEC)[m * 32 + i], sn = C.at<float>(WS_ROPES)[m * 32 + i];
            *(unsigned*)(C.at<bf16_t>(WS_KR) + m * 64 + 2 * i) = cvt_pk_bf16(x1 * cs - x2 * sn, x1 * sn + x2 * cs);
        }
        __syncthreads();
        {
            LAS unsigned char* HB = C.lds + 8192 + wv * 16384;
            LAS bf16_t* tl = (LAS bf16_t*)HB;
            LAS float* mats = (LAS float*)(HB + 8192);
#pragma unroll
            for (int p2 = 0; p2 < 8; ++p2) {
                tl[(2 * p2) * 64 + lane] = (bf16_t)(tA[p2] & 0xffffu); tl[(2 * p2 + 1) * 64 + lane] = (bf16_t)(tA[p2] >> 16);
                tl[1024 + (2 * p2) * 64 + lane] = (bf16_t)(tB[p2] & 0xffffu); tl[1024 + (2 * p2 + 1) * 64 + lane] = (bf16_t)(tB[p2] >> 16);
                tl[2048 + (2 * p2) * 64 + lane] = (bf16_t)(tK[p2] & 0xffffu); tl[2048 + (2 * p2 + 1) * 64 + lane] = (bf16_t)(tK[p2] >> 16);
                tl[3072 + (2 * p2) * 64 + lane] = (bf16_t)(tR[p2] & 0xffffu); tl[3072 + (2 * p2 + 1) * 64 + lane] = (bf16_t)(tR[p2] >> 16);
            }
            {
                bf16x8 fa[2], fb[2], fk[2], fr[2];
#pragma unroll
                for (int ks = 0; ks < 2; ++ks) { const int o = n * 64 + ks * 32 + kg * 8;
                    fa[ks] = *(const LAS bf16x8*)(tl + o); fb[ks] = *(const LAS bf16x8*)(tl + 1024 + o); fk[ks] = *(const LAS bf16x8*)(tl + 2048 + o); fr[ks] = *(const LAS bf16x8*)(tl + 3072 + o); }
                const f32x4 z = {0.f, 0.f, 0.f, 0.f};
                f32x4 gN = __builtin_amdgcn_mfma_f32_16x16x32_bf16(fb[0], fa[0], z, 0, 0, 0); gN = __builtin_amdgcn_mfma_f32_16x16x32_bf16(fb[1], fa[1], gN, 0, 0, 0);
                f32x4 gM = __builtin_amdgcn_mfma_f32_16x16x32_bf16(fk[0], fa[0], z, 0, 0, 0); gM = __builtin_amdgcn_mfma_f32_16x16x32_bf16(fk[1], fa[1], gM, 0, 0, 0);
                f32x4 gB = __builtin_amdgcn_mfma_f32_16x16x32_bf16(fb[0], fr[0], z, 0, 0, 0); gB = __builtin_amdgcn_mfma_f32_16x16x32_bf16(fb[1], fr[1], gB, 0, 0, 0);
                f32x4 gK = __builtin_amdgcn_mfma_f32_16x16x32_bf16(fk[0], fr[0], z, 0, 0, 0); gK = __builtin_amdgcn_mfma_f32_16x16x32_bf16(fk[1], fr[1], gK, 0, 0, 0);
#pragma unroll
                for (int j = 0; j < 4; ++j) { const int i = 4 * kg + j; if (!(i < n)) { gN[j] = 0.f; gM[j] = 0.f; } if (!(i <= n)) { gB[j] = 0.f; gK[j] = 0.f; } }
                *(LAS f32x4*)(mats + n * 16 + 4 * kg) = gN; *(LAS f32x4*)(mats + 256 + n * 16 + 4 * kg) = gM;
                *(LAS f32x4*)(mats + 512 + n * 16 + 4 * kg) = gB; *(LAS f32x4*)(mats + 768 + n * 16 + 4 * kg) = gK;
            }
            float Tr[16], TEr[16];
#pragma unroll
            for (int t = 0; t < 16; ++t) {
                float nr[16];
#pragma unroll
                for (int q4 = 0; q4 < 4; ++q4) { const f32x4 x = *(const LAS f32x4*)(mats + t * 16 + 4 * q4); nr[4 * q4] = x[0]; nr[4 * q4 + 1] = x[1]; nr[4 * q4 + 2] = x[2]; nr[4 * q4 + 3] = x[3]; }
                float acc = (n == t) ? 1.0f : 0.0f;
#pragma unroll
                for (int s2 = 0; s2 < t; ++s2) acc += Tr[s2] * nr[s2];
                Tr[t] = acc;
                asm volatile("" ::: "memory");
            }
#pragma unroll
            for (int t = 0; t < 16; ++t) {
                float er[16];
#pragma unroll
                for (int q4 = 0; q4 < 4; ++q4) { const f32x4 x = *(const LAS f32x4*)(mats + 512 + t * 16 + 4 * q4); er[4 * q4] = x[0]; er[4 * q4 + 1] = x[1]; er[4 * q4 + 2] = x[2]; er[4 * q4 + 3] = x[3]; }
                float acc = 0.f;
#pragma unroll
                for (int s2 = 0; s2 <= t; ++s2) acc += Tr[s2] * er[s2];
                TEr[t] = acc;
                asm volatile("" ::: "memory");
            }
            LAS float* Tt = mats + 1024; LAS float* TEt = mats + 1280;
#pragma unroll
            for (int t = 0; t < 16; ++t) { Tt[t * 16 + n] = Tr[t]; TEt[t * 16 + n] = TEr[t]; }
            float Mr[16];
#pragma unroll
            for (int s2 = 0; s2 < 16; ++s2) Mr[s2] = mats[256 + s2 * 16 + n];
            unsigned char* CBg = C.ws + WS_SCAN + ((size_t)(b * 8 + wv) * (SEQ / 16) + (t0 >> 4)) * CB_BYTES;
            bf16_t* WAg = (bf16_t*)(CBg + CB_WA); bf16_t* QAg = (bf16_t*)(CBg + CB_QA); bf16_t* MTg = (bf16_t*)(CBg + CB_MT); bf16_t* Q2g = (bf16_t*)(CBg + CB_Q2);
            const int wks = lane >> 5, wq = (lane >> 2) & 3, we = 4 * ((lane >> 4) & 1) + (lane & 3);
#pragma unroll
            for (int t = 0; t < 16; ++t) {
                float trw[16], tew[16];
#pragma unroll
                for (int q4 = 0; q4 < 4; ++q4) { const f32x4 x = *(const LAS f32x4*)(Tt + t * 16 + 4 * q4), y = *(const LAS f32x4*)(TEt + t * 16 + 4 * q4);
                    trw[4 * q4] = x[0]; trw[4 * q4 + 1] = x[1]; trw[4 * q4 + 2] = x[2]; trw[4 * q4 + 3] = x[3]; tew[4 * q4] = y[0]; tew[4 * q4 + 1] = y[1]; tew[4 * q4 + 2] = y[2]; tew[4 * q4 + 3] = y[3]; }
                float w1 = 0.f, q1 = (t & 1) ? __uint_as_float(tR[t >> 1] & 0xffff0000u) : __uint_as_float(tR[t >> 1] << 16), mtv = 0.f, q2v = mats[768 + t * 16 + n];
#pragma unroll
                for (int s2 = 0; s2 <= t; ++s2) { const float as = (s2 & 1) ? __uint_as_float(tA[s2 >> 1] & 0xffff0000u) : __uint_as_float(tA[s2 >> 1] << 16);
                    w1 += as * trw[s2]; q1 += as * tew[s2]; mtv += Mr[s2] * trw[s2]; q2v += Mr[s2] * tew[s2]; }
                const int wi = ((wks * 16 + t) * 4 + wq) * 8 + we;
                WAg[wi] = f2bf(w1); QAg[wi] = f2bf(q1);
                if (lane < 16) { MTg[t * 16 + lane] = f2bf(mtv); Q2g[t * 16 + lane] = f2bf(q2v); }
                asm volatile("" ::: "memory");
            }
            {
                u32x4* BKg = (u32x4*)(CBg + CB_BK + lane * 64);
#pragma unroll
                for (int g4 = 0; g4 < 4; ++g4) {
                    const float b0 = __uint_as_float(tB[2 * g4] << 16) * PCv, b1 = __uint_as_float(tB[2 * g4] & 0xffff0000u) * PCv, b2 = __uint_as_float(tB[2 * g4 + 1] << 16) * PCv, b3 = __uint_as_float(tB[2 * g4 + 1] & 0xffff0000u) * PCv;
                    const float k0 = __uint_as_float(tK[2 * g4] << 16) * PCv, k1 = __uint_as_float(tK[2 * g4] & 0xffff0000u) * PCv, k2 = __uint_as_float(tK[2 * g4 + 1] << 16) * PCv, k3 = __uint_as_float(tK[2 * g4 + 1] & 0xffff0000u) * PCv;
                    u32x4 w; w.x = cvt_pk_bf16(b0, b1); w.y = cvt_pk_bf16(b2, b3); w.z = cvt_pk_bf16(k0, k1); w.w = cvt_pk_bf16(k2, k3);
                    BKg[g4] = w;
                }
                ((float*)(CBg + CB_PC))[lane] = PCv;
                u32x4* VTg = (u32x4*)(CBg + CB_VT + lane * 32);
                VTg[0] = (u32x4){tV[0], tV[1], tV[2], tV[3]}; VTg[1] = (u32x4){tV[4], tV[5], tV[6], tV[7]};
            }
        }
        __syncthreads();
    }
}

constexpr int SC_GRP = 2, SC_STG = SC_GRP * CB_BYTES;
constexpr int SC_YB = SC_GRP * 16 * 64;
struct ScanPostConst { f32x4 gain0, gain1, bias0, bias1; };
struct ScanPostIn { u32x4 bw, gw; };
__device__ __forceinline__ ScanPostIn scan_post_load(const bf16_t* Bvp, const bf16_t* Gp, size_t tok0, int tl0, int lane) {
    const int tl = tl0 + (lane >> 3), q = lane & 7; const size_t tok = tok0 + tl; ScanPostIn r;
    r.bw = *(const u32x4*)(Bvp + tok * BW + q * 8); r.gw = *(const u32x4*)(Gp + tok * BW + q * 8);
    return r;
}
__device__ __forceinline__ f32x4 bf4_lo(const u32x4& w) { return (f32x4){__uint_as_float(w.x << 16), __uint_as_float(w.x & 0xffff0000u), __uint_as_float(w.y << 16), __uint_as_float(w.y & 0xffff0000u)}; }
__device__ __forceinline__ f32x4 bf4_hi(const u32x4& w) { return (f32x4){__uint_as_float(w.z << 16), __uint_as_float(w.z & 0xffff0000u), __uint_as_float(w.w << 16), __uint_as_float(w.w & 0xffff0000u)}; }
__device__ __forceinline__ void scan_post(LAS float* yb, const ScanPostIn& I, bf16_t* Yp, size_t tok0, int tl0, int lane, const ScanPostConst& K) {
    const int tl = tl0 + (lane >> 3), q = lane & 7; const size_t tok = tok0 + tl;
    const f32x4 y0 = *(const LAS f32x4*)(yb + tl * 64 + q * 8), y1 = *(const LAS f32x4*)(yb + tl * 64 + q * 8 + 4);
    const f32x4 ys = y0 + y1;
    const float mean = red8((ys[0] + ys[1]) + (ys[2] + ys[3])) * (1.0f / 64.0f);
    const f32x4 d0 = y0 - mean, d1 = y1 - mean;
    const f32x4 dq = d0 * d0 + d1 * d1;
    const float var = red8((dq[0] + dq[1]) + (dq[2] + dq[3])) * (1.0f / 64.0f);
    const float rstd = __builtin_amdgcn_rsqf(var + 64e-5f);
    const f32x4 o0 = (d0 * rstd * K.gain0 + K.bias0 + bf4_lo(I.bw)) * bf4_lo(I.gw), o1 = (d1 * rstd * K.gain1 + K.bias1 + bf4_hi(I.bw)) * bf4_hi(I.gw);
    u32x4 w; w.x = cvt_pk_bf16(o0[0], o0[1]); w.y = cvt_pk_bf16(o0[2], o0[3]); w.z = cvt_pk_bf16(o1[0], o1[1]); w.w = cvt_pk_bf16(o1[2], o1[3]);
    *(u32x4*)(Yp + tok * DM + q * 8) = w;
}
__device__ __forceinline__ void scan_unit(const Ctx& C, int l, int bh) {
    const int tid = opaque_tid(), lane = tid & 63, wv = __builtin_amdgcn_readfirstlane(tid >> 6);
    LAS unsigned char* stg = C.lds;
    LAS float* ybuf = (LAS float*)(C.lds + 2 * SC_STG);
    const unsigned char* src = C.ws + WS_SCAN + (size_t)bh * (SEQ / 16) * CB_BYTES;
    const int b = bh >> 3, h = bh & 7;
    constexpr int NGRP = SEQ / 16 / SC_GRP;
    for (int i = tid; i < SC_STG / 16; i += NTHREADS) *(LAS u32x4*)(stg + i * 16) = *(const u32x4*)(src + (size_t)i * 16);
    __syncthreads();
    if (wv < 4) {
        const int vq = lane & 15, q = lane >> 4;
        f32x4 S[4];
#pragma unroll
        for (int m = 0; m < 4; ++m) S[m] = (f32x4){0.f, 0.f, 0.f, 0.f};
        const bf16x8 zf = {0, 0, 0, 0, 0, 0, 0, 0};
#pragma nounroll
        for (int g = 0; g < NGRP; ++g) {
            LAS unsigned char* sb = stg + (g & 1) * SC_STG;
            LAS float* yb = ybuf + (g & 1) * SC_YB;
#pragma unroll
            for (int cc = 0; cc < SC_GRP; ++cc) {
                LAS unsigned char* cb = sb + cc * CB_BYTES;
                const bf16x8 wa0 = *(const LAS bf16x8*)(cb + CB_WA + ((0 * 16 + vq) * 4 + q) * 16), wa1 = *(const LAS bf16x8*)(cb + CB_WA + ((1 * 16 + vq) * 4 + q) * 16);
                const bf16x8 qa0 = *(const LAS bf16x8*)(cb + CB_QA + ((0 * 16 + vq) * 4 + q) * 16), qa1 = *(const LAS bf16x8*)(cb + CB_QA + ((1 * 16 + vq) * 4 + q) * 16);
                const int qc = q & 1;
                bf16x8 mtf = *(const LAS bf16x8*)(cb + CB_MT + vq * 32 + qc * 16), q2f = *(const LAS bf16x8*)(cb + CB_Q2 + vq * 32 + qc * 16);
                bf16x8 bvf = *(const LAS bf16x8*)(cb + CB_VT + (16 * wv + vq) * 32 + qc * 16);
                if (q >= 2) { mtf = zf; q2f = zf; bvf = zf; }
                const u32x2 vpart = *(const LAS u32x2*)(cb + CB_VT + (16 * wv + vq) * 32 + q * 8);
                bf16x8 bk[4]; f32x4 pc[4];
#pragma unroll
                for (int m = 0; m < 4; ++m) { bk[m] = *(const LAS bf16x8*)(cb + CB_BK + ((16 * m + vq) * 4 + q) * 16); pc[m] = *(const LAS f32x4*)(cb + CB_PC + (16 * m + 4 * q) * 4); }
                bf16x8 bh[2], bl[2];
#pragma unroll
                for (int ks = 0; ks < 2; ++ks) {
                    const f32x4 s0 = S[2 * ks], s1 = S[2 * ks + 1];
                    u32x4 hp; hp.x = cvt_pk_bf16(s0[0], s0[1]); hp.y = cvt_pk_bf16(s0[2], s0[3]); hp.z = cvt_pk_bf16(s1[0], s1[1]); hp.w = cvt_pk_bf16(s1[2], s1[3]);
                    const float l0 = s0[0] - __uint_as_float(hp.x << 16), l1 = s0[1] - __uint_as_float(hp.x & 0xffff0000u), l2 = s0[2] - __uint_as_float(hp.y << 16), l3 = s0[3] - __uint_as_float(hp.y & 0xffff0000u);
                    const float l4 = s1[0] - __uint_as_float(hp.z << 16), l5 = s1[1] - __uint_as_float(hp.z & 0xffff0000u), l6 = s1[2] - __uint_as_float(hp.w << 16), l7 = s1[3] - __uint_as_float(hp.w & 0xffff0000u);
                    u32x4 lp; lp.x = cvt_pk_bf16(l0, l1); lp.y = cvt_pk_bf16(l2, l3); lp.z = cvt_pk_bf16(l4, l5); lp.w = cvt_pk_bf16(l6, l7);
                    bh[ks] = __builtin_bit_cast(bf16x8, hp); bl[ks] = __builtin_bit_cast(bf16x8, lp);
                }
                const f32x4 z = {0.f, 0.f, 0.f, 0.f};
                f32x4 U = __builtin_amdgcn_mfma_f32_16x16x32_bf16(mtf, bvf, z, 0, 0, 0);
                U = __builtin_amdgcn_mfma_f32_16x16x32_bf16(wa0, bl[0], U, 0, 0, 0); U = __builtin_amdgcn_mfma_f32_16x16x32_bf16(wa1, bl[1], U, 0, 0, 0);
                U = __builtin_amdgcn_mfma_f32_16x16x32_bf16(wa0, bh[0], U, 0, 0, 0); U = __builtin_amdgcn_mfma_f32_16x16x32_bf16(wa1, bh[1], U, 0, 0, 0);
                f32x4 Yt = __builtin_amdgcn_mfma_f32_16x16x32_bf16(q2f, bvf, z, 0, 0, 0);
                Yt = __builtin_amdgcn_mfma_f32_16x16x32_bf16(qa0, bl[0], Yt, 0, 0, 0); Yt = __builtin_amdgcn_mfma_f32_16x16x32_bf16(qa1, bl[1], Yt, 0, 0, 0);
                Yt = __builtin_amdgcn_mfma_f32_16x16x32_bf16(qa0, bh[0], Yt, 0, 0, 0); Yt = __builtin_amdgcn_mfma_f32_16x16x32_bf16(qa1, bh[1], Yt, 0, 0, 0);
                u32x4 up; up.x = cvt_pk_bf16(U[0], U[1]); up.y = cvt_pk_bf16(U[2], U[3]); up.z = vpart.x; up.w = vpart.y;
                const bf16x8 bu = __builtin_bit_cast(bf16x8, up);
#pragma unroll
                for (int m = 0; m < 4; ++m) S[m] = __builtin_amdgcn_mfma_f32_16x16x32_bf16(bk[m], bu, S[m] * pc[m], 0, 0, 0);
#pragma unroll
                for (int j = 0; j < 4; ++j) yb[(cc * 16 + 4 * q + j) * 64 + 16 * wv + vq] = Yt[j];
            }
            __syncthreads();
        }
    } else {
        const int hw = wv - 4, ht = tid - 256;
        ScanPostConst PC;
        { const int o = l * BW + h * 64 + (lane & 7) * 8;
          PC.gain0 = *(const f32x4*)(C.fin(22) + o); PC.gain1 = *(const f32x4*)(C.fin(22) + o + 4); PC.bias0 = *(const f32x4*)(C.fin(23) + o); PC.bias1 = *(const f32x4*)(C.fin(23) + o + 4); }
        const bf16_t* Gp = C.at<bf16_t>(WS_G) + (size_t)b * SEQ * BW + h * 64;
        const bf16_t* Bvp = C.at<bf16_t>(WS_BV) + (size_t)b * SEQ * BW + h * 64;
        bf16_t* Yp = C.at<bf16_t>(WS_Y) + (size_t)b * SEQ * DM + 1024 + h * 64;
        constexpr int NL = (SC_STG / 16 + 255) / 256;
        u32x4 tmp[4][NL]; ScanPostIn pin[4];
#define SCH_LOAD(gg, set) do { if ((gg) < NGRP) { const unsigned char* s2_ = src + (size_t)(gg) * SC_STG; \
            _Pragma("unroll") for (int i = 0; i < NL; ++i) { const int o_ = (ht + 256 * i) * 16; if (o_ < SC_STG) tmp[set][i] = *(const u32x4*)(s2_ + o_); } } } while (0)
#define SCH_STORE(gg, set) do { if ((gg) < NGRP) { LAS unsigned char* d2_ = stg + ((gg) & 1) * SC_STG; \
            _Pragma("unroll") for (int i = 0; i < NL; ++i) { const int o_ = (ht + 256 * i) * 16; if (o_ < SC_STG) *(LAS u32x4*)(d2_ + o_) = tmp[set][i]; } } } while (0)
#define SCH_PLOAD(gg, set) do { if ((gg) < NGRP) pin[set] = scan_post_load(Bvp, Gp, (size_t)(gg) * (SC_GRP * 16), hw * 8, lane); } while (0)
#define SCH_POST(gg, set) do { if ((gg) >= 0) scan_post(ybuf + ((gg) & 1) * SC_YB, pin[set], Yp, (size_t)(gg) * (SC_GRP * 16), hw * 8, lane, PC); } while (0)
#define SCH_ITER(g_, k) do { SCH_STORE((g_) + 1, ((k) + 1) & 3); SCH_LOAD((g_) + 4, (k)); SCH_PLOAD((g_) + 2, ((k) + 2) & 3); SCH_POST((g_) - 1, ((k) + 3) & 3); __syncthreads(); } while (0)
        SCH_LOAD(1, 1); SCH_LOAD(2, 2); SCH_LOAD(3, 3); SCH_PLOAD(0, 0); SCH_PLOAD(1, 1);
#pragma nounroll
        for (int g = 0; g < NGRP; g += 4) { SCH_ITER(g, 0); SCH_ITER(g + 1, 1); SCH_ITER(g + 2, 2); SCH_ITER(g + 3, 3); }
        SCH_POST(NGRP - 1, (NGRP - 1) & 3);
#undef SCH_LOAD
#undef SCH_STORE
#undef SCH_PLOAD
#undef SCH_POST
#undef SCH_ITER
    }
    __syncthreads();
}

constexpr int KSTR = 400, VSTR = 320;
constexpr int KBUF = 64 * KSTR, VBUF = 64 * VSTR;
constexpr int ASTG = KBUF + VBUF;
struct AttnDma { unsigned off[6]; unsigned strd[6]; };
__device__ __forceinline__ void attn_dma_init(AttnDma& D, size_t tk, int h, int w, int lane) {
#pragma unroll
    for (int i = 0; i < 6; ++i) {
        const int wi = w + 8 * i, ci = wi * 64 + lane; size_t off; unsigned st = 64u * NKV * 2u;
        if (ci < 1600) { const int r = ci / 25, ch = ci - r * 25;
            if (ch < 16) off = ((tk + r) * NKV + h * 256 + ch * 8) * 2;
            else if (ch < 24) { off = (size_t)MTOK * NKV * 2 + ((tk + r) * 64 + (ch - 16) * 8) * 2; st = 64u * 64u * 2u; }
            else off = ((tk + r) * NKV + h * 256) * 2; }
        else { const int cv = ci - 1600, r = cv / 20, ch = cv - r * 20;
            off = ((tk + r) * NKV + h * 256 + 128 + (ch < 16 ? ch : 0) * 8) * 2; }
        D.off[i] = (unsigned)off; D.strd[i] = st;
    }
}
__device__ __forceinline__ void attn_dma_issue(LAS unsigned char* lds, const bf16_t* KV, AttnDma& D, int stg, int w) {
    const char* kvb = (const char*)KV;
#pragma unroll
    for (int i = 0; i < 6; ++i) {
        const int wi = w + 8 * i;
        if (wi < 45) __builtin_amdgcn_global_load_lds((const unsigned*)(kvb + D.off[i]), (LAS unsigned*)(lds + stg * ASTG + wi * 1024), 16, 0, 0);
        D.off[i] += D.strd[i];
    }
}
template <int CUR>
__device__ __forceinline__ void attn_tile(LAS unsigned char* lds, const bf16_t* KV, AttnDma& dma, int j, int ntiles, int mytiles, int w, int hh, int qi, int kaddr, int vaddr,
                                          const bf16x8 (&qf)[12], f32x16 (&o)[4], float& mrun, float& lrun) {
    if (j + 1 < ntiles) attn_dma_issue(lds, KV, dma, CUR ^ 1, w);
    if (j < mytiles) {
        f32x16 sc[2];
#pragma unroll
        for (int kb = 0; kb < 2; ++kb) {
#pragma unroll
            for (int i = 0; i < 16; ++i) sc[kb][i] = 0.f;
#pragma unroll
            for (int s = 0; s < 12; ++s) {
                const bf16x8 a = *(const LAS bf16x8*)(lds + CUR * ASTG + kaddr + kb * 32 * KSTR + s * 32);
                sc[kb] = __builtin_amdgcn_mfma_f32_32x32x16_bf16(a, qf[s], sc[kb], 0, 0, 0);
            }
        }
        if (j == mytiles - 1) {
#pragma unroll
            for (int kb = 0; kb < 2; ++kb)
#pragma unroll
                for (int i = 0; i < 16; ++i) { const int key = j * 64 + kb * 32 + (i & 3) + 8 * (i >> 2) + 4 * hh; if (key > qi) sc[kb][i] = -INFINITY; }
        }
        float mx = sc[0][0];
#pragma unroll
        for (int kb = 0; kb < 2; ++kb)
#pragma unroll
            for (int i = 0; i < 16; ++i) mx = fmaxf(mx, sc[kb][i]);
        mx = fmaxf(mx, __shfl_xor(mx, 32));
        const bool bump = mx > mrun + 8.0f;
        const float mnew = bump ? mx : mrun;
        if (__builtin_amdgcn_ballot_w64(bump) != 0ull) {
            const float alpha = __builtin_amdgcn_exp2f(mrun - mnew);
            lrun *= alpha;
#pragma unroll
            for (int d = 0; d < 4; ++d)
#pragma unroll
                for (int i = 0; i < 16; ++i) o[d][i] *= alpha;
        }
        mrun = mnew;
        f32x2 ps2 = {0.f, 0.f}; const f32x2 mn2 = {mnew, mnew};
#pragma unroll
        for (int kb = 0; kb < 2; ++kb)
#pragma unroll
            for (int i = 0; i < 16; i += 2) { const f32x2 dlt = (f32x2){sc[kb][i], sc[kb][i + 1]} - mn2; f32x2 p; p.x = __builtin_amdgcn_exp2f(dlt.x); p.y = __builtin_amdgcn_exp2f(dlt.y); sc[kb][i] = p.x; sc[kb][i + 1] = p.y; ps2 += p; }
        lrun += ps2.x + ps2.y;
        bf16x8 pfr[4];
#pragma unroll
        for (int g = 0; g < 4; ++g) { const int kb = g >> 1, s2 = g & 1;
            u32x4 pk; pk.x = cvt_pk_bf16(sc[kb][8 * s2 + 0], sc[kb][8 * s2 + 1]); pk.y = cvt_pk_bf16(sc[kb][8 * s2 + 2], sc[kb][8 * s2 + 3]);
            pk.z = cvt_pk_bf16(sc[kb][8 * s2 + 4], sc[kb][8 * s2 + 5]); pk.w = cvt_pk_bf16(sc[kb][8 * s2 + 6], sc[kb][8 * s2 + 7]);
            pfr[g] = __builtin_bit_cast(bf16x8, pk); }
        const unsigned vb = (unsigned)(size_t)(lds + CUR * ASTG) + (unsigned)vaddr;
        s16x4 RA[8], RB[8];
#define ATT_TR8(R, G) asm volatile("ds_read_b64_tr_b16 %0, %8 offset:%9\n\tds_read_b64_tr_b16 %1, %8 offset:%10\n\tds_read_b64_tr_b16 %2, %8 offset:%11\n\tds_read_b64_tr_b16 %3, %8 offset:%12\n\t" \
                                   "ds_read_b64_tr_b16 %4, %8 offset:%13\n\tds_read_b64_tr_b16 %5, %8 offset:%14\n\tds_read_b64_tr_b16 %6, %8 offset:%15\n\tds_read_b64_tr_b16 %7, %8 offset:%16" \
            : "=&v"(R[0]), "=&v"(R[1]), "=&v"(R[2]), "=&v"(R[3]), "=&v"(R[4]), "=&v"(R[5]), "=&v"(R[6]), "=&v"(R[7]) \
            : "v"(vb), "n"((G) * 16 * VSTR), "n"((G) * 16 * VSTR + 8 * VSTR), "n"((G) * 16 * VSTR + 64), "n"((G) * 16 * VSTR + 64 + 8 * VSTR), \
              "n"((G) * 16 * VSTR + 128), "n"((G) * 16 * VSTR + 128 + 8 * VSTR), "n"((G) * 16 * VSTR + 192), "n"((G) * 16 * VSTR + 192 + 8 * VSTR))
#define ATT_TRWAIT(R, N) asm volatile("s_waitcnt lgkmcnt(" #N ")" : "+v"(R[0]), "+v"(R[1]), "+v"(R[2]), "+v"(R[3]), "+v"(R[4]), "+v"(R[5]), "+v"(R[6]), "+v"(R[7]))
#define ATT_PV(R, G) do { _Pragma("unroll") for (int d = 0; d < 4; ++d) { const bf16x8 vf = __builtin_shufflevector(R[2 * d], R[2 * d + 1], 0, 1, 2, 3, 4, 5, 6, 7); \
            o[d] = __builtin_amdgcn_mfma_f32_32x32x16_bf16(vf, pfr[G], o[d], 0, 0, 0); } } while (0)
        ATT_TR8(RA, 0);
        ATT_TR8(RB, 1); ATT_TRWAIT(RA, 8); ATT_PV(RA, 0);
        ATT_TR8(RA, 2); ATT_TRWAIT(RB, 8); ATT_PV(RB, 1);
        ATT_TR8(RB, 3); ATT_TRWAIT(RA, 8); ATT_PV(RA, 2);
        ATT_TRWAIT(RB, 0); ATT_PV(RB, 3);
#undef ATT_TR8
#undef ATT_TRWAIT
#undef ATT_PV
    }
    asm volatile("s_waitcnt vmcnt(0)" ::: "memory");
    __builtin_amdgcn_s_barrier();
}
__device__ __forceinline__ void attn_unit(const Ctx& C, int l, int b, int h, int qb) {
    const int tid = opaque_tid(), lane = tid & 63, w = __builtin_amdgcn_readfirstlane(tid >> 6), ql = lane & 31, hh = lane >> 5;
    LAS unsigned char* lds = C.lds;
    const int q0 = qb * 256;
    const size_t tok0 = (size_t)b * SEQ;
    const bf16_t* KV = C.at<bf16_t>(WS_KV);
    static_assert(WS_KR == WS_KV + (size_t)MTOK * NKV * 2, "kr must follow kv");
    static_assert((size_t)MTOK * NKV * 2 + (size_t)MTOK * 64 * 2 < 0xffffffffull, "32-bit DMA offsets");
    AttnDma dma; attn_dma_init(dma, tok0, h, w, lane);
    attn_dma_issue(lds, KV, dma, 0, w);
    bf16x8 qf[12];
    {
        const bf16_t* qp = C.at<bf16_t>(WS_Q) + (tok0 + q0 + w * 32 + ql) * NQ + h * QKD + hh * 8;
#pragma unroll
        for (int s = 0; s < 12; ++s) qf[s] = *(const bf16x8*)(qp + 16 * s);
    }
    f32x16 o[4];
#pragma unroll
    for (int d = 0; d < 4; ++d)
#pragma unroll
        for (int i = 0; i < 16; ++i) o[d][i] = 0.f;
    float mrun = -1e30f, lrun = 0.f;
    const int ntiles = 4 * qb + 4, mytiles = 4 * qb + (w >> 1) + 1;
    asm volatile("s_waitcnt vmcnt(0)" ::: "memory");
    __syncthreads();
    const int qi = q0 + w * 32 + ql;
    const int kaddr = ql * KSTR + hh * 16;
    const int vaddr = KBUF + (4 * hh + ((lane & 15) >> 2)) * VSTR + (16 * ((lane >> 4) & 1) + 4 * (lane & 3)) * 2;
#pragma nounroll
    for (int j = 0; j < ntiles; j += 2) {
        attn_tile<0>(lds, KV, dma, j, ntiles, mytiles, w, hh, qi, kaddr, vaddr, qf, o, mrun, lrun);
        attn_tile<1>(lds, KV, dma, j + 1, ntiles, mytiles, w, hh, qi, kaddr, vaddr, qf, o, mrun, lrun);
    }
    __syncthreads();
    const float ltot = lrun + __shfl_xor(lrun, 32);
    const float inv = 1.0f / ltot;
    float ss = 0.f;
#pragma unroll
    for (int d = 0; d < 4; ++d)
#pragma unroll
        for (int i = 0; i < 16; ++i) { o[d][i] *= inv; ss += o[d][i] * o[d][i]; }
    ss += __shfl_xor(ss, 32);
    const float rn = rsqrtf(ss * (1.0f / 128.0f) + RMS_EPS);
    const float* gn = C.fin(12) + l * 1024 + h * 128;
    bf16_t* yp = C.at<bf16_t>(WS_Y) + (tok0 + q0 + w * 32 + ql) * DM + h * 128;
#pragma unroll
    for (int d = 0; d < 4; ++d)
#pragma unroll
        for (int g4 = 0; g4 < 4; ++g4) {
            const int dd = 32 * d + 8 * g4 + 4 * hh;
            const f32x4 gv = *(const f32x4*)(gn + dd);
            u32x2 wv2; wv2.x = cvt_pk_bf16(o[d][4 * g4 + 0] * rn * gv[0], o[d][4 * g4 + 1] * rn * gv[1]); wv2.y = cvt_pk_bf16(o[d][4 * g4 + 2] * rn * gv[2], o[d][4 * g4 + 3] * rn * gv[3]);
            *(u32x2*)(yp + dd) = wv2;
        }
}

__device__ __forceinline__ void phase_final(const Ctx& C) {
    const int tid = opaque_tid(), lane = tid & 63, wv = tid >> 6;
    const float* part = C.at<float>(WS_PARTH); const float* gn = C.fin(31); const bf16_t* hb = C.at<bf16_t>(WS_HB);
    for (int row = C.wg * 8 + wv; row < MTOK; row += C.G * 8) {
        const float rs = rsqrtf(sum_part<32>(part + (size_t)row * 32) * (1.0f / DM) + RMS_EPS);
#pragma unroll
        for (int i = 0; i < 4; ++i) {
            const int col = (i * 64 + lane) * 8; const size_t off = (size_t)row * DM + col;
            const u32x4 w = *(const u32x4*)(hb + off); const f32x4 g0 = *(const f32x4*)(gn + col), g1 = *(const f32x4*)(gn + col + 4);
            const f32x4 v0 = {__uint_as_float(w.x << 16), __uint_as_float(w.x & 0xffff0000u), __uint_as_float(w.y << 16), __uint_as_float(w.y & 0xffff0000u)};
            const f32x4 v1 = {__uint_as_float(w.z << 16), __uint_as_float(w.z & 0xffff0000u), __uint_as_float(w.w << 16), __uint_as_float(w.w & 0xffff0000u)};
            *(f32x4*)(C.out + off) = v0 * rs * g0; *(f32x4*)(C.out + off + 4) = v1 * rs * g1;
        }
    }
}

constexpr int N_PHASES = 2 + 9 * DEPTH;
__global__ void __launch_bounds__(NTHREADS, 2) fwd_kernel(Args args) {
    extern __shared__ __attribute__((aligned(16))) unsigned char lds_raw[];
    Ctx C0; C0.in = args.in; C0.out = args.out; C0.ws = args.ws; C0.lds = (LAS unsigned char*)lds_raw; C0.G = gridDim.x; C0.wg = blockIdx.x;
    volatile LAS unsigned* misc = (volatile LAS unsigned*)(C0.lds + LDS_MISC);
    if (threadIdx.x < 16) misc[threadIdx.x] = 0u;
    __syncthreads();
    const int lo = args.ph_lo, hi = args.ph_hi;
    constexpr bool one_launch = !MK_MULTI;
    XcdBarrier bar; bar.bar = (unsigned*)(C0.ws + WS_CTL); bar.x = 0; bar.st = misc;
    if (hi - lo > 1) bar = xcd_barrier_post((unsigned*)(C0.ws + WS_CTL), misc);
#define IN(k) (lo <= (k) && (k) < hi)
#define SEAM(k) do { if (IN((k) + 1)) { xcd_barrier(bar); if (REP(10)) xcd_barrier(bar); } } while (0)

    if (IN(0)) { if (!SKIP(0)) {
#pragma nounroll
        for (int rep = 0; rep <= REP(12); ++rep) { phase_prologue(C0.fresh()); phase_convert(C0.fresh(), 0, bar); } } SEAM(0); }

    for (int it = 0; it < 3 * DEPTH; ++it) {
        const int l = it / 3, kind = it - 3 * l;
        const int pb = 1 + 9 * l;
        if (kind != 1) {
            const int id = pb + (kind == 0 ? 0 : 6);
            if (IN(id)) {
                const Ctx C = C0.fresh();
                pg8::Gemm g{C.at<bf16_t>(WS_H8), C.at<bf16_t>(kind == 0 ? WS_W1GU : WS_W2GU), MTOK, 2 * DFF, DM / 2, DM / 2, 0};
                pg8::StaticOrder S; S.init(MTOK, 2 * DFF, C.G, C.wg, MK_WGM_GU);
                EpiGU E{C.at<bf16_t>(WS_ACT), C.at<float>(WS_PARTH), C.at<float>(WS_RSA), C.at<float>(WS_CTL + CW_WMAX) + l * 2 + (kind == 0 ? 0 : 1), C.at<unsigned>(kind == 0 ? WS_AMAX : WS_AMAX2)};
#pragma nounroll
                for (int rep = 0; rep <= REP(1); ++rep)
                if (!SKIP(1)) pg8::gemm_phase<EpiGU, REP(8)>(C.lds, g, S, E, E);
                xcd_barrier(bar); actq_pass(C0.fresh(), kind == 0 ? WS_AMAX : WS_AMAX2, kind == 0 ? WS_AMAX2 : WS_AMAX, C0.at<float>(WS_CTL + CW_WMAX) + l * 2 + (kind == 0 ? 0 : 1));
                SEAM(id);
            }
        }
        {
            const int id = pb + (kind == 0 ? 1 : (kind == 1 ? 5 : 7));
            if (IN(id)) {
                const Ctx C = C0.fresh();
                pg8::StaticOrder S; S.init(MTOK, DM, C.G, C.wg, MK_WGM_RES);
                const float* basef = (it == 0) ? C.fin(0) : nullptr;
                if (kind == 1) {
                    pg8::Gemm g{C.at<bf16_t>(WS_Y), C.at<bf16_t>(WS_WOUT), MTOK, DM, DM, DM, 0};
                    EpiResT<false> E{basef, C.at<bf16_t>(WS_HB), C.at<float>(WS_PARTH), 1.0f, nullptr, nullptr};
                    if (!SKIP(2)) pg8::gemm_phase<EpiResT<false>>(C.lds, g, S, E, E);
                } else {
                    pg8::Gemm g{C.at<bf16_t>(WS_ACT8), C.at<bf16_t>(kind == 0 ? WS_W1D : WS_W2D), MTOK, DM, DFF / 2, 64, 1};
                    EpiResT<true> E{basef, C.at<bf16_t>(WS_HB), C.at<float>(WS_PARTH), 0.5f, C.at<float>(WS_ASC), C.at<float>(WS_CTL + CW_WMAX) + 8 + l * 2 + (kind == 0 ? 0 : 1)};
#pragma nounroll
                    for (int rep = 0; rep <= REP(2); ++rep)
                    if (!SKIP(2)) pg8::gemm_phase<EpiResT<true>>(C.lds, g, S, E, E);
                }
                if (one_launch && it != 3 * DEPTH - 1) { xcd_barrier(bar); if (kind == 0) rstd_pass(C0.fresh()); else quant_pass(C0.fresh()); }
                SEAM(id);
            }
        }
        if (kind == 0) {
            if (IN(pb + 2)) {
                const Ctx C = C0.fresh();
                pg8::Gemm g{C.at<bf16_t>(WS_HB), C.at<bf16_t>(WS_WIN), MTOK, NINP, DM, DM, 0};
                pg8::StaticOrder S; S.init(MTOK, NINP, C.G, C.wg, MK_WGM_WIN);
                EpiScale<0> E{C.at<bf16_t>(WS_P), NINP, C.at<float>(WS_PARTH), 1.0f / DM, 1.0f, C.at<float>(WS_PARTQ), C.at<float>(WS_PARTKV), nullptr, nullptr, one_launch ? C.at<float>(WS_RSTD) : nullptr};
#pragma nounroll
                for (int rep = 0; rep <= REP(3); ++rep)
                if (!SKIP(3)) pg8::gemm_phase<EpiScale<0>>(C.lds, g, S, E, E);
                SEAM(pb + 2);
            }
            if (IN(pb + 3)) {
                {
                    const Ctx C = C0.fresh();
                    pg8::Gemm g{C.at<bf16_t>(WS_P), C.at<bf16_t>(WS_WUQ), MTOK, NQ, QL, NINP, 0};
                    pg8::StaticOrder S; S.init(MTOK, NQ, C.G, C.wg);
                    EpiScale<2> E{C.at<bf16_t>(WS_Q), NQ, C.at<float>(WS_PARTQ), 1.0f / QL, 0.07216878364870322f * 1.4426950408889634f, nullptr, nullptr, C.at<float>(WS_ROPEC), C.at<float>(WS_ROPES), nullptr};
#pragma nounroll
                    for (int rep = 0; rep <= REP(4); ++rep)
                    if (!SKIP(4)) pg8::gemm_phase<EpiScale<2>>(C.lds, g, S, E, E);
                }
                {
                    const Ctx C = C0.fresh();
                    pg8::Gemm g{C.at<bf16_t>(WS_P) + QL, C.at<bf16_t>(WS_WUKV), MTOK, NKV, KVL, NINP, 0};
                    pg8::StaticOrder S; S.init(MTOK, NKV, C.G, C.wg);
                    EpiScale<1> E{C.at<bf16_t>(WS_KV), NKV, C.at<float>(WS_PARTKV), 1.0f / KVL, 1.0f, nullptr, nullptr, nullptr, nullptr, nullptr};
#pragma nounroll
                    for (int rep = 0; rep <= REP(4); ++rep)
                    if (!SKIP(5)) pg8::gemm_phase<EpiScale<1>>(C.lds, g, S, E, E);
                }
#pragma nounroll
                for (int rep = 0; rep <= REP(5); ++rep)
                if (!SKIP(6)) prep_phase(C0.fresh(), l);
                SEAM(pb + 3);
            }
            if (IN(pb + 4)) {
                unsigned* qctr = (unsigned*)(C0.fresh().ws + WS_CTL + CW_QUEUE) + 64 * l;
                if (REP(6)) { if ((int)C0.wg < 128) scan_unit(C0.fresh(), l, C0.wg); xcd_barrier(bar); }
                if (REP(7)) { for (int pi = C0.wg; pi < 1024; pi += C0.G) { const int bh = pi & 127, qb = (pi >> 7) & 1 ? (pi >> 8) : 7 - (pi >> 8); attn_unit(C0.fresh(), l, bh >> 3, bh & 7, qb); } xcd_barrier(bar); }
#pragma nounroll
                for (int rep = 0; rep <= REP(11); ++rep, qctr += 256)
                for (;;) {
                    if (threadIdx.x == 0) misc[4] = xb_add(qctr, 1u);
                    __syncthreads();
                    const int item = (int)misc[4];
                    __syncthreads();
                    if (item >= 128 + 1024) break;
                    if (item < 128) { if (!SKIP(7)) scan_unit(C0.fresh(), l, item); }
                    else { const int idx = item - 128, bh = idx & 127, qb = 7 - (idx >> 7);
                        if (!SKIP(8)) attn_unit(C0.fresh(), l, bh >> 3, bh & 7, qb); }
                }
                SEAM(pb + 4);
            }
        }
        if (kind == 2) {
            if (IN(pb + 8)) { if (l + 1 < DEPTH && !SKIP(9)) { phase_convert(C0.fresh(), l + 1, bar); if (REP(0)) phase_convert(C0.fresh(), l + 1, bar); } SEAM(pb + 8); }
        }
    }
    if (IN(N_PHASES - 1) && !SKIP(10)) {
#pragma nounroll
        for (int rep = 0; rep <= REP(12); ++rep) phase_final(C0.fresh()); }
#undef IN
#undef SEAM
}

extern "C" void kernel_launch(void* const* d_in, const int* in_sizes, int n_in, void* d_out, int out_size, void* d_ws, size_t ws_size, hipStream_t stream) {
    static int grid = 0;
    if (grid == 0) {
        if (n_in != 32 || out_size != MTOK * DM || ws_size < WS_END) { fprintf(stderr, "kernel_launch: unexpected shapes (n_in %d, out %d, ws %zu, need %zu)\n", n_in, out_size, ws_size, (size_t)WS_END); grid = -1; return; }
        int dev = 0, cus = 0, per_cu = 0;
        if (hipGetDevice(&dev) != hipSuccess || hipDeviceGetAttribute(&cus, hipDeviceAttributeMultiprocessorCount, dev) != hipSuccess) { grid = -1; return; }
        if (hipFuncSetAttribute((const void*)fwd_kernel, hipFuncAttributeMaxDynamicSharedMemorySize, LDS_BYTES) != hipSuccess) { fprintf(stderr, "kernel_launch: hipFuncSetAttribute failed\n"); grid = -1; return; }
        if (hipOccupancyMaxActiveBlocksPerMultiprocessor(&per_cu, (const void*)fwd_kernel, NTHREADS, LDS_BYTES) != hipSuccess || per_cu < 1) { fprintf(stderr, "kernel_launch: occupancy query says %d\n", per_cu); }
        (void)hipGetLastError();
        grid = cus;
    }
    if (grid < 0) return;
    (void)hipMemsetAsync((char*)d_ws + WS_CTL, 0, ZERO_BYTES, stream);
    Args a{};
    for (int i = 0; i < 32; ++i) a.in[i] = d_in[i];
    a.out = (float*)d_out; a.ws = (unsigned char*)d_ws;
#if MK_MULTI
    for (int p = 0; p < N_PHASES; ++p) { a.ph_lo = p; a.ph_hi = p + 1; hipLaunchKernelGGL(fwd_kernel, dim3(grid), dim3(NTHREADS), LDS_BYTES, stream, a); }
#else
    a.ph_lo = 0; a.ph_hi = N_PHASES;
    hipLaunchKernelGGL(fwd_kernel, dim3(grid), dim3(NTHREADS), LDS_BYTES, stream, a);
#endif
}
```

```cpp
#include <hip/hip_runtime.h>
#include <stdint.h>
#include <stdio.h>

#ifndef MK_MULTI
#define MK_MULTI 0
#endif

#ifndef MK_SKIP
#define MK_SKIP 0
#endif
#define SKIP(b) ((MK_SKIP >> (b)) & 1)
#ifndef MK_WGM_RES
#define MK_WGM_RES 4
#endif
#ifndef MK_WGM_GU
#define MK_WGM_GU 8
#endif
#ifndef MK_WGM_WIN
#define MK_WGM_WIN 4
#endif
#ifndef MK_REP
#define MK_REP 0
#endif
#define REP(b) ((MK_REP >> (b)) & 1)
#define LAS __attribute__((address_space(3)))
typedef unsigned short bf16_t;
typedef short bf16x8 __attribute__((ext_vector_type(8)));
typedef short s16x4 __attribute__((ext_vector_type(4)));
typedef float f32x4 __attribute__((ext_vector_type(4)));
typedef float f32x2 __attribute__((ext_vector_type(2)));
typedef float f32x16 __attribute__((ext_vector_type(16)));
typedef unsigned u32x4 __attribute__((ext_vector_type(4)));
typedef unsigned u32x2 __attribute__((ext_vector_type(2)));
typedef int i32x4 __attribute__((ext_vector_type(4)));
typedef int i32x8 __attribute__((ext_vector_type(8)));

constexpr int BATCH = 16, SEQ = 2048, MTOK = BATCH * SEQ, DM = 2048, DFF = 5632, DEPTH = 4;
constexpr int NIN = 4064, NINP = 4096;
constexpr int QL = 512, KVL = 256, AH = 8, QKD = 192;
constexpr int NQ = AH * QKD;
constexpr int NKV = AH * 256;
constexpr int BW = 512;
constexpr int PB0 = 832, PC0 = 2528;
constexpr float RMS_EPS = 1e-6f;
constexpr int NTHREADS = 512;

constexpr size_t al256(size_t x) { return (x + 255) & ~(size_t)255; }
constexpr int XCD_BAR_WORDS_C = 3456;
constexpr size_t WS_CTL = 0;
constexpr size_t CTL_BYTES = 65536;
constexpr size_t CW_QUEUE = 16384;
constexpr size_t WS_PARTH = WS_CTL + CTL_BYTES;
constexpr size_t WS_PARTQ = WS_PARTH + (size_t)MTOK * 32 * 4;
constexpr size_t WS_PARTKV = WS_PARTQ + (size_t)MTOK * 8 * 4;
constexpr size_t ZERO_BYTES = CTL_BYTES;
constexpr size_t WS_RSTD = WS_PARTKV + (size_t)MTOK * 4 * 4;
constexpr size_t WS_ROPEC = al256(WS_RSTD + (size_t)MTOK * 4);
constexpr size_t WS_ROPES = WS_ROPEC + (size_t)MTOK * 32 * 4;
constexpr size_t WS_W1GU = WS_ROPES + (size_t)MTOK * 32 * 4;
constexpr size_t SZ_WGU = (size_t)2 * DFF * DM * 2;
constexpr size_t SZ_WD = (size_t)DM * DFF * 2;
constexpr size_t WS_W1D = WS_W1GU + SZ_WGU;
constexpr size_t WS_WIN = WS_W1D + SZ_WD;
constexpr size_t WS_WUQ = WS_WIN + (size_t)NINP * DM * 2;
constexpr size_t WS_WUKV = WS_WUQ + (size_t)NQ * QL * 2;
constexpr size_t WS_WOUT = WS_WUKV + (size_t)NKV * KVL * 2;
constexpr size_t WS_W2GU = WS_WOUT + (size_t)DM * DM * 2;
constexpr size_t WS_W2D = WS_W2GU + SZ_WGU;
constexpr size_t WS_LORA = WS_W2D + SZ_WD;
constexpr size_t WS_HB = al256(WS_LORA + (size_t)512 * 160 * 2);
constexpr size_t WS_X = WS_HB + (size_t)MTOK * DM * 2;
constexpr size_t WS_ACT = WS_X;
constexpr size_t WS_P = WS_X;
constexpr size_t WS_Q = WS_P + (size_t)MTOK * NINP * 2;
constexpr size_t WS_KV = WS_Q + (size_t)MTOK * NQ * 2;
constexpr size_t WS_KR = WS_KV + (size_t)MTOK * NKV * 2;
constexpr size_t WS_SCAN = WS_KR + (size_t)MTOK * 64 * 2;
constexpr int CB_BYTES = 11520;
constexpr int CB_WA = 0, CB_QA = 2048, CB_MT = 4096, CB_Q2 = 4608, CB_BK = 5120, CB_PC = 9216, CB_VT = 9472;
constexpr size_t WS_BV = WS_SCAN + (size_t)BATCH * 8 * (SEQ / 16) * CB_BYTES;
constexpr size_t WS_G = WS_SCAN + (size_t)MTOK * 8 * 6 * 64 * 4;
static_assert(WS_BV + (size_t)MTOK * BW * 4 <= WS_G, "scan region");
constexpr size_t WS_Y = WS_G + (size_t)MTOK * BW * 4;
constexpr size_t WS_MIXEND = WS_Y + (size_t)MTOK * DM * 2;
constexpr size_t WS_ACTEND = WS_ACT + (size_t)MTOK * DFF * 2;
constexpr size_t WS_H8 = al256(WS_MIXEND > WS_ACTEND ? WS_MIXEND : WS_ACTEND);
constexpr size_t WS_RSA = WS_H8 + (size_t)MTOK * DM;
constexpr size_t WS_AMAX = WS_RSA + (size_t)MTOK * 4;
constexpr size_t WS_AMAX2 = WS_AMAX + (size_t)MTOK * 4;
constexpr size_t WS_ASC = WS_AMAX2 + (size_t)MTOK * 4;
constexpr size_t WS_END = WS_ASC + (size_t)MTOK * 4;
constexpr size_t WS_ACT8 = WS_ACT + (size_t)MTOK * DFF * 2;
static_assert(WS_ACT8 + (size_t)MTOK * DFF <= WS_MIXEND, "act8 inside the union");
constexpr size_t CW_WMAX = 32768;

constexpr int STAGE_BYTES_C = 131072;
constexpr int LDS_WORK = 8192 + 8 * 16384;
constexpr int LDS_MISC = LDS_WORK;
constexpr int LDS_BYTES = LDS_WORK + 256;

typedef __bf16 bf16x2_t __attribute__((ext_vector_type(2)));
__device__ __forceinline__ unsigned cvt_pk_bf16(float lo, float hi) { const f32x2 f = {lo, hi}; return __builtin_bit_cast(unsigned, __builtin_convertvector(f, bf16x2_t)); }
__device__ __forceinline__ unsigned pk4_i8(float a, float b, float c, float d) {
    const unsigned ua = __float_as_uint(a + 12582912.0f), ub = __float_as_uint(b + 12582912.0f), uc = __float_as_uint(c + 12582912.0f), ud = __float_as_uint(d + 12582912.0f);
    return __builtin_amdgcn_perm(__builtin_amdgcn_perm(ud, uc, 0x0c0c0400u), __builtin_amdgcn_perm(ub, ua, 0x0c0c0400u), 0x05040100u);
}
__device__ __forceinline__ float bf2f(bf16_t b) { return __uint_as_float(((unsigned)b) << 16); }
__device__ __forceinline__ bf16_t f2bf(float f) { return (bf16_t)(cvt_pk_bf16(f, 0.f) & 0xffffu); }
__device__ __forceinline__ int opaque_tid() { int t = threadIdx.x; asm volatile("" : "+v"(t)); return t; }
__device__ __forceinline__ float wave_sum(float v) {
#pragma unroll
    for (int o = 32; o >= 1; o >>= 1) v += __shfl_xor(v, o);
    return v;
}
__device__ __forceinline__ float rdlane(float v, int l) { return __builtin_bit_cast(float, __builtin_amdgcn_readlane(__builtin_bit_cast(int, v), l)); }
template <int CTRL> __device__ __forceinline__ float dpp_mov(float v) { return __builtin_bit_cast(float, __builtin_amdgcn_update_dpp(0, __builtin_bit_cast(int, v), CTRL, 0xf, 0xf, false)); }
__device__ __forceinline__ float red16(float v) { v += dpp_mov<0xB1>(v); v += dpp_mov<0x4E>(v); v += dpp_mov<0x141>(v); v += dpp_mov<0x140>(v); return v; }
__device__ __forceinline__ float xor16_add(float v) { const unsigned b = __builtin_bit_cast(unsigned, v); const u32x2 r = __builtin_amdgcn_permlane16_swap(b, b, false, false); return __uint_as_float(r.x) + __uint_as_float(r.y); }
__device__ __forceinline__ float xor32_add(float v) { const unsigned b = __builtin_bit_cast(unsigned, v); const u32x2 r = __builtin_amdgcn_permlane32_swap(b, b, false, false); return __uint_as_float(r.x) + __uint_as_float(r.y); }
__device__ __forceinline__ float xor16_max(float v) { const unsigned b = __builtin_bit_cast(unsigned, v); const u32x2 r = __builtin_amdgcn_permlane16_swap(b, b, false, false); return fmaxf(__uint_as_float(r.x), __uint_as_float(r.y)); }
__device__ __forceinline__ float xor32_max(float v) { const unsigned b = __builtin_bit_cast(unsigned, v); const u32x2 r = __builtin_amdgcn_permlane32_swap(b, b, false, false); return fmaxf(__uint_as_float(r.x), __uint_as_float(r.y)); }
__device__ __forceinline__ void fwht8(float (&v)[8]) {
#pragma unroll
    for (int h = 1; h < 8; h <<= 1)
#pragma unroll
        for (int i = 0; i < 8; ++i) if (!(i & h)) { const float a = v[i], b = v[i | h]; v[i] = a + b; v[i | h] = a - b; }
}
__device__ __forceinline__ void fwht8_pk(f32x2 (&p)[4]) {
#pragma unroll
    for (int i = 0; i < 4; ++i) { f32x2 d; asm("v_pk_add_f32 %0, %1, %1 op_sel:[0,1] op_sel_hi:[0,1] neg_hi:[0,1]" : "=v"(d) : "v"(p[i])); p[i] = d; }
    { const f32x2 a = p[0] + p[1], b = p[0] - p[1], c = p[2] + p[3], d = p[2] - p[3]; p[0] = a; p[1] = b; p[2] = c; p[3] = d; }
    { const f32x2 a = p[0] + p[2], b = p[1] + p[3], c = p[0] - p[2], d = p[1] - p[3]; p[0] = a; p[1] = b; p[2] = c; p[3] = d; }
}
__device__ __forceinline__ float wave_sum_fast(float v) { return xor32_add(xor16_add(red16(v))); }
__device__ __forceinline__ float sigmoid_fast(float x) { return __builtin_amdgcn_rcpf(1.0f + __builtin_amdgcn_exp2f(-1.4426950408889634f * x)); }
__device__ __forceinline__ float red8(float v) { v += dpp_mov<0xB1>(v); v += dpp_mov<0x4E>(v); v += dpp_mov<0x141>(v); return v; }
template <int N> __device__ __forceinline__ float sum_part(const float* p) {
    f32x4 a = *(const f32x4*)p;
#pragma unroll
    for (int i = 1; i < N / 4; ++i) a += *(const f32x4*)(p + 4 * i);
    return (a[0] + a[1]) + (a[2] + a[3]);
}

#define XB_TMO      128
#define XB_XCNT(j)  (256  + 64 * (j))
#define XB_XSUB(j)  (1280 + 64 * (j))
#define XB_XGEN(j)  (2304 + 64 * (j))
#define XB_TOP      3328
#define XB_TOPGEN   3392
#define XCD_BAR_WORDS 3456
#define XB_SPIN_CAP (1u << 22)
static_assert(XCD_BAR_WORDS == XCD_BAR_WORDS_C && XCD_BAR_WORDS * 4 <= CW_QUEUE, "ctl layout");

__device__ __forceinline__ unsigned xb_ld(unsigned* p)              { return __hip_atomic_load(p, __ATOMIC_RELAXED, __HIP_MEMORY_SCOPE_AGENT); }
__device__ __forceinline__ unsigned xb_add(unsigned* p, unsigned v) { return __hip_atomic_fetch_add(p, v, __ATOMIC_RELAXED, __HIP_MEMORY_SCOPE_AGENT); }
__device__ __forceinline__ unsigned xb_xcc_id() { return (unsigned)__builtin_amdgcn_s_getreg((3 << 11) | 20) & 0xFu; }
#define XB_SPIN(cond, bar) do { unsigned _sp = 0; while (cond) { __builtin_amdgcn_s_sleep(1); \
    if ((++_sp & 255u) == 0u) { if (xb_ld(&(bar)[XB_TMO])) break; if (_sp > XB_SPIN_CAP) { atomicAdd(&(bar)[XB_TMO], 1u); break; } } } } while (0)

struct XcdBarrier { unsigned* bar; unsigned x; volatile LAS unsigned* st; };

__device__ __forceinline__ XcdBarrier xcd_barrier_post(unsigned* bar, volatile LAS unsigned* st) {
    XcdBarrier b; b.bar = bar; b.x = xb_xcc_id(); b.st = st;
    if (threadIdx.x == 0) (void)xb_add(&bar[XB_XCNT(b.x)], 1u);
    return b;
}
__device__ __forceinline__ void xcd_barrier_complete(unsigned* bar, unsigned x, unsigned& nloc, unsigned& nx) {
    const unsigned G = gridDim.x * gridDim.y * gridDim.z;
    unsigned sum, cnt, mine, sp = 0u;
    for (;;) {
        sum = 0u; cnt = 0u; mine = 0u;
#pragma unroll
        for (unsigned j = 0; j < 16; ++j) { const unsigned c = xb_ld(&bar[XB_XCNT(j)]); sum += c; cnt += (c > 0u) ? 1u : 0u; mine = (j == x) ? c : mine; }
        if (sum == G) break;
        __builtin_amdgcn_s_sleep(1);
        if ((++sp & 255u) == 0u) { if (xb_ld(&bar[XB_TMO])) break; if (sp > XB_SPIN_CAP) { atomicAdd(&bar[XB_TMO], 1u); break; } }
    }
    nloc = mine > 0u ? mine : 1u; nx = cnt > 0u ? cnt : 1u;
}
__device__ __forceinline__ void xcd_barrier(const XcdBarrier& b) {
    asm volatile("s_waitcnt vmcnt(0)" ::: "memory");
    __syncthreads();
    if (threadIdx.x == 0) {
        unsigned* bar = b.bar;
        __builtin_amdgcn_s_waitcnt(0);
        unsigned nloc = b.st[0], nx = b.st[1];
        if (nloc == 0u) { xcd_barrier_complete(bar, b.x, nloc, nx); b.st[0] = nloc; b.st[1] = nx; }
        const unsigned old = xb_add(&bar[XB_XSUB(b.x)], 1u);
        const unsigned gen = old / nloc;
        if (old + 1u == (gen + 1u) * nloc) {
            __builtin_amdgcn_fence(__ATOMIC_RELEASE, "agent");
            asm volatile("s_waitcnt vmcnt(0)" ::: "memory");
            const unsigned og = xb_add(&bar[XB_TOP], 1u);
            const unsigned tg = og / nx;
            if (og + 1u == (tg + 1u) * nx) xb_add(&bar[XB_TOPGEN], 1u);
            else XB_SPIN(xb_ld(&bar[XB_TOPGEN]) == tg, bar);
            __builtin_amdgcn_fence(__ATOMIC_ACQUIRE, "agent");
            xb_add(&bar[XB_XGEN(b.x)], 1u);
            asm volatile("s_waitcnt vmcnt(0)" ::: "memory");
        } else {
            XB_SPIN(xb_ld(&bar[XB_XGEN(b.x)]) == gen, bar);
            __builtin_amdgcn_fence(__ATOMIC_ACQUIRE, "agent");
            asm volatile("s_waitcnt vmcnt(0)" ::: "memory");
        }
    }
    __syncthreads();
}

namespace pg8 {
constexpr int BM = 256, BK = 64, HALF = 128, HTB = HALF * BK * 2, STAGE_BYTES = 8 * HTB, NXCD = 8, WGM = 8;
static_assert(STAGE_BYTES == STAGE_BYTES_C, "stage bytes");
__host__ __device__ __forceinline__ int lds_byte(int r, int c) { const int st = (r >> 4) * 2 + (c >> 5), rr = r & 15, cc = c & 31, ob = rr * 64 + cc * 2; return st * 1024 + (ob ^ (((ob >> 9) & 1) << 5)); }
__host__ __device__ __forceinline__ void stage_rc(int b, int& R, int& C) { const int st = b / 1024, sb = b % 1024, swz = sb ^ (((sb >> 9) & 1) << 5); R = (st >> 1) * 16 + swz / 64; C = (st & 1) * 32 + (swz % 64) / 2; }
__host__ __device__ __forceinline__ int perm32(int rho) { const int n = rho >> 4, i = rho & 15; return 8 * (i >> 2) + 4 * n + (i & 3); }

struct Unit { int pm, pn; };
struct Gemm { const bf16_t* A; const bf16_t* Bt; int M, N, K, lda; int ablk; };

struct StaticOrder {
    int nM, nN, nwg, G, c, wgm;
    __host__ __device__ void init(int M, int N, int G_, int c_, int wgm_ = WGM) { nM = M / BM; nN = N / BM; nwg = nM * nN; G = G_; c = c_; wgm = wgm_; }
    __host__ __device__ bool next(int i, Unit& u) const {
        const long L = (long)i * G + c; if (L >= nwg) return false;
        int wgid = (int)L; { const int q = nwg / NXCD, r = nwg % NXCD, xcd = wgid % NXCD, off = wgid / NXCD; wgid = (xcd < r ? xcd * (q + 1) : r * (q + 1) + (xcd - r) * q) + off; }
        const int nig = wgm * nN, gid = wgid / nig, fm = gid * wgm, gsz = (nM - fm) < wgm ? (nM - fm) : wgm;
        u.pm = fm + ((wgid % nig) % gsz); u.pn = (wgid % nig) / gsz; return true;
    }
};

template <class Epi, bool REPE = false>
__device__ __forceinline__ void gemm_phase(LAS unsigned char* lds, const Gemm g, const StaticOrder& S, const Epi& E, const Epi& E0) {
    const int tid = opaque_tid(), wid = __builtin_amdgcn_readfirstlane(tid >> 6), lane = tid & 63, wr = wid >> 2, wc = wid & 3, fr = lane & 15, fq = lane >> 4;
    const int K = g.K, nt = K / BK, lda = g.lda;
    unsigned voffA[2], voffB[2];
#pragma unroll
    for (int i = 0; i < 2; ++i) { int R, C; stage_rc(tid * 16 + i * 8192, R, C); const int Rb = Epi::PERM ? ((R & ~31) + perm32(R & 31)) : R;
        voffA[i] = g.ablk ? (unsigned)((C >> 5) * (BM * 32) + R * 32 + (C & 31)) * 2u : (unsigned)(R * lda + C) * 2u; voffB[i] = (unsigned)(Rb * BK + C) * 2u; }
    const size_t kstep = (size_t)(BK * 2);
    const size_t hstepA = g.ablk ? (size_t)HALF * 32 * 2 : (size_t)HALF * lda * 2, hstepB = (size_t)HALF * BK * 2;
    const size_t kstepA = g.ablk ? (size_t)(BM * BK * 2) : kstep;
    const size_t kstepB = (size_t)(BM * BK * 2);
    const size_t tstepA = g.ablk ? (size_t)nt * kstepA : 2 * hstepA, tstepB = (size_t)nt * kstepB;
    const unsigned ldsw = (unsigned)wid * 1024u;
    const int aoff = lds_byte(wr * 64 + fr, fq * 8), boff = lds_byte(wc * 32 + fr, fq * 8);
#define PG8_SA(b, h) (((b) * 2 + (h)) * HTB)
#define PG8_SB(b, h) ((4 + (b) * 2 + (h)) * HTB)
#define PG8_STAGE(bufoff, gbase, voff) do { _Pragma("unroll") for (int _i = 0; _i < 2; ++_i) \
        __builtin_amdgcn_global_load_lds((const unsigned*)((const char*)(gbase) + (voff)[_i]), (LAS unsigned*)(lds + (bufoff) + ldsw + _i * 8192), 16, 0, 0); } while (0)
#define PG8_LDA(dst, b, h) do { _Pragma("unroll") for (int m = 0; m < 4; ++m) _Pragma("unroll") for (int k = 0; k < 2; ++k) dst[m][k] = *(const LAS bf16x8*)(lds + PG8_SA(b, h) + aoff + m * 2048 + k * 1024); } while (0)
#define PG8_LDB(dst, b, h) do { _Pragma("unroll") for (int n = 0; n < 2; ++n) _Pragma("unroll") for (int k = 0; k < 2; ++k) dst[n][k] = *(const LAS bf16x8*)(lds + PG8_SB(b, h) + boff + n * 2048 + k * 1024); } while (0)
#define PG8_MMA(ai, bj, At, Bt) do { __builtin_amdgcn_s_setprio(1); \
        if constexpr (Epi::I8) { _Pragma("unroll") for (int m = 0; m < 4; ++m) _Pragma("unroll") for (int n = 0; n < 2; ++n) _Pragma("unroll") for (int k = 0; k < 2; ++k) \
            acc[ai][bj][m][n] = __builtin_bit_cast(f32x4, __builtin_amdgcn_mfma_i32_16x16x64_i8(__builtin_bit_cast(i32x4, Bt[n][k]), __builtin_bit_cast(i32x4, At[m][k]), __builtin_bit_cast(i32x4, acc[ai][bj][m][n]), 0, 0, 0)); } \
        else { _Pragma("unroll") for (int m = 0; m < 4; ++m) _Pragma("unroll") for (int n = 0; n < 2; ++n) _Pragma("unroll") for (int k = 0; k < 2; ++k) \
            acc[ai][bj][m][n] = __builtin_amdgcn_mfma_f32_16x16x32_bf16(Bt[n][k], At[m][k], acc[ai][bj][m][n], 0, 0, 0); } \
        __builtin_amdgcn_s_setprio(0); } while (0)
#define PG8_WAIT_V(n) asm volatile("s_waitcnt vmcnt(" #n ")" ::: "memory")
#define PG8_WAIT_L(n) asm volatile("s_waitcnt lgkmcnt(" #n ")" ::: "memory")
#define PG8_BAR __builtin_amdgcn_s_barrier()
#define PG8_SCHED __builtin_amdgcn_sched_barrier(0)
    Unit cur, nxt; int ui = 0;
    if (!S.next(0, cur)) return;
    float rsn[8];
#pragma unroll
    for (int r = 0; r < 8; ++r) rsn[r] = 0.f;
    if (Epi::PREF) E.rs_first(cur, wr, fr, fq, rsn);
    f32x4 acc[2][2][4][2];
#pragma unroll
    for (int a = 0; a < 2; ++a)
#pragma unroll
        for (int b = 0; b < 2; ++b)
#pragma unroll
            for (int m = 0; m < 4; ++m)
#pragma unroll
                for (int n = 0; n < 2; ++n) acc[a][b][m][n] = (f32x4){0.f, 0.f, 0.f, 0.f};
    bf16x8 At[4][2], B0[2][2], B1[2][2];
    const char* cA = (const char*)g.A + (size_t)cur.pm * tstepA; const char* cB = (const char*)g.Bt + (size_t)cur.pn * tstepB;
    PG8_STAGE(PG8_SB(0, 0), cB, voffB); PG8_STAGE(PG8_SA(0, 0), cA, voffA); PG8_STAGE(PG8_SB(0, 1), cB + hstepB, voffB); PG8_STAGE(PG8_SA(0, 1), cA + hstepA, voffA);
    if (wr == 1) PG8_BAR;
    PG8_WAIT_V(4); PG8_BAR;
    PG8_STAGE(PG8_SB(1, 0), cB + kstepB, voffB); PG8_STAGE(PG8_SA(1, 0), cA + kstepA, voffA); PG8_STAGE(PG8_SB(1, 1), cB + hstepB + kstepB, voffB);
    PG8_WAIT_V(6); PG8_BAR;
    for (;;) {
        const bool has_next = S.next(ui + 1, nxt);
        const char* nA = has_next ? (const char*)g.A + (size_t)nxt.pm * tstepA : cA; const char* nB = has_next ? (const char*)g.Bt + (size_t)nxt.pn * tstepB : cB;
#pragma nounroll
        for (int t = 0; t < nt; t += 2) {
            const bool last = (t == nt - 2);
            const char* a1 = cA + (size_t)(t + 1) * kstepA;
            const char* a2 = last ? nA : cA + (size_t)(t + 2) * kstepA; const char* b2 = last ? nB : cB + (size_t)(t + 2) * kstepB;
            const char* a3 = a2 + kstepA; const char* b3 = b2 + kstepB;
            PG8_LDB(B0, 0, 0); PG8_SCHED; PG8_LDA(At, 0, 0); PG8_STAGE(PG8_SA(1, 1), a1 + hstepA, voffA);
            PG8_WAIT_L(8); PG8_BAR; PG8_WAIT_L(0); PG8_MMA(0, 0, At, B0); PG8_BAR; PG8_SCHED;
            PG8_LDB(B1, 0, 1); PG8_STAGE(PG8_SB(0, 0), b2, voffB);
            PG8_BAR; PG8_WAIT_L(0); PG8_MMA(0, 1, At, B1); PG8_BAR;
            PG8_LDA(At, 0, 1); PG8_STAGE(PG8_SA(0, 0), a2, voffA);
            PG8_BAR; PG8_WAIT_L(0); PG8_MMA(1, 0, At, B0); PG8_BAR; PG8_SCHED;
            PG8_STAGE(PG8_SB(0, 1), b2 + hstepB, voffB);
            PG8_WAIT_V(6); PG8_BAR; PG8_MMA(1, 1, At, B1); PG8_BAR;
            PG8_LDB(B0, 1, 0); PG8_SCHED; PG8_LDA(At, 1, 0); PG8_STAGE(PG8_SA(0, 1), a2 + hstepA, voffA);
            PG8_WAIT_L(8); PG8_BAR; PG8_WAIT_L(0); PG8_MMA(0, 0, At, B0); PG8_BAR; PG8_SCHED;
            PG8_LDB(B1, 1, 1); PG8_STAGE(PG8_SB(1, 0), b3, voffB);
            PG8_BAR; PG8_WAIT_L(0); PG8_MMA(0, 1, At, B1); PG8_BAR;
            PG8_LDA(At, 1, 1); PG8_STAGE(PG8_SA(1, 0), a3, voffA);
            PG8_BAR; PG8_WAIT_L(0); PG8_MMA(1, 0, At, B0); PG8_BAR; PG8_SCHED;
            PG8_STAGE(PG8_SB(1, 1), b3 + hstepB, voffB);
            PG8_WAIT_V(6); PG8_BAR; PG8_MMA(1, 1, At, B1); PG8_BAR;
        }
        if (REPE) { float rs2[8]; _Pragma("unroll") for (int r = 0; r < 8; ++r) rs2[r] = rsn[r]; E0(acc, cur, nxt, false, rs2, wr, wc, fr, fq); }
        E(acc, cur, nxt, has_next, rsn, wr, wc, fr, fq);
        if (!has_next) break;
#pragma unroll
        for (int a = 0; a < 2; ++a)
#pragma unroll
            for (int b = 0; b < 2; ++b)
#pragma unroll
                for (int m = 0; m < 4; ++m)
#pragma unroll
                    for (int n = 0; n < 2; ++n) acc[a][b][m][n] = (f32x4){0.f, 0.f, 0.f, 0.f};
        cur = nxt; cA = nA; cB = nB; ++ui;
    }
    PG8_WAIT_V(0);
    if (wr == 0) PG8_BAR;
    PG8_BAR;
#undef PG8_SA
#undef PG8_SB
#undef PG8_STAGE
#undef PG8_LDA
#undef PG8_LDB
#undef PG8_MMA
#undef PG8_WAIT_V
#undef PG8_WAIT_L
#undef PG8_BAR
#undef PG8_SCHED
}
}

__device__ __forceinline__ float silu_f(float x) { return x * __builtin_amdgcn_rcpf(1.0f + __expf(-x)); }

__device__ __forceinline__ void rstd8_from_part32(const float* part, int row0, int fq, float inv_n, float (&rs)[8]) {
    f32x4 pa[8], pb[8];
#pragma unroll
    for (int r = 0; r < 8; ++r) { const float* p = part + (size_t)(row0 + (r >> 2) * 128 + (r & 3) * 16) * 32 + fq * 8; pa[r] = *(const f32x4*)p; pb[r] = *(const f32x4*)(p + 4); }
#pragma unroll
    for (int r = 0; r < 8; ++r) {
        float sm = ((pa[r][0] + pa[r][1]) + (pa[r][2] + pa[r][3])) + ((pb[r][0] + pb[r][1]) + (pb[r][2] + pb[r][3]));
        sm += __shfl_xor(sm, 16); sm += __shfl_xor(sm, 32);
        rs[r] = rsqrtf(sm * inv_n + RMS_EPS);
    }
}
__device__ __forceinline__ void rstd8_load(const float* rstd, int row0, float (&rs)[8]) {
#pragma unroll
    for (int r = 0; r < 8; ++r) rs[r] = rstd[row0 + (r >> 2) * 128 + (r & 3) * 16];
}
struct EpiGU {
    static constexpr bool PERM = true, PREF = true, I8 = true;
    bf16_t* O; const float* part; const float* rstd; const float* wmax; unsigned* amax;
    __device__ __forceinline__ void rs_first(const pg8::Unit& u, int wr, int fr, int fq, float (&rs)[8]) const { if (rstd) rstd8_load(rstd, u.pm * 256 + wr * 64 + fr, rs); }
    __device__ __forceinline__ void operator()(const f32x4 (&acc)[2][2][4][2], const pg8::Unit& u, const pg8::Unit& nx, bool has_next, float (&rsn)[8], int wr, int wc, int fr_, int fq_) const {
        int fr = fr_, fq = fq_; asm volatile("" : "+v"(fr), "+v"(fq));
        const int row0 = u.pm * 256 + wr * 64 + fr, col0 = u.pn * 128 + wc * 32 + 8 * fq;
        float rsv[8], rsp[8];
        const float wsc = *wmax * (1.0f / 127.0f);
        unsigned mxr[8];
        if (rstd && !PREF) rstd8_load(rstd, row0, rsv);
        else if (rstd) {
#pragma unroll
            for (int r = 0; r < 8; ++r) { rsv[r] = rsn[r]; rsp[r] = rsn[r]; }
            if (has_next) rstd8_load(rstd, nx.pm * 256 + wr * 64 + fr, rsp);
        } else rstd8_from_part32(part, row0, fq, 1.0f / DM, rsv);
#pragma unroll
        for (int ai = 0; ai < 2; ++ai)
#pragma unroll
            for (int m = 0; m < 4; ++m) {
                const int row = row0 + ai * 128 + m * 16;
                const float rs = rsv[ai * 4 + m] * wsc;
                const float c1 = rs * -1.4426950408889634f;
                f32x2 op[4];
#pragma unroll
                for (int n = 0; n < 2; ++n)
#pragma unroll
                    for (int e2 = 0; e2 < 2; ++e2) {
                        const i32x4 gi = __builtin_bit_cast(i32x4, acc[ai][0][m][n]), ui = __builtin_bit_cast(i32x4, acc[ai][1][m][n]);
                        const f32x2 g2 = {(float)gi[2 * e2], (float)gi[2 * e2 + 1]}, u2 = {(float)ui[2 * e2], (float)ui[2 * e2 + 1]};
                        const f32x2 t2 = g2 * c1; f32x2 d2 = {__builtin_amdgcn_exp2f(t2.x), __builtin_amdgcn_exp2f(t2.y)}; d2 = d2 + 1.0f;
                        const f32x2 r2 = {__builtin_amdgcn_rcpf(d2.x), __builtin_amdgcn_rcpf(d2.y)};
                        op[n * 2 + e2] = (g2 * u2) * r2; }
                fwht8_pk(op);
                const float o[8] = {op[0][0], op[0][1], op[1][0], op[1][1], op[2][0], op[2][1], op[3][0], op[3][1]};
                {
                    unsigned mx, m2;
                    asm("v_max3_f32 %0, |%1|, |%2|, |%3|" : "=v"(mx) : "v"(o[0]), "v"(o[1]), "v"(o[2]));
                    asm("v_max3_f32 %0, |%1|, |%2|, |%3|" : "=v"(m2) : "v"(o[3]), "v"(o[4]), "v"(o[5]));
                    asm("v_max3_f32 %0, %1, |%2|, |%3|" : "=v"(mx) : "v"(mx), "v"(o[6]), "v"(o[7]));
                    mx = mx > m2 ? mx : m2;
                    { const u32x2 r = __builtin_amdgcn_permlane16_swap(mx, mx, false, false); mx = r.x > r.y ? r.x : r.y; }
                    { const u32x2 r = __builtin_amdgcn_permlane32_swap(mx, mx, false, false); mx = r.x > r.y ? r.x : r.y; }
                    mxr[ai * 4 + m] = mx;
                }
                u32x4 w; w.x = cvt_pk_bf16(o[0], o[1]); w.y = cvt_pk_bf16(o[2], o[3]); w.z = cvt_pk_bf16(o[4], o[5]); w.w = cvt_pk_bf16(o[6], o[7]);
                __builtin_nontemporal_store(w, (u32x4*)(O + ((((size_t)u.pm * (DFF / 64) + (col0 >> 6)) * 2 + ((col0 >> 5) & 1)) * 256 + (row & 255)) * 32 + (col0 & 31)));
            }
        if (fq == 0) {
#pragma unroll
            for (int r = 0; r < 8; ++r) __hip_atomic_fetch_max(amax + row0 + (r >> 2) * 128 + (r & 3) * 16, mxr[r], __ATOMIC_RELAXED, __HIP_MEMORY_SCOPE_AGENT);
        }
        if (rstd && PREF) {
#pragma unroll
            for (int r = 0; r < 8; ++r) rsn[r] = rsp[r];
        }
    }
};

template <bool I8_> struct EpiResT {
    static constexpr bool PERM = true, PREF = false, I8 = I8_;
    const float* basef; bf16_t* hb; float* part; float scale; const float* asc; const float* wmax;
    __device__ __forceinline__ void rs_first(const pg8::Unit&, int, int, int, float (&)[8]) const {}
    __device__ __forceinline__ void operator()(const f32x4 (&acc)[2][2][4][2], const pg8::Unit& u, const pg8::Unit&, bool, float (&)[8], int wr, int wc, int fr, int fq) const {
        const int row0 = u.pm * 256 + wr * 64 + fr, col0 = u.pn * 256 + wc * 32 + 8 * fq;
        const float wsc = I8 ? scale * (*wmax * (1.0f / 127.0f)) : scale;
#pragma unroll
        for (int ai = 0; ai < 2; ++ai)
#pragma unroll
        for (int mh = 0; mh < 2; ++mh) {
            f32x4 b0[2][2], b1[2][2]; float rowf[2];
#pragma unroll
            for (int m2 = 0; m2 < 2; ++m2) rowf[m2] = I8 ? wsc * asc[row0 + ai * 128 + (mh * 2 + m2) * 16] : scale;
            if (basef) {
#pragma unroll
                for (int m2 = 0; m2 < 2; ++m2)
#pragma unroll
                    for (int bj = 0; bj < 2; ++bj) { const float* p = basef + (size_t)(row0 + ai * 128 + (mh * 2 + m2) * 16) * DM + col0 + bj * 128; b0[m2][bj] = *(const f32x4*)p; b1[m2][bj] = *(const f32x4*)(p + 4); }
            } else {
#pragma unroll
                for (int m2 = 0; m2 < 2; ++m2)
#pragma unroll
                    for (int bj = 0; bj < 2; ++bj) { const u32x4 w = *(const u32x4*)(hb + (size_t)(row0 + ai * 128 + (mh * 2 + m2) * 16) * DM + col0 + bj * 128);
                        b0[m2][bj] = (f32x4){__uint_as_float(w.x << 16), __uint_as_float(w.x & 0xffff0000u), __uint_as_float(w.y << 16), __uint_as_float(w.y & 0xffff0000u)};
                        b1[m2][bj] = (f32x4){__uint_as_float(w.z << 16), __uint_as_float(w.z & 0xffff0000u), __uint_as_float(w.w << 16), __uint_as_float(w.w & 0xffff0000u)}; }
            }
#pragma unroll
            for (int m2 = 0; m2 < 2; ++m2) {
                const int m = mh * 2 + m2;
                const int row = row0 + ai * 128 + m * 16; float sq = 0.f;
#pragma unroll
                for (int bj = 0; bj < 2; ++bj) {
                    const f32x4 a0 = I8 ? __builtin_convertvector(__builtin_bit_cast(i32x4, acc[ai][bj][m][0]), f32x4) : acc[ai][bj][m][0], a1 = I8 ? __builtin_convertvector(__builtin_bit_cast(i32x4, acc[ai][bj][m][1]), f32x4) : acc[ai][bj][m][1];
                    const f32x4 v0 = b0[m2][bj] + a0 * rowf[m2], v1 = b1[m2][bj] + a1 * rowf[m2];
                    u32x4 w; w.x = cvt_pk_bf16(v0[0], v0[1]); w.y = cvt_pk_bf16(v0[2], v0[3]); w.z = cvt_pk_bf16(v1[0], v1[1]); w.w = cvt_pk_bf16(v1[2], v1[3]);
                    *(u32x4*)(hb + (size_t)row * DM + col0 + bj * 128) = w;
                    const float r0 = __uint_as_float(w.x << 16), r1 = __uint_as_float(w.x & 0xffff0000u), r2 = __uint_as_float(w.y << 16), r3 = __uint_as_float(w.y & 0xffff0000u);
                    const float r4 = __uint_as_float(w.z << 16), r5 = __uint_as_float(w.z & 0xffff0000u), r6 = __uint_as_float(w.w << 16), r7 = __uint_as_float(w.w & 0xffff0000u);
                    sq += ((r0 * r0 + r1 * r1) + (r2 * r2 + r3 * r3)) + ((r4 * r4 + r5 * r5) + (r6 * r6 + r7 * r7));
                }
                sq += __shfl_xor(sq, 16); sq += __shfl_xor(sq, 32);
                if (fq == 0) part[(size_t)row * 32 + u.pn * 4 + wc] = sq;
            }
        }
    }
};

template <int MODE> struct EpiScale {
    static constexpr bool PERM = true, PREF = (MODE == 0), I8 = false;
    bf16_t* O; int ldo; const float* part_in; float inv_n; float mul; float* part_q; float* part_kv; const float* rc; const float* rs; const float* rstd;
    __device__ __forceinline__ void rs_first(const pg8::Unit& u, int wr, int fr, int fq, float (&rv)[8]) const { if (MODE == 0 && rstd) rstd8_load(rstd, u.pm * 256 + wr * 64 + fr, rv); }
    __device__ __forceinline__ void operator()(const f32x4 (&acc)[2][2][4][2], const pg8::Unit& u, const pg8::Unit& nx, bool has_next, float (&rsn)[8], int wr, int wc, int fr, int fq) const {
        const int row0 = u.pm * 256 + wr * 64 + fr, col0 = u.pn * 256 + wc * 32 + 8 * fq;
        float rsv[8], rsp[8];
        if (MODE == 0 && rstd) {
#pragma unroll
            for (int r = 0; r < 8; ++r) { rsv[r] = rsn[r]; rsp[r] = rsn[r]; }
            if (has_next) rstd8_load(rstd, nx.pm * 256 + wr * 64 + fr, rsp);
        } else if (MODE == 0) rstd8_from_part32(part_in, row0, fq, inv_n, rsv);
        else if (MODE == 2) {
            f32x4 pa[8], pb[8];
#pragma unroll
            for (int r = 0; r < 8; ++r) { const float* p = part_in + (size_t)(row0 + (r >> 2) * 128 + (r & 3) * 16) * 8; pa[r] = *(const f32x4*)p; pb[r] = *(const f32x4*)(p + 4); }
#pragma unroll
            for (int r = 0; r < 8; ++r) rsv[r] = rsqrtf((((pa[r][0] + pa[r][1]) + (pa[r][2] + pa[r][3])) + ((pb[r][0] + pb[r][1]) + (pb[r][2] + pb[r][3]))) * inv_n + RMS_EPS);
        } else {
            f32x4 pa[8];
#pragma unroll
            for (int r = 0; r < 8; ++r) pa[r] = *(const f32x4*)(part_in + (size_t)(row0 + (r >> 2) * 128 + (r & 3) * 16) * 4);
#pragma unroll
            for (int r = 0; r < 8; ++r) rsv[r] = rsqrtf(((pa[r][0] + pa[r][1]) + (pa[r][2] + pa[r][3])) * inv_n + RMS_EPS);
        }
#pragma unroll
        for (int ai = 0; ai < 2; ++ai)
#pragma unroll
            for (int m = 0; m < 4; ++m) {
                const int row = row0 + ai * 128 + m * 16;
                const float r = rsv[ai * 4 + m] * mul;
                float sq = 0.f;
#pragma unroll
                for (int bj = 0; bj < 2; ++bj) {
                    const int c = col0 + bj * 128;
                    f32x4 v0 = acc[ai][bj][m][0] * r, v1 = acc[ai][bj][m][1] * r;
                    if (MODE == 2) {
                        const int cc = c % QKD;
                        if (cc >= 128) {
                            const int j0 = (cc - 128) >> 1;
                            const f32x4 cs = *(const f32x4*)(rc + (size_t)row * 32 + j0), sn = *(const f32x4*)(rs + (size_t)row * 32 + j0);
                            f32x4 a0, a1;
                            a0[0] = v0[0] * cs[0] - v0[1] * sn[0]; a0[1] = v0[0] * sn[0] + v0[1] * cs[0];
                            a0[2] = v0[2] * cs[1] - v0[3] * sn[1]; a0[3] = v0[2] * sn[1] + v0[3] * cs[1];
                            a1[0] = v1[0] * cs[2] - v1[1] * sn[2]; a1[1] = v1[0] * sn[2] + v1[1] * cs[2];
                            a1[2] = v1[2] * cs[3] - v1[3] * sn[3]; a1[3] = v1[2] * sn[3] + v1[3] * cs[3];
                            v0 = a0; v1 = a1;
                        }
                    }
                    if (MODE == 0) sq += (v0[0] * v0[0] + v0[1] * v0[1]) + (v0[2] * v0[2] + v0[3] * v0[3]) + (v1[0] * v1[0] + v1[1] * v1[1]) + (v1[2] * v1[2] + v1[3] * v1[3]);
                    u32x4 w; w.x = cvt_pk_bf16(v0[0], v0[1]); w.y = cvt_pk_bf16(v0[2], v0[3]); w.z = cvt_pk_bf16(v1[0], v1[1]); w.w = cvt_pk_bf16(v1[2], v1[3]);
                    __builtin_nontemporal_store(w, (u32x4*)(O + (size_t)row * ldo + c));
                }
                if (MODE == 0) {
                    if (u.pn < 3) {
                        sq += __shfl_xor(sq, 16); sq += __shfl_xor(sq, 32);
                        if (fq == 0) { if (u.pn < 2) part_q[(size_t)row * 8 + u.pn * 4 + wc] = sq; else part_kv[(size_t)row * 4 + wc] = sq; }
                    }
                }
            }
        if (MODE == 0 && rstd) {
#pragma unroll
            for (int r = 0; r < 8; ++r) rsn[r] = rsp[r];
        }
    }
};

struct Args { const void* in[32]; float* out; unsigned char* ws; int ph_lo, ph_hi; };

struct Ctx {
    const void* const* in; float* out; unsigned char* ws;
    LAS unsigned char* lds; int G, wg;
    __device__ __forceinline__ const float* fin(int i) const { return (const float*)in[i]; }
    template <class T> __device__ __forceinline__ T* at(size_t off) const { return (T*)(ws + off); }
    __device__ __forceinline__ Ctx fresh() const { Ctx c = *this; int z; asm volatile("s_mov_b32 %0, 0" : "=s"(z)); c.in = in + z; c.out = out + z; c.ws = ws + z; c.G = G + z; c.wg = wg + z; return c; }
};

enum { MAP_ID = 0, MAP_GU = 1, MAP_WIN = 2, MAP_UQ = 3 };
template <int MAP> __device__ __forceinline__ int src_col(int n) {
    if (MAP == MAP_WIN) { if (n >= NIN) return -1; if (n >= 768 && n < 832) { const int jj = n - 768; return 768 + (jj & 1) * 32 + (jj >> 1); } return n; }
    if (MAP == MAP_UQ) { const int h = n / QKD, cc = n % QKD; if (cc < 128) return n; const int jj = cc - 128; return h * QKD + 128 + (jj & 1) * 32 + (jj >> 1); }
    return n;
}
template <int MAP, bool F8 = false, bool HAD = false>
__device__ __forceinline__ void conv_job(const Ctx& C, int& toff, const float* src, const float* src2, int ldsrc, bf16_t* dst, int Ndst, int K, const float* gain, float qs = 1.0f) {
    LAS float* tile = (LAS float*)C.lds;
    const int tid = opaque_tid(), ntn = Ndst / 64, ntk = K / 256, ntiles = ntn * ntk;
    const int tfirst = (C.wg + C.G - toff % C.G) % C.G; toff += ntiles;
    for (int t = tfirst; t < ntiles; t += C.G) {
        const int tn = t % ntn, tk = t / ntn, n0 = tn * 64, k0 = tk * 256;
        {
            const int nl = tid & 63, kl0 = tid >> 6;
            const float* s = src; int col;
            if (MAP == MAP_GU) { const int n = n0 + nl, tt = n >> 8, r = n & 255; s = (r < 128) ? src : src2; col = tt * 128 + (r & 127); }
            else col = src_col<MAP>(n0 + nl);
            float v[32];
            const float* sp = s + (size_t)(k0 + kl0) * ldsrc + (col >= 0 ? col : 0);
#pragma unroll
            for (int i = 0; i < 32; ++i) v[i] = sp[(size_t)(8 * i) * ldsrc];
#pragma unroll
            for (int i = 0; i < 32; ++i) {
                float x = (col >= 0) ? v[i] : 0.f;
                if (gain) x *= gain[k0 + kl0 + 8 * i];
                if (F8) x *= qs;
                tile[(kl0 + 8 * i) * 65 + nl] = x;
            }
        }
        __syncthreads();
        {
            const int nl = tid >> 3, kc = (tid & 7) * 8;
#pragma unroll
            for (int q = 0; q < 4; ++q) {
                float v[8];
#pragma unroll
                for (int e = 0; e < 8; ++e) v[e] = tile[(q * 64 + kc + e) * 65 + nl];
                if (HAD) { fwht8(v);
#pragma unroll
                    for (int e = 0; e < 8; ++e) v[e] *= 0.35355339059327373f; }
                if (F8) {
                    u32x2 w8; w8.x = pk4_i8(v[0], v[1], v[2], v[3]); w8.y = pk4_i8(v[4], v[5], v[6], v[7]);
                    const int n_ = n0 + nl, kt_ = (k0 >> 7) + (q >> 1);
                    *(u32x2*)((unsigned char*)dst + (((size_t)(n_ >> 8) * (K >> 7) + kt_) * 256 + (n_ & 255)) * 128 + (q & 1) * 64 + kc) = w8;
                    continue;
                }
                u32x4 w; w.x = cvt_pk_bf16(v[0], v[1]); w.y = cvt_pk_bf16(v[2], v[3]); w.z = cvt_pk_bf16(v[4], v[5]); w.w = cvt_pk_bf16(v[6], v[7]);
                { const int n_ = n0 + nl, kt_ = (k0 >> 6) + q;
                  *(u32x4*)(dst + (((size_t)(n_ >> 8) * (K >> 6) + kt_) * 256 + (n_ & 255)) * 64 + kc) = w; }
            }
        }
        __syncthreads();
    }
}
template <bool GU, bool HAD>
__device__ __forceinline__ void conv_job_w(const Ctx& C, int& toff, const float* src, const float* src2, int ldsrc, unsigned char* dst, int Ndst, int K, const float* gain, float qs) {
    LAS float* tile = (LAS float*)C.lds;
    const int tid = opaque_tid(), ntn = Ndst / 256, ntk = K / 64, ntiles = ntn * ntk;
    const int tfirst = (C.wg + C.G - toff % C.G) % C.G; toff += ntiles;
    for (int t = tfirst; t < ntiles; t += C.G) {
        const int tn = t % ntn, tk = t / ntn, n0 = tn * 256, k0 = tk * 64;
        {
            const int n4 = tid & 63, kl0 = tid >> 6;
            const float* s = src; int col = n0 + 4 * n4;
            if (GU) { const int r = 4 * n4; s = (r < 128) ? src : src2; col = tn * 128 + (r & 127); }
            f32x4 v[8];
            const float* sp = s + (size_t)(k0 + kl0) * ldsrc + col;
#pragma unroll
            for (int i = 0; i < 8; ++i) v[i] = *(const f32x4*)(sp + (size_t)(8 * i) * ldsrc);
#pragma unroll
            for (int i = 0; i < 8; ++i) { float g = qs; if (gain) g *= gain[k0 + kl0 + 8 * i]; *(LAS f32x4*)(tile + (kl0 + 8 * i) * 260 + 4 * n4) = v[i] * g; }
        }
        __syncthreads();
#pragma unroll
        for (int j = 0; j < 4; ++j) {
            const int p = tid + 512 * j, kg = p & 7, nl = p >> 3;
            float v[8];
#pragma unroll
            for (int e = 0; e < 8; ++e) v[e] = tile[(kg * 8 + e) * 260 + nl];
            if (HAD) { fwht8(v);
#pragma unroll
                for (int e = 0; e < 8; ++e) v[e] *= 0.35355339059327373f; }
            u32x2 w8; w8.x = pk4_i8(v[0], v[1], v[2], v[3]); w8.y = pk4_i8(v[4], v[5], v[6], v[7]);
            const int n_ = n0 + nl, kk = k0 + kg * 8;
            *(u32x2*)(dst + (((size_t)(n_ >> 8) * (K >> 7) + (kk >> 7)) * 256 + (n_ & 255)) * 128 + (kk & 127)) = w8;
        }
        __syncthreads();
    }
}
__device__ __forceinline__ float wmax_scan(const Ctx& C, const float* w, const float* gain, float mx) {
    const int tid = opaque_tid();
    for (int k0 = C.wg; k0 < DM; k0 += 4 * C.G) {
        f32x4 v[4][3];
#pragma unroll
        for (int j = 0; j < 4; ++j) { const int k = k0 + j * C.G; const float* r = w + (size_t)(k < DM ? k : k0) * DFF;
#pragma unroll
            for (int i = 0; i < 3; ++i) { const int c = (i * 512 + tid) * 4; v[j][i] = *(const f32x4*)(r + (c < DFF ? c : 0)); } }
#pragma unroll
        for (int j = 0; j < 4; ++j) { const int k = k0 + j * C.G; float m = 0.f;
#pragma unroll
            for (int i = 0; i < 3; ++i) m = fmaxf(fmaxf(m, fmaxf(__builtin_fabsf(v[j][i][0]), __builtin_fabsf(v[j][i][1]))), fmaxf(__builtin_fabsf(v[j][i][2]), __builtin_fabsf(v[j][i][3])));
            mx = fmaxf(mx, m * __builtin_fabsf(gain[k < DM ? k : k0])); }
    }
    return mx;
}
__device__ __forceinline__ float wmax_scan_rot(const Ctx& C, const float* w) {
    const int tid = opaque_tid(); float mx = 0.f;
    for (int grp = C.wg; grp < DFF / 8; grp += C.G) {
        f32x4 v[8];
#pragma unroll
        for (int j = 0; j < 8; ++j) v[j] = *(const f32x4*)(w + (size_t)(grp * 8 + j) * DM + tid * 4);
#pragma unroll
        for (int c = 0; c < 4; ++c) { float t[8];
#pragma unroll
            for (int j = 0; j < 8; ++j) t[j] = v[j][c];
            fwht8(t);
#pragma unroll
            for (int j = 0; j < 8; ++j) mx = fmaxf(mx, __builtin_fabsf(t[j] * 0.35355339059327373f)); }
    }
    return mx;
}
__device__ __forceinline__ void phase_convert(const Ctx& C, int l, const XcdBarrier& bar) {
    const size_t offGU = (size_t)l * DM * DFF, offD = (size_t)l * DFF * DM; int toff = 0;
    unsigned* wm = C.at<unsigned>(WS_CTL + CW_WMAX) + l * 2;
    {
#pragma unroll
        for (int f = 0; f < 2; ++f) {
            float mx = wmax_scan(C, C.fin(f ? 28 : 3) + offGU, C.fin(f ? 27 : 2) + l * DM, 0.f);
            mx = wmax_scan(C, C.fin(f ? 29 : 4) + offGU, C.fin(f ? 27 : 2) + l * DM, mx);
#pragma unroll
            for (int o = 32; o >= 1; o >>= 1) mx = fmaxf(mx, __shfl_xor(mx, o));
            if ((opaque_tid() & 63) == 0) __hip_atomic_fetch_max(wm + f, __float_as_uint(mx), __ATOMIC_RELAXED, __HIP_MEMORY_SCOPE_AGENT);
            float md = wmax_scan_rot(C, C.fin(f ? 30 : 5) + offD);
#pragma unroll
            for (int o = 32; o >= 1; o >>= 1) md = fmaxf(md, __shfl_xor(md, o));
            if ((opaque_tid() & 63) == 0) __hip_atomic_fetch_max(wm + 8 + f, __float_as_uint(md), __ATOMIC_RELAXED, __HIP_MEMORY_SCOPE_AGENT);
        }
        xcd_barrier(bar);
    }
    const float wmaxd1 = __uint_as_float(__hip_atomic_load(wm + 8, __ATOMIC_RELAXED, __HIP_MEMORY_SCOPE_AGENT)), wmaxd2 = __uint_as_float(__hip_atomic_load(wm + 9, __ATOMIC_RELAXED, __HIP_MEMORY_SCOPE_AGENT));
    const float qd1 = wmaxd1 > 0.f ? 127.0f / wmaxd1 : 0.f, qd2 = wmaxd2 > 0.f ? 127.0f / wmaxd2 : 0.f;
    const float wmax1 = __uint_as_float(__hip_atomic_load(wm + 0, __ATOMIC_RELAXED, __HIP_MEMORY_SCOPE_AGENT)), wmax2 = __uint_as_float(__hip_atomic_load(wm + 1, __ATOMIC_RELAXED, __HIP_MEMORY_SCOPE_AGENT));
    const float qs1 = wmax1 > 0.f ? 127.0f / wmax1 : 0.f, qs2 = wmax2 > 0.f ? 127.0f / wmax2 : 0.f;
    conv_job_w<false, true>(C, toff, C.fin(30) + offD, nullptr, DM, C.at<unsigned char>(WS_W2D), DM, DFF, nullptr, qd2);
    conv_job_w<true, false>(C, toff, C.fin(28) + offGU, C.fin(29) + offGU, DFF, C.at<unsigned char>(WS_W2GU), 2 * DFF, DM, C.fin(27) + l * DM, qs2);
    conv_job_w<false, true>(C, toff, C.fin(5) + offD, nullptr, DM, C.at<unsigned char>(WS_W1D), DM, DFF, nullptr, qd1);
    conv_job_w<true, false>(C, toff, C.fin(3) + offGU, C.fin(4) + offGU, DFF, C.at<unsigned char>(WS_W1GU), 2 * DFF, DM, C.fin(2) + l * DM, qs1);
    conv_job<MAP_WIN>(C, toff, C.fin(7) + (size_t)l * DM * NIN, nullptr, NIN, C.at<bf16_t>(WS_WIN), NINP, DM, C.fin(6) + l * DM);
    conv_job<MAP_UQ>(C, toff, C.fin(10) + (size_t)l * QL * NQ, nullptr, NQ, C.at<bf16_t>(WS_WUQ), NQ, QL, C.fin(8) + l * QL);
    conv_job<MAP_ID>(C, toff, C.fin(11) + (size_t)l * KVL * NKV, nullptr, NKV, C.at<bf16_t>(WS_WUKV), NKV, KVL, C.fin(9) + l * KVL);
    conv_job<MAP_ID>(C, toff, C.fin(26) + (size_t)l * DM * DM, nullptr, DM, C.at<bf16_t>(WS_WOUT), DM, DM, nullptr);
    {
        const int tid = opaque_tid(); bf16_t* Ub = C.at<bf16_t>(WS_LORA);
        const float* dU = C.fin(15) + (size_t)l * 32 * BW; const float* iU = C.fin(17) + (size_t)l * 32 * BW; const float* gU = C.fin(18) + (size_t)l * 96 * BW;
        for (int e = C.wg * NTHREADS + tid; e < 512 * 160; e += C.G * NTHREADS) {
            const int k = e >> 9, n = e & 511;
            const float v = (k < 32) ? dU[k * BW + n] : (k < 64 ? iU[(k - 32) * BW + n] : gU[(k - 64) * BW + n]);
            Ub[n * 160 + k] = f2bf(v);
        }
    }
}

__device__ __forceinline__ void phase_prologue(const Ctx& C) {
    const int tid = opaque_tid(), lane = tid & 63, wv = tid >> 6;
    const float* x = C.fin(0); bf16_t* hb = C.at<bf16_t>(WS_HB); float* part = C.at<float>(WS_PARTH); unsigned char* h8 = C.at<unsigned char>(WS_H8);
    for (int row = C.wg * 8 + wv; row < MTOK; row += C.G * 8) {
        float s = 0.f, mx = 0.f; f32x4 v[8];
#pragma unroll
        for (int i = 0; i < 8; ++i) {
            const size_t off = (size_t)row * DM + (i * 64 + lane) * 4;
            v[i] = *(const f32x4*)(x + off);
            u32x2 w; w.x = cvt_pk_bf16(v[i][0], v[i][1]); w.y = cvt_pk_bf16(v[i][2], v[i][3]);
            *(u32x2*)(hb + off) = w;
            s += (v[i][0] * v[i][0] + v[i][1] * v[i][1]) + (v[i][2] * v[i][2] + v[i][3] * v[i][3]);
            mx = fmaxf(fmaxf(mx, fmaxf(__builtin_fabsf(v[i][0]), __builtin_fabsf(v[i][1]))), fmaxf(__builtin_fabsf(v[i][2]), __builtin_fabsf(v[i][3])));
        }
        s = wave_sum(s);
#pragma unroll
        for (int o = 32; o >= 1; o >>= 1) mx = fmaxf(mx, __shfl_xor(mx, o));
        const float qs = mx > 0.f ? 127.0f / mx : 0.f;
#pragma unroll
        for (int i = 0; i < 8; ++i) *(unsigned*)(h8 + (size_t)row * DM + (i * 64 + lane) * 4) = pk4_i8(v[i][0] * qs, v[i][1] * qs, v[i][2] * qs, v[i][3] * qs);
        if (lane < 32) part[(size_t)row * 32 + lane] = (lane == 0) ? s : 0.f;
        const float rstd = rsqrtf(s * (1.0f / DM) + RMS_EPS);
        if (lane == 0) { C.at<float>(WS_RSTD)[row] = rstd; C.at<float>(WS_RSA)[row] = rstd * (mx * (1.0f / 127.0f)); C.at<unsigned>(WS_AMAX)[row] = 0u; C.at<unsigned>(WS_AMAX2)[row] = 0u; }
    }
    const int* pos = (const int*)C.in[1]; float* rc = C.at<float>(WS_ROPEC); float* rs = C.at<float>(WS_ROPES);
    for (int i = C.wg * NTHREADS + tid; i < MTOK * 32; i += C.G * NTHREADS) {
        const int m = i >> 5, j = i & 31;
        const float inv = 1.0f / powf(10000.0f, (float)(2 * j) * (1.0f / 64.0f));
        const float ang = (float)pos[m] * inv;
        const double ad = (double)ang; const double n = rint(ad * 0.15915494309189535); const float red = (float)(ad - n * 6.283185307179586);
        rc[i] = cosf(red); rs[i] = sinf(red);
    }
}

__device__ __forceinline__ void rstd_pass(const Ctx& C) {
    const int tid = opaque_tid();
    const float* part = C.at<float>(WS_PARTH); float* rstd = C.at<float>(WS_RSTD);
    for (int row = C.wg * 128 + (tid >> 2); row < MTOK; row += C.G * 128) {
        const float* p = part + (size_t)row * 32 + (tid & 3) * 8;
        const f32x4 a = *(const f32x4*)p, b = *(const f32x4*)(p + 4);
        float sm = ((a[0] + a[1]) + (a[2] + a[3])) + ((b[0] + b[1]) + (b[2] + b[3]));
        sm += dpp_mov<0xB1>(sm); sm += dpp_mov<0x4E>(sm);
        if ((tid & 3) == 0) rstd[row] = rsqrtf(sm * (1.0f / DM) + RMS_EPS);
    }
}

__device__ __forceinline__ void quant_pass(const Ctx& C) {
    const int tid = opaque_tid(), lane = tid & 63, wv = tid >> 6;
    const bf16_t* hb = C.at<bf16_t>(WS_HB); unsigned char* h8 = C.at<unsigned char>(WS_H8); float* rsa = C.at<float>(WS_RSA);
    for (int row0 = (C.wg * 8 + wv) * 2; row0 < MTOK; row0 += C.G * 16) {
        u32x4 w[2][4];
#pragma unroll
        for (int r = 0; r < 2; ++r)
#pragma unroll
            for (int i = 0; i < 4; ++i) w[r][i] = *(const u32x4*)(hb + (size_t)(row0 + r) * DM + (i * 64 + lane) * 8);
#pragma unroll
        for (int r = 0; r < 2; ++r) {
            float v[4][8]; float s = 0.f, mx = 0.f;
#pragma unroll
            for (int i = 0; i < 4; ++i) {
                v[i][0] = __uint_as_float(w[r][i].x << 16); v[i][1] = __uint_as_float(w[r][i].x & 0xffff0000u); v[i][2] = __uint_as_float(w[r][i].y << 16); v[i][3] = __uint_as_float(w[r][i].y & 0xffff0000u);
                v[i][4] = __uint_as_float(w[r][i].z << 16); v[i][5] = __uint_as_float(w[r][i].z & 0xffff0000u); v[i][6] = __uint_as_float(w[r][i].w << 16); v[i][7] = __uint_as_float(w[r][i].w & 0xffff0000u);
#pragma unroll
                for (int e = 0; e < 8; ++e) { s += v[i][e] * v[i][e]; mx = fmaxf(mx, __builtin_fabsf(v[i][e])); }
            }
            s = wave_sum_fast(s);
#pragma unroll
            for (int o = 32; o >= 1; o >>= 1) mx = fmaxf(mx, __shfl_xor(mx, o));
            const float qs = mx > 0.f ? 127.0f / mx : 0.f;
#pragma unroll
            for (int i = 0; i < 4; ++i) { u32x2 q; q.x = pk4_i8(v[i][0] * qs, v[i][1] * qs, v[i][2] * qs, v[i][3] * qs); q.y = pk4_i8(v[i][4] * qs, v[i][5] * qs, v[i][6] * qs, v[i][7] * qs);
                *(u32x2*)(h8 + (size_t)(row0 + r) * DM + (i * 64 + lane) * 8) = q; }
            if (lane == 0) rsa[row0 + r] = rsqrtf(s * (1.0f / DM) + RMS_EPS) * (mx * (1.0f / 127.0f));
        }
    }
}

__device__ __forceinline__ void actq_pass(const Ctx& C, size_t amax_off, size_t amax_other, const float* wmax) {
    const int tid = opaque_tid(), lane = tid & 63, wv = tid >> 6, pc = lane & 3;
    const bf16_t* act = C.at<bf16_t>(WS_ACT); unsigned char* a8 = C.at<unsigned char>(WS_ACT8);
    for (int item = C.wg; item < (MTOK / 256) * 2; item += C.G) {
        const int pm = item >> 1, hk = item & 1;
        int rr[2]; float qs[2];
#pragma unroll
        for (int sg = 0; sg < 2; ++sg) {
            rr[sg] = wv * 32 + sg * 16 + (lane >> 2); const int row = pm * 256 + rr[sg];
            const float mx = __uint_as_float(C.at<unsigned>(amax_off)[row]);
            qs[sg] = mx > 0.f ? 127.0f / mx : 0.f;
            if (hk == 0 && pc == 0) {
                const float rs = C.at<float>(WS_RSA)[row] * (*wmax * (1.0f / 127.0f));
                C.at<float>(WS_ASC)[row] = mx * (1.0f / 127.0f) * (rs * rs * 0.35355339059327373f); C.at<unsigned>(amax_other)[row] = 0u; }
        }
#pragma nounroll
        for (int kt0 = hk * (DFF / 128); kt0 < (hk + 1) * (DFF / 128); kt0 += 4) {
            u32x4 w[4][2][2];
#pragma unroll
            for (int t = 0; t < 4; ++t)
#pragma unroll
                for (int jh = 0; jh < 2; ++jh)
#pragma unroll
                    for (int sg = 0; sg < 2; ++sg) w[t][jh][sg] = __builtin_nontemporal_load((const u32x4*)(act + ((((size_t)pm * (DFF / 64) + kt0 + t) * 2 + jh) * 256 + rr[sg]) * 32 + pc * 8));
#pragma unroll
            for (int t = 0; t < 4; ++t) {
                const int kt = kt0 + t;
                unsigned char* blk = a8 + (((size_t)pm * (DFF / 128) + (kt >> 1)) * 2 + (kt & 1)) * (256 * 64);
#pragma unroll
                for (int sg = 0; sg < 2; ++sg)
#pragma unroll
                    for (int jh = 0; jh < 2; ++jh) {
                        const u32x4 x = w[t][jh][sg]; const float q = qs[sg];
                        u32x2 o;
                        o.x = pk4_i8(__uint_as_float(x.x << 16) * q, __uint_as_float(x.x & 0xffff0000u) * q, __uint_as_float(x.y << 16) * q, __uint_as_float(x.y & 0xffff0000u) * q);
                        o.y = pk4_i8(__uint_as_float(x.z << 16) * q, __uint_as_float(x.z & 0xffff0000u) * q, __uint_as_float(x.w << 16) * q, __uint_as_float(x.w & 0xffff0000u) * q);
                        *(u32x2*)(blk + rr[sg] * 64 + jh * 32 + pc * 8) = o;
                    }
            }
        }
    }
}

__device__ __forceinline__ void prep_phase(const Ctx& C, int l) {
    const int tid = opaque_tid(), lane = tid & 63, wv = __builtin_amdgcn_readfirstlane(tid >> 6);
    const bf16_t* P = C.at<bf16_t>(WS_P);
    LAS bf16_t* Lin = (LAS bf16_t*)C.lds;
    LAS float* Lout = (LAS float*)(C.lds + 8192);
    const float* mu = C.fin(13) + l * 1696;
    const int c = tid;
    const float w0 = C.fin(14)[l * BW + c], a0 = C.fin(16)[l * BW + c], kkc = C.fin(19)[l * BW + c], kac = C.fin(20)[l * BW + c];
    const float mur = mu[c], muk = mu[512 + c], muv = mu[1024 + c];
    const float rkc = C.fin(21)[l * BW + c];
    const float cw0 = C.fin(24)[l * 1536 + c], cw1 = C.fin(24)[l * 1536 + 512 + c], cw2 = C.fin(24)[l * 1536 + 1024 + c], gn = C.fin(25)[l * BW + c];
    const int n = lane & 15, kg = lane >> 4;
#pragma nounroll
    for (int item = C.wg; item < MTOK / 16; item += C.G) {
        const int tid = opaque_tid(), lane = tid & 63, c = tid, n = lane & 15, kg = lane >> 4;
        const int b = item >> 7, t0 = (item & 127) * 16;
        const size_t m0 = (size_t)b * SEQ + t0;
        bf16x8 bfr[4][5];
        {
            const bf16_t* Ub = C.at<bf16_t>(WS_LORA) + (size_t)(wv * 64 + n) * 160 + kg * 8;
#pragma unroll
            for (int nt = 0; nt < 4; ++nt)
#pragma unroll
                for (int ks = 0; ks < 5; ++ks) bfr[nt][ks] = *(const bf16x8*)(Ub + nt * 16 * 160 + ks * 32);
        }
        for (int e = tid; e < 2560; e += NTHREADS) {
            const int tt = e / 160, j = e - tt * 160, col = 2368 + j;
            const float cur = bf2f(P[(m0 + tt) * NINP + col]);
            const float prev = (t0 + tt > 0) ? bf2f(P[(m0 + tt - 1) * NINP + col]) : 0.f;
            float xs = cur + (prev - cur) * mu[1536 + j];
            if (j < 32) xs = tanhf(xs); else if (j >= 64) xs = sigmoid_fast(xs);
            Lin[tt * 168 + j] = f2bf(xs);
        }
        __syncthreads();
        {
            bf16x8 af[5];
#pragma unroll
            for (int ks = 0; ks < 5; ++ks) af[ks] = *(const LAS bf16x8*)(Lin + n * 168 + ks * 32 + kg * 8);
#pragma unroll
            for (int nt = 0; nt < 4; ++nt) {
                const f32x4 z = {0.f, 0.f, 0.f, 0.f};
                const f32x4 cw = __builtin_amdgcn_mfma_f32_16x16x32_bf16(af[0], bfr[nt][0], z, 0, 0, 0);
                const f32x4 ca = __builtin_amdgcn_mfma_f32_16x16x32_bf16(af[1], bfr[nt][1], z, 0, 0, 0);
                f32x4 cg = __builtin_amdgcn_mfma_f32_16x16x32_bf16(af[2], bfr[nt][2], z, 0, 0, 0);
                cg = __builtin_amdgcn_mfma_f32_16x16x32_bf16(af[3], bfr[nt][3], cg, 0, 0, 0);
                cg = __builtin_amdgcn_mfma_f32_16x16x32_bf16(af[4], bfr[nt][4], cg, 0, 0, 0);
                const int ch = wv * 64 + nt * 16 + n;
#pragma unroll
                for (int j = 0; j < 4; ++j) { const int tok = kg * 4 + j;
                    Lout[tok * 512 + ch] = cw[j]; Lout[8192 + tok * 512 + ch] = ca[j]; Lout[16384 + tok * 512 + ch] = cg[j]; }
            }
        }
        __syncthreads();
        unsigned tA[8], tB[8], tK[8], tR[8], tV[8]; float PCv;
        {
            float pr = 0.f, pk = 0.f, pv = 0.f, um2 = 0.f, um1 = 0.f;
            if (t0 > 0) { const bf16_t* pp = P + (m0 - 1) * NINP + c; pr = bf2f(pp[PB0]); pk = bf2f(pp[PB0 + 512]); pv = bf2f(pp[PB0 + 1024]);
                um1 = bf2f(pp[PC0 + 512]) * bf2f(pp[PC0 + 1024]); const bf16_t* p2 = pp - NINP; um2 = bf2f(p2[PC0 + 512]) * bf2f(p2[PC0 + 1024]); }
            bf16_t* Gp = C.at<bf16_t>(WS_G) + m0 * BW + c;
            bf16_t* Bvp = C.at<bf16_t>(WS_BV) + m0 * BW + c;
            bf16_t* Y = C.at<bf16_t>(WS_Y) + m0 * DM + 1536 + c;
            float Pc = 1.0f;
            float sA[2], sB[2], sK[2], sR[2], sV[2];
#pragma unroll
            for (int hb8 = 0; hb8 < 2; ++hb8) {
                bf16_t raw[8][6];
#pragma unroll
                for (int i = 0; i < 8; ++i) { const bf16_t* pp = P + (m0 + hb8 * 8 + i) * NINP + c;
                    raw[i][0] = pp[PB0]; raw[i][1] = pp[PB0 + 512]; raw[i][2] = pp[PB0 + 1024]; raw[i][3] = pp[PC0]; raw[i][4] = pp[PC0 + 512]; raw[i][5] = pp[PC0 + 1024]; }
#pragma unroll
                for (int i = 0; i < 8; ++i) {
                    const int tt = hb8 * 8 + i;
                    const float cr = bf2f(raw[i][0]), ck = bf2f(raw[i][1]), cv = bf2f(raw[i][2]);
                    const float r = cr + (pr - cr) * mur, k = ck + (pk - ck) * muk, v = cv + (pv - cv) * muv;
                    pr = cr; pk = ck; pv = cv;
                    const float decay = __builtin_amdgcn_exp2f(-0.6065306597126334f * 1.4426950408889634f * sigmoid_fast(w0 + Lout[tt * 512 + c]));
                    const float a = sigmoid_fast(a0 + Lout[8192 + tt * 512 + c]);
                    float kk = k * kkc;
                    const float ss = wave_sum_fast(kk * kk);
                    kk = kk * __builtin_amdgcn_rsqf(fmaxf(ss, 1e-24f));
                    const float kmod = k * (1.0f + (a - 1.0f) * kac);
                    const float bonus = wave_sum_fast(r * kmod * rkc);
                    Bvp[(size_t)tt * BW] = f2bf(bonus * v);
                    Gp[(size_t)tt * BW] = f2bf(Lout[16384 + tt * 512 + c]);
                    const float Pprev = Pc; Pc = Pc * decay; const float invP = __builtin_amdgcn_rcpf(Pc);
                    sA[i & 1] = -kk * Pprev; sB[i & 1] = kk * a * invP; sK[i & 1] = kmod * invP; sR[i & 1] = r * Pc; sV[i & 1] = v;
                    if (i & 1) { tA[tt >> 1] = cvt_pk_bf16(sA[0], sA[1]); tB[tt >> 1] = cvt_pk_bf16(sB[0], sB[1]); tK[tt >> 1] = cvt_pk_bf16(sK[0], sK[1]); tR[tt >> 1] = cvt_pk_bf16(sR[0], sR[1]); tV[tt >> 1] = cvt_pk_bf16(sV[0], sV[1]); }
                    const float bg = bf2f(raw[i][3]), u = bf2f(raw[i][4]) * bf2f(raw[i][5]);
                    const float yv = cw0 * um2 + cw1 * um1 + cw2 * u;
                    um2 = um1; um1 = u;
                    const float z = bg * yv;
                    const float s2 = wave_sum_fast(z * z);
                    Y[(size_t)tt * DM] = f2bf(z * __builtin_amdgcn_rsqf(s2 * (1.0f / 64.0f) + RMS_EPS) * gn);
                }
            }
            PCv = Pc;
        }
        {
            const int tt = tid >> 5, i = tid & 31; const size_t m = m0 + tt;
            const unsigned pr2 = *(const unsigned*)(P + m * NINP + 768 + 2 * i);
            const float x1 = __uint_as_float(pr2 << 16), x2 = __uint_as_float(pr2 & 0xffff0000u);
            const float cs = C.at<float>(WS_ROPEC)[m * 32 + i], sn = C.at<float>(WS_ROPES)[m * 32 + i];
            *(unsigned*)(C.at<bf16_t>(WS_KR) + m * 64 + 2 * i) = cvt_pk_bf16(x1 * cs - x2 * sn, x1 * sn + x2 * cs);
        }
        __syncthreads();
        {
            LAS unsigned char* HB = C.lds + 8192 + wv * 16384;
            LAS bf16_t* tl = (LAS bf16_t*)HB;
            LAS float* mats = (LAS float*)(HB + 8192);
#pragma unroll
            for (int p2 = 0; p2 < 8; ++p2) {
                tl[(2 * p2) * 64 + lane] = (bf16_t)(tA[p2] & 0xffffu); tl[(2 * p2 + 1) * 64 + lane] = (bf16_t)(tA[p2] >> 16);
                tl[1024 + (2 * p2) * 64 + lane] = (bf16_t)(tB[p2] & 0xffffu); tl[1024 + (2 * p2 + 1) * 64 + lane] = (bf16_t)(tB[p2] >> 16);
                tl[2048 + (2 * p2) * 64 + lane] = (bf16_t)(tK[p2] & 0xffffu); tl[2048 + (2 * p2 + 1) * 64 + lane] = (bf16_t)(tK[p2] >> 16);
                tl[3072 + (2 * p2) * 64 + lane] = (bf16_t)(tR[p2] & 0xffffu); tl[3072 + (2 * p2 + 1) * 64 + lane] = (bf16_t)(tR[p2] >> 16);
            }
            {
                bf16x8 fa[2], fb[2], fk[2], fr[2];
#pragma unroll
                for (int ks = 0; ks < 2; ++ks) { const int o = n * 64 + ks * 32 + kg * 8;
                    fa[ks] = *(const LAS bf16x8*)(tl + o); fb[ks] = *(const LAS bf16x8*)(tl + 1024 + o); fk[ks] = *(const LAS bf16x8*)(tl + 2048 + o); fr[ks] = *(const LAS bf16x8*)(tl + 3072 + o); }
                const f32x4 z = {0.f, 0.f, 0.f, 0.f};
                f32x4 gN = __builtin_amdgcn_mfma_f32_16x16x32_bf16(fb[0], fa[0], z, 0, 0, 0); gN = __builtin_amdgcn_mfma_f32_16x16x32_bf16(fb[1], fa[1], gN, 0, 0, 0);
                f32x4 gM = __builtin_amdgcn_mfma_f32_16x16x32_bf16(fk[0], fa[0], z, 0, 0, 0); gM = __builtin_amdgcn_mfma_f32_16x16x32_bf16(fk[1], fa[1], gM, 0, 0, 0);
                f32x4 gB = __builtin_amdgcn_mfma_f32_16x16x32_bf16(fb[0], fr[0], z, 0, 0, 0); gB = __builtin_amdgcn_mfma_f32_16x16x32_bf16(fb[1], fr[1], gB, 0, 0, 0);
                f32x4 gK = __builtin_amdgcn_mfma_f32_16x16x32_bf16(fk[0], fr[0], z, 0, 0, 0); gK = __builtin_amdgcn_mfma_f32_16x16x32_bf16(fk[1], fr[1], gK, 0, 0, 0);
#pragma unroll
                for (int j = 0; j < 4; ++j) { const int i = 4 * kg + j; if (!(i < n)) { gN[j] = 0.f; gM[j] = 0.f; } if (!(i <= n)) { gB[j] = 0.f; gK[j] = 0.f; } }
                *(LAS f32x4*)(mats + n * 16 + 4 * kg) = gN; *(LAS f32x4*)(mats + 256 + n * 16 + 4 * kg) = gM;
                *(LAS f32x4*)(mats + 512 + n * 16 + 4 * kg) = gB; *(LAS f32x4*)(mats + 768 + n * 16 + 4 * kg) = gK;
            }
            float Tr[16], TEr[16];
#pragma unroll
            for (int t = 0; t < 16; ++t) {
                float nr[16];
#pragma unroll
                for (int q4 = 0; q4 < 4; ++q4) { const f32x4 x = *(const LAS f32x4*)(mats + t * 16 + 4 * q4); nr[4 * q4] = x[0]; nr[4 * q4 + 1] = x[1]; nr[4 * q4 + 2] = x[2]; nr[4 * q4 + 3] = x[3]; }
                float acc = (n == t) ? 1.0f : 0.0f;
#pragma unroll
                for (int s2 = 0; s2 < t; ++s2) acc += Tr[s2] * nr[s2];
                Tr[t] = acc;
                asm volatile("" ::: "memory");
            }
#pragma unroll
            for (int t = 0; t < 16; ++t) {
                float er[16];
#pragma unroll
                for (int q4 = 0; q4 < 4; ++q4) { const f32x4 x = *(const LAS f32x4*)(mats + 512 + t * 16 + 4 * q4); er[4 * q4] = x[0]; er[4 * q4 + 1] = x[1]; er[4 * q4 + 2] = x[2]; er[4 * q4 + 3] = x[3]; }
                float acc = 0.f;
#pragma unroll
                for (int s2 = 0; s2 <= t; ++s2) acc += Tr[s2] * er[s2];
                TEr[t] = acc;
                asm volatile("" ::: "memory");
            }
            LAS float* Tt = mats + 1024; LAS float* TEt = mats + 1280;
#pragma unroll
            for (int t = 0; t < 16; ++t) { Tt[t * 16 + n] = Tr[t]; TEt[t * 16 + n] = TEr[t]; }
            float Mr[16];
#pragma unroll
            for (int s2 = 0; s2 < 16; ++s2) Mr[s2] = mats[256 + s2 * 16 + n];
            unsigned char* CBg = C.ws + WS_SCAN + ((size_t)(b * 8 + wv) * (SEQ / 16) + (t0 >> 4)) * CB_BYTES;
            bf16_t* WAg = (bf16_t*)(CBg + CB_WA); bf16_t* QAg = (bf16_t*)(CBg + CB_QA); bf16_t* MTg = (bf16_t*)(CBg + CB_MT); bf16_t* Q2g = (bf16_t*)(CBg + CB_Q2);
            const int wks = lane >> 5, wq = (lane >> 2) & 3, we = 4 * ((lane >> 4) & 1) + (lane & 3);
#pragma unroll
            for (int t = 0; t < 16; ++t) {
                float trw[16], tew[16];
#pragma unroll
                for (int q4 = 0; q4 < 4; ++q4) { const f32x4 x = *(const LAS f32x4*)(Tt + t * 16 + 4 * q4), y = *(const LAS f32x4*)(TEt + t * 16 + 4 * q4);
                    trw[4 * q4] = x[0]; trw[4 * q4 + 1] = x[1]; trw[4 * q4 + 2] = x[2]; trw[4 * q4 + 3] = x[3]; tew[4 * q4] = y[0]; tew[4 * q4 + 1] = y[1]; tew[4 * q4 + 2] = y[2]; tew[4 * q4 + 3] = y[3]; }
                float w1 = 0.f, q1 = (t & 1) ? __uint_as_float(tR[t >> 1] & 0xffff0000u) : __uint_as_float(tR[t >> 1] << 16), mtv = 0.f, q2v = mats[768 + t * 16 + n];
#pragma unroll
                for (int s2 = 0; s2 <= t; ++s2) { const float as = (s2 & 1) ? __uint_as_float(tA[s2 >> 1] & 0xffff0000u) : __uint_as_float(tA[s2 >> 1] << 16);
                    w1 += as * trw[s2]; q1 += as * tew[s2]; mtv += Mr[s2] * trw[s2]; q2v += Mr[s2] * tew[s2]; }
                const int wi = ((wks * 16 + t) * 4 + wq) * 8 + we;
                WAg[wi] = f2bf(w1); QAg[wi] = f2bf(q1);
                if (lane < 16) { MTg[t * 16 + lane] = f2bf(mtv); Q2g[t * 16 + lane] = f2bf(q2v); }
                asm volatile("" ::: "memory");
            }
            {
                u32x4* BKg = (u32x4*)(CBg + CB_BK + lane * 64);
#pragma unroll
                for (int g4 = 0; g4 < 4; ++g4) {
                    const float b0 = __uint_as_float(tB[2 * g4] << 16) * PCv, b1 = __uint_as_float(tB[2 * g4] & 0xffff0000u) * PCv, b2 = __uint_as_float(tB[2 * g4 + 1] << 16) * PCv, b3 = __uint_as_float(tB[2 * g4 + 1] & 0xffff0000u) * PCv;
                    const float k0 = __uint_as_float(tK[2 * g4] << 16) * PCv, k1 = __uint_as_float(tK[2 * g4] & 0xffff0000u) * PCv, k2 = __uint_as_float(tK[2 * g4 + 1] << 16) * PCv, k3 = __uint_as_float(tK[2 * g4 + 1] & 0xffff0000u) * PCv;
                    u32x4 w; w.x = cvt_pk_bf16(b0, b1); w.y = cvt_pk_bf16(b2, b3); w.z = cvt_pk_bf16(k0, k1); w.w = cvt_pk_bf16(k2, k3);
                    BKg[g4] = w;
                }
                ((float*)(CBg + CB_PC))[lane] = PCv;
                u32x4* VTg = (u32x4*)(CBg + CB_VT + lane * 32);
                VTg[0] = (u32x4){tV[0], tV[1], tV[2], tV[3]}; VTg[1] = (u32x4){tV[4], tV[5], tV[6], tV[7]};
            }
        }
        __syncthreads();
    }
}

constexpr int SC_GRP = 2, SC_STG = SC_GRP * CB_BYTES;
constexpr int SC_YB = SC_GRP * 16 * 64;
struct ScanPostConst { f32x4 gain0, gain1, bias0, bias1; };
struct ScanPostIn { u32x4 bw, gw; };
__device__ __forceinline__ ScanPostIn scan_post_load(const bf16_t* Bvp, const bf16_t* Gp, size_t tok0, int tl0, int lane) {
    const int tl = tl0 + (lane >> 3), q = lane & 7; const size_t tok = tok0 + tl; ScanPostIn r;
    r.bw = *(const u32x4*)(Bvp + tok * BW + q * 8); r.gw = *(const u32x4*)(Gp + tok * BW + q * 8);
    return r;
}
__device__ __forceinline__ f32x4 bf4_lo(const u32x4& w) { return (f32x4){__uint_as_float(w.x << 16), __uint_as_float(w.x & 0xffff0000u), __uint_as_float(w.y << 16), __uint_as_float(w.y & 0xffff0000u)}; }
__device__ __forceinline__ f32x4 bf4_hi(const u32x4& w) { return (f32x4){__uint_as_float(w.z << 16), __uint_as_float(w.z & 0xffff0000u), __uint_as_float(w.w << 16), __uint_as_float(w.w & 0xffff0000u)}; }
__device__ __forceinline__ void scan_post(LAS float* yb, const ScanPostIn& I, bf16_t* Yp, size_t tok0, int tl0, int lane, const ScanPostConst& K) {
    const int tl = tl0 + (lane >> 3), q = lane & 7; const size_t tok = tok0 + tl;
    const f32x4 y0 = *(const LAS f32x4*)(yb + tl * 64 + q * 8), y1 = *(const LAS f32x4*)(yb + tl * 64 + q * 8 + 4);
    const f32x4 ys = y0 + y1;
    const float mean = red8((ys[0] + ys[1]) + (ys[2] + ys[3])) * (1.0f / 64.0f);
    const f32x4 d0 = y0 - mean, d1 = y1 - mean;
    const f32x4 dq = d0 * d0 + d1 * d1;
    const float var = red8((dq[0] + dq[1]) + (dq[2] + dq[3])) * (1.0f / 64.0f);
    const float rstd = __builtin_amdgcn_rsqf(var + 64e-5f);
    const f32x4 o0 = (d0 * rstd * K.gain0 + K.bias0 + bf4_lo(I.bw)) * bf4_lo(I.gw), o1 = (d1 * rstd * K.gain1 + K.bias1 + bf4_hi(I.bw)) * bf4_hi(I.gw);
    u32x4 w; w.x = cvt_pk_bf16(o0[0], o0[1]); w.y = cvt_pk_bf16(o0[2], o0[3]); w.z = cvt_pk_bf16(o1[0], o1[1]); w.w = cvt_pk_bf16(o1[2], o1[3]);
    *(u32x4*)(Yp + tok * DM + q * 8) = w;
}
__device__ __forceinline__ void scan_unit(const Ctx& C, int l, int bh) {
    const int tid = opaque_tid(), lane = tid & 63, wv = __builtin_amdgcn_readfirstlane(tid >> 6);
    LAS unsigned char* stg = C.lds;
    LAS float* ybuf = (LAS float*)(C.lds + 2 * SC_STG);
    const unsigned char* src = C.ws + WS_SCAN + (size_t)bh * (SEQ / 16) * CB_BYTES;
    const int b = bh >> 3, h = bh & 7;
    constexpr int NGRP = SEQ / 16 / SC_GRP;
    for (int i = tid; i < SC_STG / 16; i += NTHREADS) *(LAS u32x4*)(stg + i * 16) = *(const u32x4*)(src + (size_t)i * 16);
    __syncthreads();
    if (wv < 4) {
        const int vq = lane & 15, q = lane >> 4;
        f32x4 S[4];
#pragma unroll
        for (int m = 0; m < 4; ++m) S[m] = (f32x4){0.f, 0.f, 0.f, 0.f};
        const bf16x8 zf = {0, 0, 0, 0, 0, 0, 0, 0};
#pragma nounroll
        for (int g = 0; g < NGRP; ++g) {
            LAS unsigned char* sb = stg + (g & 1) * SC_STG;
            LAS float* yb = ybuf + (g & 1) * SC_YB;
#pragma unroll
            for (int cc = 0; cc < SC_GRP; ++cc) {
                LAS unsigned char* cb = sb + cc * CB_BYTES;
                const bf16x8 wa0 = *(const LAS bf16x8*)(cb + CB_WA + ((0 * 16 + vq) * 4 + q) * 16), wa1 = *(const LAS bf16x8*)(cb + CB_WA + ((1 * 16 + vq) * 4 + q) * 16);
                const bf16x8 qa0 = *(const LAS bf16x8*)(cb + CB_QA + ((0 * 16 + vq) * 4 + q) * 16), qa1 = *(const LAS bf16x8*)(cb + CB_QA + ((1 * 16 + vq) * 4 + q) * 16);
                const int qc = q & 1;
                bf16x8 mtf = *(const LAS bf16x8*)(cb + CB_MT + vq * 32 + qc * 16), q2f = *(const LAS bf16x8*)(cb + CB_Q2 + vq * 32 + qc * 16);
                bf16x8 bvf = *(const LAS bf16x8*)(cb + CB_VT + (16 * wv + vq) * 32 + qc * 16);
                if (q >= 2) { mtf = zf; q2f = zf; bvf = zf; }
                const u32x2 vpart = *(const LAS u32x2*)(cb + CB_VT + (16 * wv + vq) * 32 + q * 8);
                bf16x8 bk[4]; f32x4 pc[4];
#pragma unroll
                for (int m = 0; m < 4; ++m) { bk[m] = *(const LAS bf16x8*)(cb + CB_BK + ((16 * m + vq) * 4 + q) * 16); pc[m] = *(const LAS f32x4*)(cb + CB_PC + (16 * m + 4 * q) * 4); }
                bf16x8 bh[2], bl[2];
#pragma unroll
                for (int ks = 0; ks < 2; ++ks) {
                    const f32x4 s0 = S[2 * ks], s1 = S[2 * ks + 1];
                    u32x4 hp; hp.x = cvt_pk_bf16(s0[0], s0[1]); hp.y = cvt_pk_bf16(s0[2], s0[3]); hp.z = cvt_pk_bf16(s1[0], s1[1]); hp.w = cvt_pk_bf16(s1[2], s1[3]);
                    const float l0 = s0[0] - __uint_as_float(hp.x << 16), l1 = s0[1] - __uint_as_float(hp.x & 0xffff0000u), l2 = s0[2] - __uint_as_float(hp.y << 16), l3 = s0[3] - __uint_as_float(hp.y & 0xffff0000u);
                    const float l4 = s1[0] - __uint_as_float(hp.z << 16), l5 = s1[1] - __uint_as_float(hp.z & 0xffff0000u), l6 = s1[2] - __uint_as_float(hp.w << 16), l7 = s1[3] - __uint_as_float(hp.w & 0xffff0000u);
                    u32x4 lp; lp.x = cvt_pk_bf16(l0, l1); lp.y = cvt_pk_bf16(l2, l3); lp.z = cvt_pk_bf16(l4, l5); lp.w = cvt_pk_bf16(l6, l7);
                    bh[ks] = __builtin_bit_cast(bf16x8, hp); bl[ks] = __builtin_bit_cast(bf16x8, lp);
                }
                const f32x4 z = {0.f, 0.f, 0.f, 0.f};
                f32x4 U = __builtin_amdgcn_mfma_f32_16x16x32_bf16(mtf, bvf, z, 0, 0, 0);
                U = __builtin_amdgcn_mfma_f32_16x16x32_bf16(wa0, bl[0], U, 0, 0, 0); U = __builtin_amdgcn_mfma_f32_16x16x32_bf16(wa1, bl[1], U, 0, 0, 0);
                U = __builtin_amdgcn_mfma_f32_16x16x32_bf16(wa0, bh[0], U, 0, 0, 0); U = __builtin_amdgcn_mfma_f32_16x16x32_bf16(wa1, bh[1], U, 0, 0, 0);
                f32x4 Yt = __builtin_amdgcn_mfma_f32_16x16x32_bf16(q2f, bvf, z, 0, 0, 0);
                Yt = __builtin_amdgcn_mfma_f32_16x16x32_bf16(qa0, bl[0], Yt, 0, 0, 0); Yt = __builtin_amdgcn_mfma_f32_16x16x32_bf16(qa1, bl[1], Yt, 0, 0, 0);
                Yt = __builtin_amdgcn_mfma_f32_16x16x32_bf16(qa0, bh[0], Yt, 0, 0, 0); Yt = __builtin_amdgcn_mfma_f32_16x16x32_bf16(qa1, bh[1], Yt, 0, 0, 0);
                u32x4 up; up.x = cvt_pk_bf16(U[0], U[1]); up.y = cvt_pk_bf16(U[2], U[3]); up.z = vpart.x; up.w = vpart.y;
                const bf16x8 bu = __builtin_bit_cast(bf16x8, up);
#pragma unroll
                for (int m = 0; m < 4; ++m) S[m] = __builtin_amdgcn_mfma_f32_16x16x32_bf16(bk[m], bu, S[m] * pc[m], 0, 0, 0);
#pragma unroll
                for (int j = 0; j < 4; ++j) yb[(cc * 16 + 4 * q + j) * 64 + 16 * wv + vq] = Yt[j];
            }
            __syncthreads();
        }
    } else {
        const int hw = wv - 4, ht = tid - 256;
        ScanPostConst PC;
        { const int o = l * BW + h * 64 + (lane & 7) * 8;
          PC.gain0 = *(const f32x4*)(C.fin(22) + o); PC.gain1 = *(const f32x4*)(C.fin(22) + o + 4); PC.bias0 = *(const f32x4*)(C.fin(23) + o); PC.bias1 = *(const f32x4*)(C.fin(23) + o + 4); }
        const bf16_t* Gp = C.at<bf16_t>(WS_G) + (size_t)b * SEQ * BW + h * 64;
        const bf16_t* Bvp = C.at<bf16_t>(WS_BV) + (size_t)b * SEQ * BW + h * 64;
        bf16_t* Yp = C.at<bf16_t>(WS_Y) + (size_t)b * SEQ * DM + 1024 + h * 64;
        constexpr int NL = (SC_STG / 16 + 255) / 256;
        u32x4 tmp[4][NL]; ScanPostIn pin[4];
#define SCH_LOAD(gg, set) do { if ((gg) < NGRP) { const unsigned char* s2_ = src + (size_t)(gg) * SC_STG; \
            _Pragma("unroll") for (int i = 0; i < NL; ++i) { const int o_ = (ht + 256 * i) * 16; if (o_ < SC_STG) tmp[set][i] = *(const u32x4*)(s2_ + o_); } } } while (0)
#define SCH_STORE(gg, set) do { if ((gg) < NGRP) { LAS unsigned char* d2_ = stg + ((gg) & 1) * SC_STG; \
            _Pragma("unroll") for (int i = 0; i < NL; ++i) { const int o_ = (ht + 256 * i) * 16; if (o_ < SC_STG) *(LAS u32x4*)(d2_ + o_) = tmp[set][i]; } } } while (0)
#define SCH_PLOAD(gg, set) do { if ((gg) < NGRP) pin[set] = scan_post_load(Bvp, Gp, (size_t)(gg) * (SC_GRP * 16), hw * 8, lane); } while (0)
#define SCH_POST(gg, set) do { if ((gg) >= 0) scan_post(ybuf + ((gg) & 1) * SC_YB, pin[set], Yp, (size_t)(gg) * (SC_GRP * 16), hw * 8, lane, PC); } while (0)
#define SCH_ITER(g_, k) do { SCH_STORE((g_) + 1, ((k) + 1) & 3); SCH_LOAD((g_) + 4, (k)); SCH_PLOAD((g_) + 2, ((k) + 2) & 3); SCH_POST((g_) - 1, ((k) + 3) & 3); __syncthreads(); } while (0)
        SCH_LOAD(1, 1); SCH_LOAD(2, 2); SCH_LOAD(3, 3); SCH_PLOAD(0, 0); SCH_PLOAD(1, 1);
#pragma nounroll
        for (int g = 0; g < NGRP; g += 4) { SCH_ITER(g, 0); SCH_ITER(g + 1, 1); SCH_ITER(g + 2, 2); SCH_ITER(g + 3, 3); }
        SCH_POST(NGRP - 1, (NGRP - 1) & 3);
#undef SCH_LOAD
#undef SCH_STORE
#undef SCH_PLOAD
#undef SCH_POST
#undef SCH_ITER
    }
    __syncthreads();
}

constexpr int KSTR = 400, VSTR = 320;
constexpr int KBUF = 64 * KSTR, VBUF = 64 * VSTR;
constexpr int ASTG = KBUF + VBUF;
struct AttnDma { unsigned off[6]; unsigned strd[6]; };
__device__ __forceinline__ void attn_dma_init(AttnDma& D, size_t tk, int h, int w, int lane) {
#pragma unroll
    for (int i = 0; i < 6; ++i) {
        const int wi = w + 8 * i, ci = wi * 64 + lane; size_t off; unsigned st = 64u * NKV * 2u;
        if (ci < 1600) { const int r = ci / 25, ch = ci - r * 25;
            if (ch < 16) off = ((tk + r) * NKV + h * 256 + ch * 8) * 2;
            else if (ch < 24) { off = (size_t)MTOK * NKV * 2 + ((tk + r) * 64 + (ch - 16) * 8) * 2; st = 64u * 64u * 2u; }
            else off = ((tk + r) * NKV + h * 256) * 2; }
        else { const int cv = ci - 1600, r = cv / 20, ch = cv - r * 20;
            off = ((tk + r) * NKV + h * 256 + 128 + (ch < 16 ? ch : 0) * 8) * 2; }
        D.off[i] = (unsigned)off; D.strd[i] = st;
    }
}
__device__ __forceinline__ void attn_dma_issue(LAS unsigned char* lds, const bf16_t* KV, AttnDma& D, int stg, int w) {
    const char* kvb = (const char*)KV;
#pragma unroll
    for (int i = 0; i < 6; ++i) {
        const int wi = w + 8 * i;
        if (wi < 45) __builtin_amdgcn_global_load_lds((const unsigned*)(kvb + D.off[i]), (LAS unsigned*)(lds + stg * ASTG + wi * 1024), 16, 0, 0);
        D.off[i] += D.strd[i];
    }
}
template <int CUR>
__device__ __forceinline__ void attn_tile(LAS unsigned char* lds, const bf16_t* KV, AttnDma& dma, int j, int ntiles, int mytiles, int w, int hh, int qi, int kaddr, int vaddr,
                                          const bf16x8 (&qf)[12], f32x16 (&o)[4], float& mrun, float& lrun) {
    if (j + 1 < ntiles) attn_dma_issue(lds, KV, dma, CUR ^ 1, w);
    if (j < mytiles) {
        f32x16 sc[2];
#pragma unroll
        for (int kb = 0; kb < 2; ++kb) {
#pragma unroll
            for (int i = 0; i < 16; ++i) sc[kb][i] = 0.f;
#pragma unroll
            for (int s = 0; s < 12; ++s) {
                const bf16x8 a = *(const LAS bf16x8*)(lds + CUR * ASTG + kaddr + kb * 32 * KSTR + s * 32);
                sc[kb] = __builtin_amdgcn_mfma_f32_32x32x16_bf16(a, qf[s], sc[kb], 0, 0, 0);
            }
        }
        if (j == mytiles - 1) {
#pragma unroll
            for (int kb = 0; kb < 2; ++kb)
#pragma unroll
                for (int i = 0; i < 16; ++i) { const int key = j * 64 + kb * 32 + (i & 3) + 8 * (i >> 2) + 4 * hh; if (key > qi) sc[kb][i] = -INFINITY; }
        }
        float mx = sc[0][0];
#pragma unroll
        for (int kb = 0; kb < 2; ++kb)
#pragma unroll
            for (int i = 0; i < 16; ++i) mx = fmaxf(mx, sc[kb][i]);
        mx = fmaxf(mx, __shfl_xor(mx, 32));
        const bool bump = mx > mrun + 8.0f;
        const float mnew = bump ? mx : mrun;
        if (__builtin_amdgcn_ballot_w64(bump) != 0ull) {
            const float alpha = __builtin_amdgcn_exp2f(mrun - mnew);
            lrun *= alpha;
#pragma unroll
            for (int d = 0; d < 4; ++d)
#pragma unroll
                for (int i = 0; i < 16; ++i) o[d][i] *= alpha;
        }
        mrun = mnew;
        f32x2 ps2 = {0.f, 0.f}; const f32x2 mn2 = {mnew, mnew};
#pragma unroll
        for (int kb = 0; kb < 2; ++kb)
#pragma unroll
            for (int i = 0; i < 16; i += 2) { const f32x2 dlt = (f32x2){sc[kb][i], sc[kb][i + 1]} - mn2; f32x2 p; p.x = __builtin_amdgcn_exp2f(dlt.x); p.y = __builtin_amdgcn_exp2f(dlt.y); sc[kb][i] = p.x; sc[kb][i + 1] = p.y; ps2 += p; }
        lrun += ps2.x + ps2.y;
        bf16x8 pfr[4];
#pragma unroll
        for (int g = 0; g < 4; ++g) { const int kb = g >> 1, s2 = g & 1;
            u32x4 pk; pk.x = cvt_pk_bf16(sc[kb][8 * s2 + 0], sc[kb][8 * s2 + 1]); pk.y = cvt_pk_bf16(sc[kb][8 * s2 + 2], sc[kb][8 * s2 + 3]);
            pk.z = cvt_pk_bf16(sc[kb][8 * s2 + 4], sc[kb][8 * s2 + 5]); pk.w = cvt_pk_bf16(sc[kb][8 * s2 + 6], sc[kb][8 * s2 + 7]);
            pfr[g] = __builtin_bit_cast(bf16x8, pk); }
        const unsigned vb = (unsigned)(size_t)(lds + CUR * ASTG) + (unsigned)vaddr;
        s16x4 RA[8], RB[8];
#define ATT_TR8(R, G) asm volatile("ds_read_b64_tr_b16 %0, %8 offset:%9\n\tds_read_b64_tr_b16 %1, %8 offset:%10\n\tds_read_b64_tr_b16 %2, %8 offset:%11\n\tds_read_b64_tr_b16 %3, %8 offset:%12\n\t" \
                                   "ds_read_b64_tr_b16 %4, %8 offset:%13\n\tds_read_b64_tr_b16 %5, %8 offset:%14\n\tds_read_b64_tr_b16 %6, %8 offset:%15\n\tds_read_b64_tr_b16 %7, %8 offset:%16" \
            : "=&v"(R[0]), "=&v"(R[1]), "=&v"(R[2]), "=&v"(R[3]), "=&v"(R[4]), "=&v"(R[5]), "=&v"(R[6]), "=&v"(R[7]) \
            : "v"(vb), "n"((G) * 16 * VSTR), "n"((G) * 16 * VSTR + 8 * VSTR), "n"((G) * 16 * VSTR + 64), "n"((G) * 16 * VSTR + 64 + 8 * VSTR), \
              "n"((G) * 16 * VSTR + 128), "n"((G) * 16 * VSTR + 128 + 8 * VSTR), "n"((G) * 16 * VSTR + 192), "n"((G) * 16 * VSTR + 192 + 8 * VSTR))
#define ATT_TRWAIT(R, N) asm volatile("s_waitcnt lgkmcnt(" #N ")" : "+v"(R[0]), "+v"(R[1]), "+v"(R[2]), "+v"(R[3]), "+v"(R[4]), "+v"(R[5]), "+v"(R[6]), "+v"(R[7]))
#define ATT_PV(R, G) do { _Pragma("unroll") for (int d = 0; d < 4; ++d) { const bf16x8 vf = __builtin_shufflevector(R[2 * d], R[2 * d + 1], 0, 1, 2, 3, 4, 5, 6, 7); \
            o[d] = __builtin_amdgcn_mfma_f32_32x32x16_bf16(vf, pfr[G], o[d], 0, 0, 0); } } while (0)
        ATT_TR8(RA, 0);
        ATT_TR8(RB, 1); ATT_TRWAIT(RA, 8); ATT_PV(RA, 0);
        ATT_TR8(RA, 2); ATT_TRWAIT(RB, 8); ATT_PV(RB, 1);
        ATT_TR8(RB, 3); ATT_TRWAIT(RA, 8); ATT_PV(RA, 2);
        ATT_TRWAIT(RB, 0); ATT_PV(RB, 3);
#undef ATT_TR8
#undef ATT_TRWAIT
#undef ATT_PV
    }
    asm volatile("s_waitcnt vmcnt(0)" ::: "memory");
    __builtin_amdgcn_s_barrier();
}
__device__ __forceinline__ void attn_unit(const Ctx& C, int l, int b, int h, int qb) {
    const int tid = opaque_tid(), lane = tid & 63, w = __builtin_amdgcn_readfirstlane(tid >> 6), ql = lane & 31, hh = lane >> 5;
    LAS unsigned char* lds = C.lds;
    const int q0 = qb * 256;
    const size_t tok0 = (size_t)b * SEQ;
    const bf16_t* KV = C.at<bf16_t>(WS_KV);
    static_assert(WS_KR == WS_KV + (size_t)MTOK * NKV * 2, "kr must follow kv");
    static_assert((size_t)MTOK * NKV * 2 + (size_t)MTOK * 64 * 2 < 0xffffffffull, "32-bit DMA offsets");
    AttnDma dma; attn_dma_init(dma, tok0, h, w, lane);
    attn_dma_issue(lds, KV, dma, 0, w);
    bf16x8 qf[12];
    {
        const bf16_t* qp = C.at<bf16_t>(WS_Q) + (tok0 + q0 + w * 32 + ql) * NQ + h * QKD + hh * 8;
#pragma unroll
        for (int s = 0; s < 12; ++s) qf[s] = *(const bf16x8*)(qp + 16 * s);
    }
    f32x16 o[4];
#pragma unroll
    for (int d = 0; d < 4; ++d)
#pragma unroll
        for (int i = 0; i < 16; ++i) o[d][i] = 0.f;
    float mrun = -1e30f, lrun = 0.f;
    const int ntiles = 4 * qb + 4, mytiles = 4 * qb + (w >> 1) + 1;
    asm volatile("s_waitcnt vmcnt(0)" ::: "memory");
    __syncthreads();
    const int qi = q0 + w * 32 + ql;
    const int kaddr = ql * KSTR + hh * 16;
    const int vaddr = KBUF + (4 * hh + ((lane & 15) >> 2)) * VSTR + (16 * ((lane >> 4) & 1) + 4 * (lane & 3)) * 2;
#pragma nounroll
    for (int j = 0; j < ntiles; j += 2) {
        attn_tile<0>(lds, KV, dma, j, ntiles, mytiles, w, hh, qi, kaddr, vaddr, qf, o, mrun, lrun);
        attn_tile<1>(lds, KV, dma, j + 1, ntiles, mytiles, w, hh, qi, kaddr, vaddr, qf, o, mrun, lrun);
    }
    __syncthreads();
    const float ltot = lrun + __shfl_xor(lrun, 32);
    const float inv = 1.0f / ltot;
    float ss = 0.f;
#pragma unroll
    for (int d = 0; d < 4; ++d)
#pragma unroll
        for (int i = 0; i < 16; ++i) { o[d][i] *= inv; ss += o[d][i] * o[d][i]; }
    ss += __shfl_xor(ss, 32);
    const float rn = rsqrtf(ss * (1.0f / 128.0f) + RMS_EPS);
    const float* gn = C.fin(12) + l * 1024 + h * 128;
    bf16_t* yp = C.at<bf16_t>(WS_Y) + (tok0 + q0 + w * 32 + ql) * DM + h * 128;
#pragma unroll
    for (int d = 0; d < 4; ++d)
#pragma unroll
        for (int g4 = 0; g4 < 4; ++g4) {
            const int dd = 32 * d + 8 * g4 + 4 * hh;
            const f32x4 gv = *(const f32x4*)(gn + dd);
            u32x2 wv2; wv2.x = cvt_pk_bf16(o[d][4 * g4 + 0] * rn * gv[0], o[d][4 * g4 + 1] * rn * gv[1]); wv2.y = cvt_pk_bf16(o[d][4 * g4 + 2] * rn * gv[2], o[d][4 * g4 + 3] * rn * gv[3]);
            *(u32x2*)(yp + dd) = wv2;
        }
}

__device__ __forceinline__ void phase_final(const Ctx& C) {
    const int tid = opaque_tid(), lane = tid & 63, wv = tid >> 6;
    const float* part = C.at<float>(WS_PARTH); const float* gn = C.fin(31); const bf16_t* hb = C.at<bf16_t>(WS_HB);
    for (int row = C.wg * 8 + wv; row < MTOK; row += C.G * 8) {
        const float rs = rsqrtf(sum_part<32>(part + (size_t)row * 32) * (1.0f / DM) + RMS_EPS);
#pragma unroll
        for (int i = 0; i < 4; ++i) {
            const int col = (i * 64 + lane) * 8; const size_t off = (size_t)row * DM + col;
            const u32x4 w = *(const u32x4*)(hb + off); const f32x4 g0 = *(const f32x4*)(gn + col), g1 = *(const f32x4*)(gn + col + 4);
            const f32x4 v0 = {__uint_as_float(w.x << 16), __uint_as_float(w.x & 0xffff0000u), __uint_as_float(w.y << 16), __uint_as_float(w.y & 0xffff0000u)};
            const f32x4 v1 = {__uint_as_float(w.z << 16), __uint_as_float(w.z & 0xffff0000u), __uint_as_float(w.w << 16), __uint_as_float(w.w & 0xffff0000u)};
            *(f32x4*)(C.out + off) = v0 * rs * g0; *(f32x4*)(C.out + off + 4) = v1 * rs * g1;
        }
    }
}

constexpr int N_PHASES = 2 + 9 * DEPTH;
__global__ void __launch_bounds__(NTHREADS, 2) fwd_kernel(Args args) {
    extern __shared__ __attribute__((aligned(16))) unsigned char lds_raw[];
    Ctx C0; C0.in = args.in; C0.out = args.out; C0.ws = args.ws; C0.lds = (LAS unsigned char*)lds_raw; C0.G = gridDim.x; C0.wg = blockIdx.x;
    volatile LAS unsigned* misc = (volatile LAS unsigned*)(C0.lds + LDS_MISC);
    if (threadIdx.x < 16) misc[threadIdx.x] = 0u;
    __syncthreads();
    const int lo = args.ph_lo, hi = args.ph_hi;
    constexpr bool one_launch = !MK_MULTI;
    XcdBarrier bar; bar.bar = (unsigned*)(C0.ws + WS_CTL); bar.x = 0; bar.st = misc;
    if (hi - lo > 1) bar = xcd_barrier_post((unsigned*)(C0.ws + WS_CTL), misc);
#define IN(k) (lo <= (k) && (k) < hi)
#define SEAM(k) do { if (IN((k) + 1)) { xcd_barrier(bar); if (REP(10)) xcd_barrier(bar); } } while (0)

    if (IN(0)) { if (!SKIP(0)) {
#pragma nounroll
        for (int rep = 0; rep <= REP(12); ++rep) { phase_prologue(C0.fresh()); phase_convert(C0.fresh(), 0, bar); } } SEAM(0); }

    for (int it = 0; it < 3 * DEPTH; ++it) {
        const int l = it / 3, kind = it - 3 * l;
        const int pb = 1 + 9 * l;
        if (kind != 1) {
            const int id = pb + (kind == 0 ? 0 : 6);
            if (IN(id)) {
                const Ctx C = C0.fresh();
                pg8::Gemm g{C.at<bf16_t>(WS_H8), C.at<bf16_t>(kind == 0 ? WS_W1GU : WS_W2GU), MTOK, 2 * DFF, DM / 2, DM / 2, 0};
                pg8::StaticOrder S; S.init(MTOK, 2 * DFF, C.G, C.wg, MK_WGM_GU);
                EpiGU E{C.at<bf16_t>(WS_ACT), C.at<float>(WS_PARTH), C.at<float>(WS_RSA), C.at<float>(WS_CTL + CW_WMAX) + l * 2 + (kind == 0 ? 0 : 1), C.at<unsigned>(kind == 0 ? WS_AMAX : WS_AMAX2)};
#pragma nounroll
                for (int rep = 0; rep <= REP(1); ++rep)
                if (!SKIP(1)) pg8::gemm_phase<EpiGU, REP(8)>(C.lds, g, S, E, E);
                xcd_barrier(bar); actq_pass(C0.fresh(), kind == 0 ? WS_AMAX : WS_AMAX2, kind == 0 ? WS_AMAX2 : WS_AMAX, C0.at<float>(WS_CTL + CW_WMAX) + l * 2 + (kind == 0 ? 0 : 1));
                SEAM(id);
            }
        }
        {
            const int id = pb + (kind == 0 ? 1 : (kind == 1 ? 5 : 7));
            if (IN(id)) {
                const Ctx C = C0.fresh();
                pg8::StaticOrder S; S.init(MTOK, DM, C.G, C.wg, MK_WGM_RES);
                const float* basef = (it == 0) ? C.fin(0) : nullptr;
                if (kind == 1) {
                    pg8::Gemm g{C.at<bf16_t>(WS_Y), C.at<bf16_t>(WS_WOUT), MTOK, DM, DM, DM, 0};
                    EpiResT<false> E{basef, C.at<bf16_t>(WS_HB), C.at<float>(WS_PARTH), 1.0f, nullptr, nullptr};
                    if (!SKIP(2)) pg8::gemm_phase<EpiResT<false>>(C.lds, g, S, E, E);
                } else {
                    pg8::Gemm g{C.at<bf16_t>(WS_ACT8), C.at<bf16_t>(kind == 0 ? WS_W1D : WS_W2D), MTOK, DM, DFF / 2, 64, 1};
                    EpiResT<true> E{basef, C.at<bf16_t>(WS_HB), C.at<float>(WS_PARTH), 0.5f, C.at<float>(WS_ASC), C.at<float>(WS_CTL + CW_WMAX) + 8 + l * 2 + (kind == 0 ? 0 : 1)};
#pragma nounroll
                    for (int rep = 0; rep <= REP(2); ++rep)
                    if (!SKIP(2)) pg8::gemm_phase<EpiResT<true>>(C.lds, g, S, E, E);
                }
                if (one_launch && kind != 2) { xcd_barrier(bar); if (kind == 0) rstd_pass(C0.fresh()); else quant_pass(C0.fresh()); }
                SEAM(id);
            }
        }
        if (kind == 0) {
            if (IN(pb + 2)) {
                const Ctx C = C0.fresh();
                pg8::Gemm g{C.at<bf16_t>(WS_HB), C.at<bf16_t>(WS_WIN), MTOK, NINP, DM, DM, 0};
                pg8::StaticOrder S; S.init(MTOK, NINP, C.G, C.wg, MK_WGM_WIN);
                EpiScale<0> E{C.at<bf16_t>(WS_P), NINP, C.at<float>(WS_PARTH), 1.0f / DM, 1.0f, C.at<float>(WS_PARTQ), C.at<float>(WS_PARTKV), nullptr, nullptr, one_launch ? C.at<float>(WS_RSTD) : nullptr};
#pragma nounroll
                for (int rep = 0; rep <= REP(3); ++rep)
                if (!SKIP(3)) pg8::gemm_phase<EpiScale<0>>(C.lds, g, S, E, E);
                SEAM(pb + 2);
            }
            if (IN(pb + 3)) {
                {
                    const Ctx C = C0.fresh();
                    pg8::Gemm g{C.at<bf16_t>(WS_P), C.at<bf16_t>(WS_WUQ), MTOK, NQ, QL, NINP, 0};
                    pg8::StaticOrder S; S.init(MTOK, NQ, C.G, C.wg);
                    EpiScale<2> E{C.at<bf16_t>(WS_Q), NQ, C.at<float>(WS_PARTQ), 1.0f / QL, 0.07216878364870322f * 1.4426950408889634f, nullptr, nullptr, C.at<float>(WS_ROPEC), C.at<float>(WS_ROPES), nullptr};
#pragma nounroll
                    for (int rep = 0; rep <= REP(4); ++rep)
                    if (!SKIP(4)) pg8::gemm_phase<EpiScale<2>>(C.lds, g, S, E, E);
                }
                {
                    const Ctx C = C0.fresh();
                    pg8::Gemm g{C.at<bf16_t>(WS_P) + QL, C.at<bf16_t>(WS_WUKV), MTOK, NKV, KVL, NINP, 0};
                    pg8::StaticOrder S; S.init(MTOK, NKV, C.G, C.wg);
                    EpiScale<1> E{C.at<bf16_t>(WS_KV), NKV, C.at<float>(WS_PARTKV), 1.0f / KVL, 1.0f, nullptr, nullptr, nullptr, nullptr, nullptr};
#pragma nounroll
                    for (int rep = 0; rep <= REP(4); ++rep)
                    if (!SKIP(5)) pg8::gemm_phase<EpiScale<1>>(C.lds, g, S, E, E);
                }
#pragma nounroll
                for (int rep = 0; rep <= REP(5); ++rep)
                if (!SKIP(6)) prep_phase(C0.fresh(), l);
                SEAM(pb + 3);
            }
            if (IN(pb + 4)) {
                unsigned* qctr = (unsigned*)(C0.fresh().ws + WS_CTL + CW_QUEUE) + 64 * l;
                if (REP(6)) { if ((int)C0.wg < 128) scan_unit(C0.fresh(), l, C0.wg); xcd_barrier(bar); }
                if (REP(7)) { for (int pi = C0.wg; pi < 1024; pi += C0.G) { const int bh = pi & 127, qb = (pi >> 7) & 1 ? (pi >> 8) : 7 - (pi >> 8); attn_unit(C0.fresh(), l, bh >> 3, bh & 7, qb); } xcd_barrier(bar); }
#pragma nounroll
                for (int rep = 0; rep <= REP(11); ++rep, qctr += 256)
                for (;;) {
                    if (threadIdx.x == 0) misc[4] = xb_add(qctr, 1u);
                    __syncthreads();
                    const int item = (int)misc[4];
                    __syncthreads();
                    if (item >= 128 + 1024) break;
                    if (item < 128) { if (!SKIP(7)) scan_unit(C0.fresh(), l, item); }
                    else { const int idx = item - 128, bh = idx & 127, qb = 7 - (idx >> 7);
                        if (!SKIP(8)) attn_unit(C0.fresh(), l, bh >> 3, bh & 7, qb); }
                }
                SEAM(pb + 4);
            }
        }
        if (kind == 2) {
            if (IN(pb + 8)) { if (l + 1 < DEPTH && !SKIP(9)) { phase_convert(C0.fresh(), l + 1, bar); if (REP(0)) phase_convert(C0.fresh(), l + 1, bar); quant_pass(C0.fresh()); } SEAM(pb + 8); }
        }
    }
    if (IN(N_PHASES - 1) && !SKIP(10)) {
#pragma nounroll
        for (int rep = 0; rep <= REP(12); ++rep) phase_final(C0.fresh()); }
#undef IN
#undef SEAM
}

extern "C" void kernel_launch(void* const* d_in, const int* in_sizes, int n_in, void* d_out, int out_size, void* d_ws, size_t ws_size, hipStream_t stream) {
    static int grid = 0;
    if (grid == 0) {
        if (n_in != 32 || out_size != MTOK * DM || ws_size < WS_END) { fprintf(stderr, "kernel_launch: unexpected shapes (n_in %d, out %d, ws %zu, need %zu)\n", n_in, out_size, ws_size, (size_t)WS_END); grid = -1; return; }
        int dev = 0, cus = 0, per_cu = 0;
        if (hipGetDevice(&dev) != hipSuccess || hipDeviceGetAttribute(&cus, hipDeviceAttributeMultiprocessorCount, dev) != hipSuccess) { grid = -1; return; }
        if (hipFuncSetAttribute((const void*)fwd_kernel, hipFuncAttributeMaxDynamicSharedMemorySize, LDS_BYTES) != hipSuccess) { fprintf(stderr, "kernel_launch: hipFuncSetAttribute failed\n"); grid = -1; return; }
        if (hipOccupancyMaxActiveBlocksPerMultiprocessor(&per_cu, (const void*)fwd_kernel, NTHREADS, LDS_BYTES) != hipSuccess || per_cu < 1) { fprintf(stderr, "kernel_launch: occupancy query says %d\n", per_cu); }
        (void)hipGetLastError();
        grid = cus;
    }
    if (grid < 0) return;
    (void)hipMemsetAsync((char*)d_ws + WS_CTL, 0, ZERO_BYTES, stream);
    Args a{};
    for (int i = 0; i < 32; ++i) a.in[i] = d_in[i];
    a.out = (float*)d_out; a.ws = (unsigned char*)d_ws;
#if MK_MULTI
    for (int p = 0; p < N_PHASES; ++p) { a.ph_lo = p; a.ph_hi = p + 1; hipLaunchKernelGGL(fwd_kernel, dim3(grid), dim3(NTHREADS), LDS_BYTES, stream, a); }
#else
    a.ph_lo = 0; a.ph_hi = N_PHASES;
    hipLaunchKernelGGL(fwd_kernel, dim3(grid), dim3(NTHREADS), LDS_BYTES, stream, a);
#endif
}
```

```cpp
#include <hip/hip_runtime.h>
#include <stdint.h>
#include <stdio.h>

#ifndef MK_MULTI
#define MK_MULTI 0
#endif

#ifndef MK_SKIP
#define MK_SKIP 0
#endif
#define SKIP(b) ((MK_SKIP >> (b)) & 1)
#ifndef MK_WGM_RES
#define MK_WGM_RES 4
#endif
#ifndef MK_WGM_GU
#define MK_WGM_GU 8
#endif
#ifndef MK_WGM_WIN
#define MK_WGM_WIN 4
#endif
#ifndef MK_REP
#define MK_REP 0
#endif
#define REP(b) ((MK_REP >> (b)) & 1)
#define LAS __attribute__((address_space(3)))
typedef unsigned short bf16_t;
typedef short bf16x8 __attribute__((ext_vector_type(8)));
typedef short s16x4 __attribute__((ext_vector_type(4)));
typedef float f32x4 __attribute__((ext_vector_type(4)));
typedef float f32x2 __attribute__((ext_vector_type(2)));
typedef float f32x16 __attribute__((ext_vector_type(16)));
typedef unsigned u32x4 __attribute__((ext_vector_type(4)));
typedef unsigned u32x2 __attribute__((ext_vector_type(2)));
typedef int i32x4 __attribute__((ext_vector_type(4)));
typedef int i32x8 __attribute__((ext_vector_type(8)));

constexpr int BATCH = 16, SEQ = 2048, MTOK = BATCH * SEQ, DM = 2048, DFF = 5632, DEPTH = 4;
constexpr int NIN = 4064, NINP = 4096;
constexpr int QL = 512, KVL = 256, AH = 8, QKD = 192;
constexpr int NQ = AH * QKD;
constexpr int NKV = AH * 256;
constexpr int BW = 512;
constexpr int PB0 = 832, PC0 = 2528;
constexpr float RMS_EPS = 1e-6f;
constexpr int NTHREADS = 512;

constexpr size_t al256(size_t x) { return (x + 255) & ~(size_t)255; }
constexpr int XCD_BAR_WORDS_C = 3456;
constexpr size_t WS_CTL = 0;
constexpr size_t CTL_BYTES = 65536;
constexpr size_t CW_QUEUE = 16384;
constexpr size_t WS_PARTH = WS_CTL + CTL_BYTES;
constexpr size_t WS_PARTQ = WS_PARTH + (size_t)MTOK * 32 * 4;
constexpr size_t WS_PARTKV = WS_PARTQ + (size_t)MTOK * 8 * 4;
constexpr size_t ZERO_BYTES = CTL_BYTES;
constexpr size_t WS_RSTD = WS_PARTKV + (size_t)MTOK * 4 * 4;
constexpr size_t WS_ROPEC = al256(WS_RSTD + (size_t)MTOK * 4);
constexpr size_t WS_ROPES = WS_ROPEC + (size_t)MTOK * 32 * 4;
constexpr size_t WS_W1GU = WS_ROPES + (size_t)MTOK * 32 * 4;
constexpr size_t SZ_WGU = (size_t)2 * DFF * DM * 2;
constexpr size_t SZ_WD = (size_t)DM * DFF * 2;
constexpr size_t WS_W1D = WS_W1GU + SZ_WGU;
constexpr size_t WS_WIN = WS_W1D + SZ_WD;
constexpr size_t WS_WUQ = WS_WIN + (size_t)NINP * DM * 2;
constexpr size_t WS_WUKV = WS_WUQ + (size_t)NQ * QL * 2;
constexpr size_t WS_WOUT = WS_WUKV + (size_t)NKV * KVL * 2;
constexpr size_t WS_W2GU = WS_WOUT + (size_t)DM * DM * 2;
constexpr size_t WS_W2D = WS_W2GU + SZ_WGU;
constexpr size_t WS_LORA = WS_W2D + SZ_WD;
constexpr size_t WS_HB = al256(WS_LORA + (size_t)512 * 160 * 2);
constexpr size_t WS_X = WS_HB + (size_t)MTOK * DM * 2;
constexpr size_t WS_ACT = WS_X;
constexpr size_t WS_P = WS_X;
constexpr size_t WS_Q = WS_P + (size_t)MTOK * NINP * 2;
constexpr size_t WS_KV = WS_Q + (size_t)MTOK * NQ * 2;
constexpr size_t WS_KR = WS_KV + (size_t)MTOK * NKV * 2;
constexpr size_t WS_SCAN = WS_KR + (size_t)MTOK * 64 * 2;
constexpr int CB_BYTES = 11520;
constexpr int CB_WA = 0, CB_QA = 2048, CB_MT = 4096, CB_Q2 = 4608, CB_BK = 5120, CB_PC = 9216, CB_VT = 9472;
constexpr size_t WS_BV = WS_SCAN + (size_t)BATCH * 8 * (SEQ / 16) * CB_BYTES;
constexpr size_t WS_G = WS_SCAN + (size_t)MTOK * 8 * 6 * 64 * 4;
static_assert(WS_BV + (size_t)MTOK * BW * 4 <= WS_G, "scan region");
constexpr size_t WS_Y = WS_G + (size_t)MTOK * BW * 4;
constexpr size_t WS_MIXEND = WS_Y + (size_t)MTOK * DM * 2;
constexpr size_t WS_ACTEND = WS_ACT + (size_t)MTOK * DFF * 2;
constexpr size_t WS_H8 = al256(WS_MIXEND > WS_ACTEND ? WS_MIXEND : WS_ACTEND);
constexpr size_t WS_RSA = WS_H8 + (size_t)MTOK * DM;
constexpr size_t WS_AMAX = WS_RSA + (size_t)MTOK * 4;
constexpr size_t WS_AMAX2 = WS_AMAX + (size_t)MTOK * 4;
constexpr size_t WS_ASC = WS_AMAX2 + (size_t)MTOK * 4;
constexpr size_t WS_END = WS_ASC + (size_t)MTOK * 4;
constexpr size_t WS_ACT8 = WS_ACT + (size_t)MTOK * DFF * 2;
static_assert(WS_ACT8 + (size_t)MTOK * DFF <= WS_MIXEND, "act8 inside the union");
constexpr size_t CW_WMAX = 32768;

constexpr int STAGE_BYTES_C = 131072;
constexpr int LDS_WORK = 8192 + 8 * 16384;
constexpr int LDS_MISC = LDS_WORK;
constexpr int LDS_BYTES = LDS_WORK + 256;

typedef __bf16 bf16x2_t __attribute__((ext_vector_type(2)));
__device__ __forceinline__ unsigned cvt_pk_bf16(float lo, float hi) { const f32x2 f = {lo, hi}; return __builtin_bit_cast(unsigned, __builtin_convertvector(f, bf16x2_t)); }
__device__ __forceinline__ unsigned pk4_i8(float a, float b, float c, float d) {
    const unsigned ua = __float_as_uint(a + 12582912.0f), ub = __float_as_uint(b + 12582912.0f), uc = __float_as_uint(c + 12582912.0f), ud = __float_as_uint(d + 12582912.0f);
    return __builtin_amdgcn_perm(__builtin_amdgcn_perm(ud, uc, 0x0c0c0400u), __builtin_amdgcn_perm(ub, ua, 0x0c0c0400u), 0x05040100u);
}
__device__ __forceinline__ float bf2f(bf16_t b) { return __uint_as_float(((unsigned)b) << 16); }
__device__ __forceinline__ bf16_t f2bf(float f) { return (bf16_t)(cvt_pk_bf16(f, 0.f) & 0xffffu); }
__device__ __forceinline__ int opaque_tid() { int t = threadIdx.x; asm volatile("" : "+v"(t)); return t; }
__device__ __forceinline__ float wave_sum(float v) {
#pragma unroll
    for (int o = 32; o >= 1; o >>= 1) v += __shfl_xor(v, o);
    return v;
}
__device__ __forceinline__ float rdlane(float v, int l) { return __builtin_bit_cast(float, __builtin_amdgcn_readlane(__builtin_bit_cast(int, v), l)); }
template <int CTRL> __device__ __forceinline__ float dpp_mov(float v) { return __builtin_bit_cast(float, __builtin_amdgcn_update_dpp(0, __builtin_bit_cast(int, v), CTRL, 0xf, 0xf, false)); }
__device__ __forceinline__ float red16(float v) { v += dpp_mov<0xB1>(v); v += dpp_mov<0x4E>(v); v += dpp_mov<0x141>(v); v += dpp_mov<0x140>(v); return v; }
__device__ __forceinline__ float xor16_add(float v) { const unsigned b = __builtin_bit_cast(unsigned, v); const u32x2 r = __builtin_amdgcn_permlane16_swap(b, b, false, false); return __uint_as_float(r.x) + __uint_as_float(r.y); }
__device__ __forceinline__ float xor32_add(float v) { const unsigned b = __builtin_bit_cast(unsigned, v); const u32x2 r = __builtin_amdgcn_permlane32_swap(b, b, false, false); return __uint_as_float(r.x) + __uint_as_float(r.y); }
__device__ __forceinline__ float xor16_max(float v) { const unsigned b = __builtin_bit_cast(unsigned, v); const u32x2 r = __builtin_amdgcn_permlane16_swap(b, b, false, false); return fmaxf(__uint_as_float(r.x), __uint_as_float(r.y)); }
__device__ __forceinline__ float xor32_max(float v) { const unsigned b = __builtin_bit_cast(unsigned, v); const u32x2 r = __builtin_amdgcn_permlane32_swap(b, b, false, false); return fmaxf(__uint_as_float(r.x), __uint_as_float(r.y)); }
__device__ __forceinline__ void fwht8(float (&v)[8]) {
#pragma unroll
    for (int h = 1; h < 8; h <<= 1)
#pragma unroll
        for (int i = 0; i < 8; ++i) if (!(i & h)) { const float a = v[i], b = v[i | h]; v[i] = a + b; v[i | h] = a - b; }
}
__device__ __forceinline__ void fwht8_pk(f32x2 (&p)[4]) {
#pragma unroll
    for (int i = 0; i < 4; ++i) { f32x2 d; asm("v_pk_add_f32 %0, %1, %1 op_sel:[0,1] op_sel_hi:[0,1] neg_hi:[0,1]" : "=v"(d) : "v"(p[i])); p[i] = d; }
    { const f32x2 a = p[0] + p[1], b = p[0] - p[1], c = p[2] + p[3], d = p[2] - p[3]; p[0] = a; p[1] = b; p[2] = c; p[3] = d; }
    { const f32x2 a = p[0] + p[2], b = p[1] + p[3], c = p[0] - p[2], d = p[1] - p[3]; p[0] = a; p[1] = b; p[2] = c; p[3] = d; }
}
__device__ __forceinline__ float wave_sum_fast(float v) { return xor32_add(xor16_add(red16(v))); }
__device__ __forceinline__ float sigmoid_fast(float x) { return __builtin_amdgcn_rcpf(1.0f + __builtin_amdgcn_exp2f(-1.4426950408889634f * x)); }
__device__ __forceinline__ float red8(float v) { v += dpp_mov<0xB1>(v); v += dpp_mov<0x4E>(v); v += dpp_mov<0x141>(v); return v; }
template <int N> __device__ __forceinline__ float sum_part(const float* p) {
    f32x4 a = *(const f32x4*)p;
#pragma unroll
    for (int i = 1; i < N / 4; ++i) a += *(const f32x4*)(p + 4 * i);
    return (a[0] + a[1]) + (a[2] + a[3]);
}

#define XB_TMO      128
#define XB_XCNT(j)  (256  + 64 * (j))
#define XB_XSUB(j)  (1280 + 64 * (j))
#define XB_XGEN(j)  (2304 + 64 * (j))
#define XB_TOP      3328
#define XB_TOPGEN   3392
#define XCD_BAR_WORDS 3456
#define XB_SPIN_CAP (1u << 22)
static_assert(XCD_BAR_WORDS == XCD_BAR_WORDS_C && XCD_BAR_WORDS * 4 <= CW_QUEUE, "ctl layout");

__device__ __forceinline__ unsigned xb_ld(unsigned* p)              { return __hip_atomic_load(p, __ATOMIC_RELAXED, __HIP_MEMORY_SCOPE_AGENT); }
__device__ __forceinline__ unsigned xb_add(unsigned* p, unsigned v) { return __hip_atomic_fetch_add(p, v, __ATOMIC_RELAXED, __HIP_MEMORY_SCOPE_AGENT); }
__device__ __forceinline__ unsigned xb_xcc_id() { return (unsigned)__builtin_amdgcn_s_getreg((3 << 11) | 20) & 0xFu; }
#define XB_SPIN(cond, bar) do { unsigned _sp = 0; while (cond) { __builtin_amdgcn_s_sleep(1); \
    if ((++_sp & 255u) == 0u) { if (xb_ld(&(bar)[XB_TMO])) break; if (_sp > XB_SPIN_CAP) { atomicAdd(&(bar)[XB_TMO], 1u); break; } } } } while (0)

struct XcdBarrier { unsigned* bar; unsigned x; volatile LAS unsigned* st; };

__device__ __forceinline__ XcdBarrier xcd_barrier_post(unsigned* bar, volatile LAS unsigned* st) {
    XcdBarrier b; b.bar = bar; b.x = xb_xcc_id(); b.st = st;
    if (threadIdx.x == 0) (void)xb_add(&bar[XB_XCNT(b.x)], 1u);
    return b;
}
__device__ __forceinline__ void xcd_barrier_complete(unsigned* bar, unsigned x, unsigned& nloc, unsigned& nx) {
    const unsigned G = gridDim.x * gridDim.y * gridDim.z;
    unsigned sum, cnt, mine, sp = 0u;
    for (;;) {
        sum = 0u; cnt = 0u; mine = 0u;
#pragma unroll
        for (unsigned j = 0; j < 16; ++j) { const unsigned c = xb_ld(&bar[XB_XCNT(j)]); sum += c; cnt += (c > 0u) ? 1u : 0u; mine = (j == x) ? c : mine; }
        if (sum == G) break;
        __builtin_amdgcn_s_sleep(1);
        if ((++sp & 255u) == 0u) { if (xb_ld(&bar[XB_TMO])) break; if (sp > XB_SPIN_CAP) { atomicAdd(&bar[XB_TMO], 1u); break; } }
    }
    nloc = mine > 0u ? mine : 1u; nx = cnt > 0u ? cnt : 1u;
}
__device__ __forceinline__ void xcd_barrier(const XcdBarrier& b) {
    asm volatile("s_waitcnt vmcnt(0)" ::: "memory");
    __syncthreads();
    if (threadIdx.x == 0) {
        unsigned* bar = b.bar;
        __builtin_amdgcn_s_waitcnt(0);
        unsigned nloc = b.st[0], nx = b.st[1];
        if (nloc == 0u) { xcd_barrier_complete(bar, b.x, nloc, nx); b.st[0] = nloc; b.st[1] = nx; }
        const unsigned old = xb_add(&bar[XB_XSUB(b.x)], 1u);
        const unsigned gen = old / nloc;
        if (old + 1u == (gen + 1u) * nloc) {
            __builtin_amdgcn_fence(__ATOMIC_RELEASE, "agent");
            asm volatile("s_waitcnt vmcnt(0)" ::: "memory");
            const unsigned og = xb_add(&bar[XB_TOP], 1u);
            const unsigned tg = og / nx;
            if (og + 1u == (tg + 1u) * nx) xb_add(&bar[XB_TOPGEN], 1u);
            else XB_SPIN(xb_ld(&bar[XB_TOPGEN]) == tg, bar);
            __builtin_amdgcn_fence(__ATOMIC_ACQUIRE, "agent");
            xb_add(&bar[XB_XGEN(b.x)], 1u);
            asm volatile("s_waitcnt vmcnt(0)" ::: "memory");
        } else {
            XB_SPIN(xb_ld(&bar[XB_XGEN(b.x)]) == gen, bar);
            __builtin_amdgcn_fence(__ATOMIC_ACQUIRE, "agent");
            asm volatile("s_waitcnt vmcnt(0)" ::: "memory");
        }
    }
    __syncthreads();
}

namespace pg8 {
typedef double f64x2_t __attribute__((ext_vector_type(2)));
__device__ __forceinline__ f32x4 zero4() { double a, b; asm volatile("v_mov_b64 %0, 0" : "=v"(a)); asm volatile("v_mov_b64 %0, 0" : "=v"(b)); const f64x2_t v = {a, b}; return __builtin_bit_cast(f32x4, v); }
constexpr int BM = 256, BK = 64, HALF = 128, HTB = HALF * BK * 2, STAGE_BYTES = 8 * HTB, NXCD = 8, WGM = 8;
static_assert(STAGE_BYTES == STAGE_BYTES_C, "stage bytes");
__host__ __device__ __forceinline__ int lds_byte(int r, int c) { const int st = (r >> 4) * 2 + (c >> 5), rr = r & 15, cc = c & 31, ob = rr * 64 + cc * 2; return st * 1024 + (ob ^ (((ob >> 9) & 1) << 5)); }
__host__ __device__ __forceinline__ void stage_rc(int b, int& R, int& C) { const int st = b / 1024, sb = b % 1024, swz = sb ^ (((sb >> 9) & 1) << 5); R = (st >> 1) * 16 + swz / 64; C = (st & 1) * 32 + (swz % 64) / 2; }
__host__ __device__ __forceinline__ int perm32(int rho) { const int n = rho >> 4, i = rho & 15; return 8 * (i >> 2) + 4 * n + (i & 3); }

struct Unit { int pm, pn; };
struct Gemm { const bf16_t* A; const bf16_t* Bt; int M, N, K, lda; int ablk; };

struct StaticOrder {
    int nM, nN, nwg, G, c, wgm;
    __host__ __device__ void init(int M, int N, int G_, int c_, int wgm_ = WGM) { nM = M / BM; nN = N / BM; nwg = nM * nN; G = G_; c = c_; wgm = wgm_; }
    __host__ __device__ bool next(int i, Unit& u) const {
        const long L = (long)i * G + c; if (L >= nwg) return false;
        int wgid = (int)L; { const int q = nwg / NXCD, r = nwg % NXCD, xcd = wgid % NXCD, off = wgid / NXCD; wgid = (xcd < r ? xcd * (q + 1) : r * (q + 1) + (xcd - r) * q) + off; }
        const int nig = wgm * nN, gid = wgid / nig, fm = gid * wgm, gsz = (nM - fm) < wgm ? (nM - fm) : wgm;
        u.pm = fm + ((wgid % nig) % gsz); u.pn = (wgid % nig) / gsz; return true;
    }
};

template <class Epi, bool REPE = false>
__device__ __forceinline__ void gemm_phase(LAS unsigned char* lds, const Gemm g, const StaticOrder& S, const Epi& E, const Epi& E0) {
    const int tid = opaque_tid(), wid = __builtin_amdgcn_readfirstlane(tid >> 6), lane = tid & 63, wr = wid >> 2, wc = wid & 3, fr = lane & 15, fq = lane >> 4;
    const int K = g.K, nt = K / BK, lda = g.lda;
    unsigned voffA[2], voffB[2];
#pragma unroll
    for (int i = 0; i < 2; ++i) { int R, C; stage_rc(tid * 16 + i * 8192, R, C); const int Rb = Epi::PERM ? ((R & ~31) + perm32(R & 31)) : R;
        voffA[i] = g.ablk ? (unsigned)((C >> 5) * (BM * 32) + R * 32 + (C & 31)) * 2u : (unsigned)(R * lda + C) * 2u; voffB[i] = (unsigned)(Rb * BK + C) * 2u; }
    const size_t kstep = (size_t)(BK * 2);
    const size_t hstepA = g.ablk ? (size_t)HALF * 32 * 2 : (size_t)HALF * lda * 2, hstepB = (size_t)HALF * BK * 2;
    const size_t kstepA = g.ablk ? (size_t)(BM * BK * 2) : kstep;
    const size_t kstepB = (size_t)(BM * BK * 2);
    const size_t tstepA = g.ablk ? (size_t)nt * kstepA : 2 * hstepA, tstepB = (size_t)nt * kstepB;
    const unsigned ldsw = (unsigned)wid * 1024u;
    const int aoff = lds_byte(wr * 64 + fr, fq * 8), boff = lds_byte(wc * 32 + fr, fq * 8);
#define PG8_SA(b, h) (((b) * 2 + (h)) * HTB)
#define PG8_SB(b, h) ((4 + (b) * 2 + (h)) * HTB)
#define PG8_STAGE(bufoff, gbase, voff) do { _Pragma("unroll") for (int _i = 0; _i < 2; ++_i) \
        __builtin_amdgcn_global_load_lds((const unsigned*)((const char*)(gbase) + (voff)[_i]), (LAS unsigned*)(lds + (bufoff) + ldsw + _i * 8192), 16, 0, 0); } while (0)
#define PG8_LDA(dst, b, h) do { _Pragma("unroll") for (int m = 0; m < 4; ++m) _Pragma("unroll") for (int k = 0; k < 2; ++k) dst[m][k] = *(const LAS bf16x8*)(lds + PG8_SA(b, h) + aoff + m * 2048 + k * 1024); } while (0)
#define PG8_LDB(dst, b, h) do { _Pragma("unroll") for (int n = 0; n < 2; ++n) _Pragma("unroll") for (int k = 0; k < 2; ++k) dst[n][k] = *(const LAS bf16x8*)(lds + PG8_SB(b, h) + boff + n * 2048 + k * 1024); } while (0)
#define PG8_MMA(ai, bj, At, Bt) do { __builtin_amdgcn_s_setprio(1); \
        if constexpr (Epi::I8) { _Pragma("unroll") for (int m = 0; m < 4; ++m) _Pragma("unroll") for (int n = 0; n < 2; ++n) _Pragma("unroll") for (int k = 0; k < 2; ++k) \
            acc[ai][bj][m][n] = __builtin_bit_cast(f32x4, __builtin_amdgcn_mfma_i32_16x16x64_i8(__builtin_bit_cast(i32x4, Bt[n][k]), __builtin_bit_cast(i32x4, At[m][k]), __builtin_bit_cast(i32x4, acc[ai][bj][m][n]), 0, 0, 0)); } \
        else { _Pragma("unroll") for (int m = 0; m < 4; ++m) _Pragma("unroll") for (int n = 0; n < 2; ++n) _Pragma("unroll") for (int k = 0; k < 2; ++k) \
            acc[ai][bj][m][n] = __builtin_amdgcn_mfma_f32_16x16x32_bf16(Bt[n][k], At[m][k], acc[ai][bj][m][n], 0, 0, 0); } \
        __builtin_amdgcn_s_setprio(0); } while (0)
#define PG8_WAIT_V(n) asm volatile("s_waitcnt vmcnt(" #n ")" ::: "memory")
#define PG8_WAIT_L(n) asm volatile("s_waitcnt lgkmcnt(" #n ")" ::: "memory")
#define PG8_BAR __builtin_amdgcn_s_barrier()
#define PG8_SCHED __builtin_amdgcn_sched_barrier(0)
    Unit cur, nxt; int ui = 0;
    if (!S.next(0, cur)) return;
    float rsn[8];
#pragma unroll
    for (int r = 0; r < 8; ++r) rsn[r] = 0.f;
    if (Epi::PREF) E.rs_first(cur, wr, fr, fq, rsn);
    f32x4 acc[2][2][4][2];
#pragma unroll
    for (int a = 0; a < 2; ++a)
#pragma unroll
        for (int b = 0; b < 2; ++b)
#pragma unroll
            for (int m = 0; m < 4; ++m)
#pragma unroll
                for (int n = 0; n < 2; ++n) acc[a][b][m][n] = zero4();
    bf16x8 At[4][2], B0[2][2], B1[2][2];
    const char* cA = (const char*)g.A + (size_t)cur.pm * tstepA; const char* cB = (const char*)g.Bt + (size_t)cur.pn * tstepB;
    PG8_STAGE(PG8_SB(0, 0), cB, voffB); PG8_STAGE(PG8_SA(0, 0), cA, voffA); PG8_STAGE(PG8_SB(0, 1), cB + hstepB, voffB); PG8_STAGE(PG8_SA(0, 1), cA + hstepA, voffA);
    if (wr == 1) PG8_BAR;
    PG8_WAIT_V(4); PG8_BAR;
    PG8_STAGE(PG8_SB(1, 0), cB + kstepB, voffB); PG8_STAGE(PG8_SA(1, 0), cA + kstepA, voffA); PG8_STAGE(PG8_SB(1, 1), cB + hstepB + kstepB, voffB);
    PG8_WAIT_V(6); PG8_BAR;
    for (;;) {
        const bool has_next = S.next(ui + 1, nxt);
        const char* nA = has_next ? (const char*)g.A + (size_t)nxt.pm * tstepA : cA; const char* nB = has_next ? (const char*)g.Bt + (size_t)nxt.pn * tstepB : cB;
#pragma nounroll
        for (int t = 0; t < nt; t += 2) {
            const bool last = (t == nt - 2);
            const char* a1 = cA + (size_t)(t + 1) * kstepA;
            const char* a2 = last ? nA : cA + (size_t)(t + 2) * kstepA; const char* b2 = last ? nB : cB + (size_t)(t + 2) * kstepB;
            const char* a3 = a2 + kstepA; const char* b3 = b2 + kstepB;
            PG8_LDB(B0, 0, 0); PG8_SCHED; PG8_LDA(At, 0, 0); PG8_STAGE(PG8_SA(1, 1), a1 + hstepA, voffA);
            PG8_WAIT_L(8); PG8_BAR; PG8_WAIT_L(0); PG8_MMA(0, 0, At, B0); PG8_BAR; PG8_SCHED;
            PG8_LDB(B1, 0, 1); PG8_STAGE(PG8_SB(0, 0), b2, voffB);
            PG8_BAR; PG8_WAIT_L(0); PG8_MMA(0, 1, At, B1); PG8_BAR;
            PG8_LDA(At, 0, 1); PG8_STAGE(PG8_SA(0, 0), a2, voffA);
            PG8_BAR; PG8_WAIT_L(0); PG8_MMA(1, 0, At, B0); PG8_BAR; PG8_SCHED;
            PG8_STAGE(PG8_SB(0, 1), b2 + hstepB, voffB);
            PG8_WAIT_V(6); PG8_BAR; PG8_MMA(1, 1, At, B1); PG8_BAR;
            PG8_LDB(B0, 1, 0); PG8_SCHED; PG8_LDA(At, 1, 0); PG8_STAGE(PG8_SA(0, 1), a2 + hstepA, voffA);
            PG8_WAIT_L(8); PG8_BAR; PG8_WAIT_L(0); PG8_MMA(0, 0, At, B0); PG8_BAR; PG8_SCHED;
            PG8_LDB(B1, 1, 1); PG8_STAGE(PG8_SB(1, 0), b3, voffB);
            PG8_BAR; PG8_WAIT_L(0); PG8_MMA(0, 1, At, B1); PG8_BAR;
            PG8_LDA(At, 1, 1); PG8_STAGE(PG8_SA(1, 0), a3, voffA);
            PG8_BAR; PG8_WAIT_L(0); PG8_MMA(1, 0, At, B0); PG8_BAR; PG8_SCHED;
            PG8_STAGE(PG8_SB(1, 1), b3 + hstepB, voffB);
            PG8_WAIT_V(6); PG8_BAR; PG8_MMA(1, 1, At, B1); PG8_BAR;
        }
        if (REPE) { float rs2[8]; _Pragma("unroll") for (int r = 0; r < 8; ++r) rs2[r] = rsn[r]; E0(acc, cur, nxt, false, rs2, wr, wc, fr, fq); }
        E(acc, cur, nxt, has_next, rsn, wr, wc, fr, fq);
        if (!has_next) break;
#pragma unroll
        for (int a = 0; a < 2; ++a)
#pragma unroll
            for (int b = 0; b < 2; ++b)
#pragma unroll
                for (int m = 0; m < 4; ++m)
#pragma unroll
                    for (int n = 0; n < 2; ++n) acc[a][b][m][n] = zero4();
        cur = nxt; cA = nA; cB = nB; ++ui;
    }
    PG8_WAIT_V(0);
    if (wr == 0) PG8_BAR;
    PG8_BAR;
#undef PG8_SA
#undef PG8_SB
#undef PG8_STAGE
#undef PG8_LDA
#undef PG8_LDB
#undef PG8_MMA
#undef PG8_WAIT_V
#undef PG8_WAIT_L
#undef PG8_BAR
#undef PG8_SCHED
}
}

__device__ __forceinline__ float silu_f(float x) { return x * __builtin_amdgcn_rcpf(1.0f + __expf(-x)); }

__device__ __forceinline__ void rstd8_from_part32(const float* part, int row0, int fq, float inv_n, float (&rs)[8]) {
    f32x4 pa[8], pb[8];
#pragma unroll
    for (int r = 0; r < 8; ++r) { const float* p = part + (size_t)(row0 + (r >> 2) * 128 + (r & 3) * 16) * 32 + fq * 8; pa[r] = *(const f32x4*)p; pb[r] = *(const f32x4*)(p + 4); }
#pragma unroll
    for (int r = 0; r < 8; ++r) {
        float sm = ((pa[r][0] + pa[r][1]) + (pa[r][2] + pa[r][3])) + ((pb[r][0] + pb[r][1]) + (pb[r][2] + pb[r][3]));
        sm += __shfl_xor(sm, 16); sm += __shfl_xor(sm, 32);
        rs[r] = rsqrtf(sm * inv_n + RMS_EPS);
    }
}
__device__ __forceinline__ void rstd8_load(const float* rstd, int row0, float (&rs)[8]) {
#pragma unroll
    for (int r = 0; r < 8; ++r) rs[r] = rstd[row0 + (r >> 2) * 128 + (r & 3) * 16];
}
struct EpiGU {
    static constexpr bool PERM = true, PREF = true, I8 = true;
    bf16_t* O; const float* part; const float* rstd; const float* wmax; unsigned* amax;
    __device__ __forceinline__ void rs_first(const pg8::Unit& u, int wr, int fr, int fq, float (&rs)[8]) const { if (rstd) rstd8_load(rstd, u.pm * 256 + wr * 64 + fr, rs); }
    __device__ __forceinline__ void operator()(const f32x4 (&acc)[2][2][4][2], const pg8::Unit& u, const pg8::Unit& nx, bool has_next, float (&rsn)[8], int wr, int wc, int fr_, int fq_) const {
        int fr = fr_, fq = fq_; asm volatile("" : "+v"(fr), "+v"(fq));
        const int row0 = u.pm * 256 + wr * 64 + fr, col0 = u.pn * 128 + wc * 32 + 8 * fq;
        float rsv[8], rsp[8];
        const float wsc = *wmax * (1.0f / 127.0f);
        unsigned mxr[8];
        if (rstd && !PREF) rstd8_load(rstd, row0, rsv);
        else if (rstd) {
#pragma unroll
            for (int r = 0; r < 8; ++r) { rsv[r] = rsn[r]; rsp[r] = rsn[r]; }
            if (has_next) rstd8_load(rstd, nx.pm * 256 + wr * 64 + fr, rsp);
        } else rstd8_from_part32(part, row0, fq, 1.0f / DM, rsv);
#pragma unroll
        for (int ai = 0; ai < 2; ++ai)
#pragma unroll
            for (int m = 0; m < 4; ++m) {
                const int row = row0 + ai * 128 + m * 16;
                const float rs = rsv[ai * 4 + m] * wsc;
                const float c1 = rs * -1.4426950408889634f;
                f32x2 op[4];
#pragma unroll
                for (int n = 0; n < 2; ++n)
#pragma unroll
                    for (int e2 = 0; e2 < 2; ++e2) {
                        const i32x4 gi = __builtin_bit_cast(i32x4, acc[ai][0][m][n]), ui = __builtin_bit_cast(i32x4, acc[ai][1][m][n]);
                        const f32x2 g2 = {(float)gi[2 * e2], (float)gi[2 * e2 + 1]}, u2 = {(float)ui[2 * e2], (float)ui[2 * e2 + 1]};
                        const f32x2 t2 = g2 * c1; f32x2 d2 = {__builtin_amdgcn_exp2f(t2.x), __builtin_amdgcn_exp2f(t2.y)}; d2 = d2 + 1.0f;
                        const f32x2 r2 = {__builtin_amdgcn_rcpf(d2.x), __builtin_amdgcn_rcpf(d2.y)};
                        op[n * 2 + e2] = (g2 * u2) * r2; }
                fwht8_pk(op);
                const float o[8] = {op[0][0], op[0][1], op[1][0], op[1][1], op[2][0], op[2][1], op[3][0], op[3][1]};
                {
                    unsigned mx, m2;
                    asm("v_max3_f32 %0, |%1|, |%2|, |%3|" : "=v"(mx) : "v"(o[0]), "v"(o[1]), "v"(o[2]));
                    asm("v_max3_f32 %0, |%1|, |%2|, |%3|" : "=v"(m2) : "v"(o[3]), "v"(o[4]), "v"(o[5]));
                    asm("v_max3_f32 %0, %1, |%2|, |%3|" : "=v"(mx) : "v"(mx), "v"(o[6]), "v"(o[7]));
                    mx = mx > m2 ? mx : m2;
                    { const u32x2 r = __builtin_amdgcn_permlane16_swap(mx, mx, false, false); mx = r.x > r.y ? r.x : r.y; }
                    { const u32x2 r = __builtin_amdgcn_permlane32_swap(mx, mx, false, false); mx = r.x > r.y ? r.x : r.y; }
                    mxr[ai * 4 + m] = mx;
                }
                u32x4 w; w.x = cvt_pk_bf16(o[0], o[1]); w.y = cvt_pk_bf16(o[2], o[3]); w.z = cvt_pk_bf16(o[4], o[5]); w.w = cvt_pk_bf16(o[6], o[7]);
                __builtin_nontemporal_store(w, (u32x4*)(O + ((((size_t)u.pm * (DFF / 64) + (col0 >> 6)) * 2 + ((col0 >> 5) & 1)) * 256 + (row & 255)) * 32 + (col0 & 31)));
            }
        if (fq == 0) {
#pragma unroll
            for (int r = 0; r < 8; ++r) __hip_atomic_fetch_max(amax + row0 + (r >> 2) * 128 + (r & 3) * 16, mxr[r], __ATOMIC_RELAXED, __HIP_MEMORY_SCOPE_AGENT);
        }
        if (rstd && PREF) {
#pragma unroll
            for (int r = 0; r < 8; ++r) rsn[r] = rsp[r];
        }
    }
};

template <bool I8_> struct EpiResT {
    static constexpr bool PERM = true, PREF = false, I8 = I8_;
    const float* basef; bf16_t* hb; float* part; float scale; const float* asc; const float* wmax;
    __device__ __forceinline__ void rs_first(const pg8::Unit&, int, int, int, float (&)[8]) const {}
    __device__ __forceinline__ void operator()(const f32x4 (&acc)[2][2][4][2], const pg8::Unit& u, const pg8::Unit&, bool, float (&)[8], int wr, int wc, int fr, int fq) const {
        const int row0 = u.pm * 256 + wr * 64 + fr, col0 = u.pn * 256 + wc * 32 + 8 * fq;
        const float wsc = I8 ? scale * (*wmax * (1.0f / 127.0f)) : scale;
#pragma unroll
        for (int ai = 0; ai < 2; ++ai)
#pragma unroll
        for (int mh = 0; mh < 2; ++mh) {
            f32x4 b0[2][2], b1[2][2]; float rowf[2];
#pragma unroll
            for (int m2 = 0; m2 < 2; ++m2) rowf[m2] = I8 ? wsc * asc[row0 + ai * 128 + (mh * 2 + m2) * 16] : scale;
            if (basef) {
#pragma unroll
                for (int m2 = 0; m2 < 2; ++m2)
#pragma unroll
                    for (int bj = 0; bj < 2; ++bj) { const float* p = basef + (size_t)(row0 + ai * 128 + (mh * 2 + m2) * 16) * DM + col0 + bj * 128; b0[m2][bj] = *(const f32x4*)p; b1[m2][bj] = *(const f32x4*)(p + 4); }
            } else {
#pragma unroll
                for (int m2 = 0; m2 < 2; ++m2)
#pragma unroll
                    for (int bj = 0; bj < 2; ++bj) { const u32x4 w = *(const u32x4*)(hb + (size_t)(row0 + ai * 128 + (mh * 2 + m2) * 16) * DM + col0 + bj * 128);
                        b0[m2][bj] = (f32x4){__uint_as_float(w.x << 16), __uint_as_float(w.x & 0xffff0000u), __uint_as_float(w.y << 16), __uint_as_float(w.y & 0xffff0000u)};
                        b1[m2][bj] = (f32x4){__uint_as_float(w.z << 16), __uint_as_float(w.z & 0xffff0000u), __uint_as_float(w.w << 16), __uint_as_float(w.w & 0xffff0000u)}; }
            }
#pragma unroll
            for (int m2 = 0; m2 < 2; ++m2) {
                const int m = mh * 2 + m2;
                const int row = row0 + ai * 128 + m * 16; float sq = 0.f;
#pragma unroll
                for (int bj = 0; bj < 2; ++bj) {
                    const f32x4 a0 = I8 ? __builtin_convertvector(__builtin_bit_cast(i32x4, acc[ai][bj][m][0]), f32x4) : acc[ai][bj][m][0], a1 = I8 ? __builtin_convertvector(__builtin_bit_cast(i32x4, acc[ai][bj][m][1]), f32x4) : acc[ai][bj][m][1];
                    const f32x4 v0 = b0[m2][bj] + a0 * rowf[m2], v1 = b1[m2][bj] + a1 * rowf[m2];
                    u32x4 w; w.x = cvt_pk_bf16(v0[0], v0[1]); w.y = cvt_pk_bf16(v0[2], v0[3]); w.z = cvt_pk_bf16(v1[0], v1[1]); w.w = cvt_pk_bf16(v1[2], v1[3]);
                    *(u32x4*)(hb + (size_t)row * DM + col0 + bj * 128) = w;
                    const float r0 = __uint_as_float(w.x << 16), r1 = __uint_as_float(w.x & 0xffff0000u), r2 = __uint_as_float(w.y << 16), r3 = __uint_as_float(w.y & 0xffff0000u);
                    const float r4 = __uint_as_float(w.z << 16), r5 = __uint_as_float(w.z & 0xffff0000u), r6 = __uint_as_float(w.w << 16), r7 = __uint_as_float(w.w & 0xffff0000u);
                    sq += ((r0 * r0 + r1 * r1) + (r2 * r2 + r3 * r3)) + ((r4 * r4 + r5 * r5) + (r6 * r6 + r7 * r7));
                }
                sq += __shfl_xor(sq, 16); sq += __shfl_xor(sq, 32);
                if (fq == 0) part[(size_t)row * 32 + u.pn * 4 + wc] = sq;
            }
        }
    }
};

template <int MODE> struct EpiScale {
    static constexpr bool PERM = true, PREF = (MODE == 0), I8 = false;
    bf16_t* O; int ldo; const float* part_in; float inv_n; float mul; float* part_q; float* part_kv; const float* rc; const float* rs; const float* rstd;
    __device__ __forceinline__ void rs_first(const pg8::Unit& u, int wr, int fr, int fq, float (&rv)[8]) const { if (MODE == 0 && rstd) rstd8_load(rstd, u.pm * 256 + wr * 64 + fr, rv); }
    __device__ __forceinline__ void operator()(const f32x4 (&acc)[2][2][4][2], const pg8::Unit& u, const pg8::Unit& nx, bool has_next, float (&rsn)[8], int wr, int wc, int fr, int fq) const {
        const int row0 = u.pm * 256 + wr * 64 + fr, col0 = u.pn * 256 + wc * 32 + 8 * fq;
        float rsv[8], rsp[8];
        if (MODE == 0 && rstd) {
#pragma unroll
            for (int r = 0; r < 8; ++r) { rsv[r] = rsn[r]; rsp[r] = rsn[r]; }
            if (has_next) rstd8_load(rstd, nx.pm * 256 + wr * 64 + fr, rsp);
        } else if (MODE == 0) rstd8_from_part32(part_in, row0, fq, inv_n, rsv);
        else if (MODE == 2) {
            f32x4 pa[8], pb[8];
#pragma unroll
            for (int r = 0; r < 8; ++r) { const float* p = part_in + (size_t)(row0 + (r >> 2) * 128 + (r & 3) * 16) * 8; pa[r] = *(const f32x4*)p; pb[r] = *(const f32x4*)(p + 4); }
#pragma unroll
            for (int r = 0; r < 8; ++r) rsv[r] = rsqrtf((((pa[r][0] + pa[r][1]) + (pa[r][2] + pa[r][3])) + ((pb[r][0] + pb[r][1]) + (pb[r][2] + pb[r][3]))) * inv_n + RMS_EPS);
        } else {
            f32x4 pa[8];
#pragma unroll
            for (int r = 0; r < 8; ++r) pa[r] = *(const f32x4*)(part_in + (size_t)(row0 + (r >> 2) * 128 + (r & 3) * 16) * 4);
#pragma unroll
            for (int r = 0; r < 8; ++r) rsv[r] = rsqrtf(((pa[r][0] + pa[r][1]) + (pa[r][2] + pa[r][3])) * inv_n + RMS_EPS);
        }
#pragma unroll
        for (int ai = 0; ai < 2; ++ai)
#pragma unroll
            for (int m = 0; m < 4; ++m) {
                const int row = row0 + ai * 128 + m * 16;
                const float r = rsv[ai * 4 + m] * mul;
                float sq = 0.f;
#pragma unroll
                for (int bj = 0; bj < 2; ++bj) {
                    const int c = col0 + bj * 128;
                    f32x4 v0 = acc[ai][bj][m][0] * r, v1 = acc[ai][bj][m][1] * r;
                    if (MODE == 2) {
                        const int cc = c % QKD;
                        if (cc >= 128) {
                            const int j0 = (cc - 128) >> 1;
                            const f32x4 cs = *(const f32x4*)(rc + (size_t)row * 32 + j0), sn = *(const f32x4*)(rs + (size_t)row * 32 + j0);
                            f32x4 a0, a1;
                            a0[0] = v0[0] * cs[0] - v0[1] * sn[0]; a0[1] = v0[0] * sn[0] + v0[1] * cs[0];
                            a0[2] = v0[2] * cs[1] - v0[3] * sn[1]; a0[3] = v0[2] * sn[1] + v0[3] * cs[1];
                            a1[0] = v1[0] * cs[2] - v1[1] * sn[2]; a1[1] = v1[0] * sn[2] + v1[1] * cs[2];
                            a1[2] = v1[2] * cs[3] - v1[3] * sn[3]; a1[3] = v1[2] * sn[3] + v1[3] * cs[3];
                            v0 = a0; v1 = a1;
                        }
                    }
                    if (MODE == 0) sq += (v0[0] * v0[0] + v0[1] * v0[1]) + (v0[2] * v0[2] + v0[3] * v0[3]) + (v1[0] * v1[0] + v1[1] * v1[1]) + (v1[2] * v1[2] + v1[3] * v1[3]);
                    u32x4 w; w.x = cvt_pk_bf16(v0[0], v0[1]); w.y = cvt_pk_bf16(v0[2], v0[3]); w.z = cvt_pk_bf16(v1[0], v1[1]); w.w = cvt_pk_bf16(v1[2], v1[3]);
                    __builtin_nontemporal_store(w, (u32x4*)(O + (size_t)row * ldo + c));
                }
                if (MODE == 0) {
                    if (u.pn < 3) {
                        sq += __shfl_xor(sq, 16); sq += __shfl_xor(sq, 32);
                        if (fq == 0) { if (u.pn < 2) part_q[(size_t)row * 8 + u.pn * 4 + wc] = sq; else part_kv[(size_t)row * 4 + wc] = sq; }
                    }
                }
            }
        if (MODE == 0 && rstd) {
#pragma unroll
            for (int r = 0; r < 8; ++r) rsn[r] = rsp[r];
        }
    }
};

struct Args { const void* in[32]; float* out; unsigned char* ws; int ph_lo, ph_hi; };

struct Ctx {
    const void* const* in; float* out; unsigned char* ws;
    LAS unsigned char* lds; int G, wg;
    __device__ __forceinline__ const float* fin(int i) const { return (const float*)in[i]; }
    template <class T> __device__ __forceinline__ T* at(size_t off) const { return (T*)(ws + off); }
    __device__ __forceinline__ Ctx fresh() const { Ctx c = *this; int z; asm volatile("s_mov_b32 %0, 0" : "=s"(z)); c.in = in + z; c.out = out + z; c.ws = ws + z; c.G = G + z; c.wg = wg + z; return c; }
};

enum { MAP_ID = 0, MAP_GU = 1, MAP_WIN = 2, MAP_UQ = 3 };
template <int MAP> __device__ __forceinline__ int src_col(int n) {
    if (MAP == MAP_WIN) { if (n >= NIN) return -1; if (n >= 768 && n < 832) { const int jj = n - 768; return 768 + (jj & 1) * 32 + (jj >> 1); } return n; }
    if (MAP == MAP_UQ) { const int h = n / QKD, cc = n % QKD; if (cc < 128) return n; const int jj = cc - 128; return h * QKD + 128 + (jj & 1) * 32 + (jj >> 1); }
    return n;
}
template <int MAP, bool F8 = false, bool HAD = false>
__device__ __forceinline__ void conv_job(const Ctx& C, int& toff, const float* src, const float* src2, int ldsrc, bf16_t* dst, int Ndst, int K, const float* gain, float qs = 1.0f) {
    LAS float* tile = (LAS float*)C.lds;
    const int tid = opaque_tid(), ntn = Ndst / 64, ntk = K / 256, ntiles = ntn * ntk;
    const int tfirst = (C.wg + C.G - toff % C.G) % C.G; toff += ntiles;
    for (int t = tfirst; t < ntiles; t += C.G) {
        const int tn = t % ntn, tk = t / ntn, n0 = tn * 64, k0 = tk * 256;
        {
            const int nl = tid & 63, kl0 = tid >> 6;
            const float* s = src; int col;
            if (MAP == MAP_GU) { const int n = n0 + nl, tt = n >> 8, r = n & 255; s = (r < 128) ? src : src2; col = tt * 128 + (r & 127); }
            else col = src_col<MAP>(n0 + nl);
            float v[32];
            const float* sp = s + (size_t)(k0 + kl0) * ldsrc + (col >= 0 ? col : 0);
#pragma unroll
            for (int i = 0; i < 32; ++i) v[i] = sp[(size_t)(8 * i) * ldsrc];
#pragma unroll
            for (int i = 0; i < 32; ++i) {
                float x = (col >= 0) ? v[i] : 0.f;
                if (gain) x *= gain[k0 + kl0 + 8 * i];
                if (F8) x *= qs;
                tile[(kl0 + 8 * i) * 65 + nl] = x;
            }
        }
        __syncthreads();
        {
            const int nl = tid >> 3, kc = (tid & 7) * 8;
#pragma unroll
            for (int q = 0; q < 4; ++q) {
                float v[8];
#pragma unroll
                for (int e = 0; e < 8; ++e) v[e] = tile[(q * 64 + kc + e) * 65 + nl];
                if (HAD) { fwht8(v);
#pragma unroll
                    for (int e = 0; e < 8; ++e) v[e] *= 0.35355339059327373f; }
                if (F8) {
                    u32x2 w8; w8.x = pk4_i8(v[0], v[1], v[2], v[3]); w8.y = pk4_i8(v[4], v[5], v[6], v[7]);
                    const int n_ = n0 + nl, kt_ = (k0 >> 7) + (q >> 1);
                    *(u32x2*)((unsigned char*)dst + (((size_t)(n_ >> 8) * (K >> 7) + kt_) * 256 + (n_ & 255)) * 128 + (q & 1) * 64 + kc) = w8;
                    continue;
                }
                u32x4 w; w.x = cvt_pk_bf16(v[0], v[1]); w.y = cvt_pk_bf16(v[2], v[3]); w.z = cvt_pk_bf16(v[4], v[5]); w.w = cvt_pk_bf16(v[6], v[7]);
                { const int n_ = n0 + nl, kt_ = (k0 >> 6) + q;
                  *(u32x4*)(dst + (((size_t)(n_ >> 8) * (K >> 6) + kt_) * 256 + (n_ & 255)) * 64 + kc) = w; }
            }
        }
        __syncthreads();
    }
}
template <bool GU, bool HAD>
__device__ __forceinline__ void conv_job_w(const Ctx& C, int& toff, const float* src, const float* src2, int ldsrc, unsigned char* dst, int Ndst, int K, const float* gain, float qs) {
    LAS float* tile = (LAS float*)C.lds;
    const int tid = opaque_tid(), ntn = Ndst / 256, ntk = K / 64, ntiles = ntn * ntk;
    const int tfirst = (C.wg + C.G - toff % C.G) % C.G; toff += ntiles;
    for (int t = tfirst; t < ntiles; t += C.G) {
        const int tn = t % ntn, tk = t / ntn, n0 = tn * 256, k0 = tk * 64;
        {
            const int n4 = tid & 63, kl0 = tid >> 6;
            const float* s = src; int col = n0 + 4 * n4;
            if (GU) { const int r = 4 * n4; s = (r < 128) ? src : src2; col = tn * 128 + (r & 127); }
            f32x4 v[8];
            const float* sp = s + (size_t)(k0 + kl0) * ldsrc + col;
#pragma unroll
            for (int i = 0; i < 8; ++i) v[i] = *(const f32x4*)(sp + (size_t)(8 * i) * ldsrc);
#pragma unroll
            for (int i = 0; i < 8; ++i) { float g = qs; if (gain) g *= gain[k0 + kl0 + 8 * i]; *(LAS f32x4*)(tile + (kl0 + 8 * i) * 260 + 4 * n4) = v[i] * g; }
        }
        __syncthreads();
#pragma unroll
        for (int j = 0; j < 4; ++j) {
            const int p = tid + 512 * j, kg = p & 7, nl = p >> 3;
            float v[8];
#pragma unroll
            for (int e = 0; e < 8; ++e) v[e] = tile[(kg * 8 + e) * 260 + nl];
            if (HAD) { fwht8(v);
#pragma unroll
                for (int e = 0; e < 8; ++e) v[e] *= 0.35355339059327373f; }
            u32x2 w8; w8.x = pk4_i8(v[0], v[1], v[2], v[3]); w8.y = pk4_i8(v[4], v[5], v[6], v[7]);
            const int n_ = n0 + nl, kk = k0 + kg * 8;
            *(u32x2*)(dst + (((size_t)(n_ >> 8) * (K >> 7) + (kk >> 7)) * 256 + (n_ & 255)) * 128 + (kk & 127)) = w8;
        }
        __syncthreads();
    }
}
__device__ __forceinline__ float wmax_scan(const Ctx& C, const float* w, const float* gain, float mx) {
    const int tid = opaque_tid();
    for (int k0 = C.wg; k0 < DM; k0 += 4 * C.G) {
        f32x4 v[4][3];
#pragma unroll
        for (int j = 0; j < 4; ++j) { const int k = k0 + j * C.G; const float* r = w + (size_t)(k < DM ? k : k0) * DFF;
#pragma unroll
            for (int i = 0; i < 3; ++i) { const int c = (i * 512 + tid) * 4; v[j][i] = *(const f32x4*)(r + (c < DFF ? c : 0)); } }
#pragma unroll
        for (int j = 0; j < 4; ++j) { const int k = k0 + j * C.G; float m = 0.f;
#pragma unroll
            for (int i = 0; i < 3; ++i) m = fmaxf(fmaxf(m, fmaxf(__builtin_fabsf(v[j][i][0]), __builtin_fabsf(v[j][i][1]))), fmaxf(__builtin_fabsf(v[j][i][2]), __builtin_fabsf(v[j][i][3])));
            mx = fmaxf(mx, m * __builtin_fabsf(gain[k < DM ? k : k0])); }
    }
    return mx;
}
__device__ __forceinline__ float wmax_scan_rot(const Ctx& C, const float* w) {
    const int tid = opaque_tid(); float mx = 0.f;
    for (int grp = C.wg; grp < DFF / 8; grp += C.G) {
        f32x4 v[8];
#pragma unroll
        for (int j = 0; j < 8; ++j) v[j] = *(const f32x4*)(w + (size_t)(grp * 8 + j) * DM + tid * 4);
#pragma unroll
        for (int c = 0; c < 4; ++c) { float t[8];
#pragma unroll
            for (int j = 0; j < 8; ++j) t[j] = v[j][c];
            fwht8(t);
#pragma unroll
            for (int j = 0; j < 8; ++j) mx = fmaxf(mx, __builtin_fabsf(t[j] * 0.35355339059327373f)); }
    }
    return mx;
}
__device__ __forceinline__ void phase_convert(const Ctx& C, int l, const XcdBarrier& bar) {
    const size_t offGU = (size_t)l * DM * DFF, offD = (size_t)l * DFF * DM; int toff = 0;
    unsigned* wm = C.at<unsigned>(WS_CTL + CW_WMAX) + l * 2;
    {
#pragma unroll
        for (int f = 0; f < 2; ++f) {
            float mx = wmax_scan(C, C.fin(f ? 28 : 3) + offGU, C.fin(f ? 27 : 2) + l * DM, 0.f);
            mx = wmax_scan(C, C.fin(f ? 29 : 4) + offGU, C.fin(f ? 27 : 2) + l * DM, mx);
#pragma unroll
            for (int o = 32; o >= 1; o >>= 1) mx = fmaxf(mx, __shfl_xor(mx, o));
            if ((opaque_tid() & 63) == 0) __hip_atomic_fetch_max(wm + f, __float_as_uint(mx), __ATOMIC_RELAXED, __HIP_MEMORY_SCOPE_AGENT);
            float md = wmax_scan_rot(C, C.fin(f ? 30 : 5) + offD);
#pragma unroll
            for (int o = 32; o >= 1; o >>= 1) md = fmaxf(md, __shfl_xor(md, o));
            if ((opaque_tid() & 63) == 0) __hip_atomic_fetch_max(wm + 8 + f, __float_as_uint(md), __ATOMIC_RELAXED, __HIP_MEMORY_SCOPE_AGENT);
        }
        xcd_barrier(bar);
    }
    const float wmaxd1 = __uint_as_float(__hip_atomic_load(wm + 8, __ATOMIC_RELAXED, __HIP_MEMORY_SCOPE_AGENT)), wmaxd2 = __uint_as_float(__hip_atomic_load(wm + 9, __ATOMIC_RELAXED, __HIP_MEMORY_SCOPE_AGENT));
    const float qd1 = wmaxd1 > 0.f ? 127.0f / wmaxd1 : 0.f, qd2 = wmaxd2 > 0.f ? 127.0f / wmaxd2 : 0.f;
    const float wmax1 = __uint_as_float(__hip_atomic_load(wm + 0, __ATOMIC_RELAXED, __HIP_MEMORY_SCOPE_AGENT)), wmax2 = __uint_as_float(__hip_atomic_load(wm + 1, __ATOMIC_RELAXED, __HIP_MEMORY_SCOPE_AGENT));
    const float qs1 = wmax1 > 0.f ? 127.0f / wmax1 : 0.f, qs2 = wmax2 > 0.f ? 127.0f / wmax2 : 0.f;
    conv_job_w<false, true>(C, toff, C.fin(30) + offD, nullptr, DM, C.at<unsigned char>(WS_W2D), DM, DFF, nullptr, qd2);
    conv_job_w<true, false>(C, toff, C.fin(28) + offGU, C.fin(29) + offGU, DFF, C.at<unsigned char>(WS_W2GU), 2 * DFF, DM, C.fin(27) + l * DM, qs2);
    conv_job_w<false, true>(C, toff, C.fin(5) + offD, nullptr, DM, C.at<unsigned char>(WS_W1D), DM, DFF, nullptr, qd1);
    conv_job_w<true, false>(C, toff, C.fin(3) + offGU, C.fin(4) + offGU, DFF, C.at<unsigned char>(WS_W1GU), 2 * DFF, DM, C.fin(2) + l * DM, qs1);
    conv_job<MAP_WIN>(C, toff, C.fin(7) + (size_t)l * DM * NIN, nullptr, NIN, C.at<bf16_t>(WS_WIN), NINP, DM, C.fin(6) + l * DM);
    conv_job<MAP_UQ>(C, toff, C.fin(10) + (size_t)l * QL * NQ, nullptr, NQ, C.at<bf16_t>(WS_WUQ), NQ, QL, C.fin(8) + l * QL);
    conv_job<MAP_ID>(C, toff, C.fin(11) + (size_t)l * KVL * NKV, nullptr, NKV, C.at<bf16_t>(WS_WUKV), NKV, KVL, C.fin(9) + l * KVL);
    conv_job<MAP_ID>(C, toff, C.fin(26) + (size_t)l * DM * DM, nullptr, DM, C.at<bf16_t>(WS_WOUT), DM, DM, nullptr);
    {
        const int tid = opaque_tid(); bf16_t* Ub = C.at<bf16_t>(WS_LORA);
        const float* dU = C.fin(15) + (size_t)l * 32 * BW; const float* iU = C.fin(17) + (size_t)l * 32 * BW; const float* gU = C.fin(18) + (size_t)l * 96 * BW;
        for (int e = C.wg * NTHREADS + tid; e < 512 * 160; e += C.G * NTHREADS) {
            const int k = e >> 9, n = e & 511;
            const float v = (k < 32) ? dU[k * BW + n] : (k < 64 ? iU[(k - 32) * BW + n] : gU[(k - 64) * BW + n]);
            Ub[n * 160 + k] = f2bf(v);
        }
    }
}

__device__ __forceinline__ void phase_prologue(const Ctx& C) {
    const int tid = opaque_tid(), lane = tid & 63, wv = tid >> 6;
    const float* x = C.fin(0); bf16_t* hb = C.at<bf16_t>(WS_HB); float* part = C.at<float>(WS_PARTH); unsigned char* h8 = C.at<unsigned char>(WS_H8);
    for (int row = C.wg * 8 + wv; row < MTOK; row += C.G * 8) {
        float s = 0.f, mx = 0.f; f32x4 v[8];
#pragma unroll
        for (int i = 0; i < 8; ++i) {
            const size_t off = (size_t)row * DM + (i * 64 + lane) * 4;
            v[i] = *(const f32x4*)(x + off);
            u32x2 w; w.x = cvt_pk_bf16(v[i][0], v[i][1]); w.y = cvt_pk_bf16(v[i][2], v[i][3]);
            *(u32x2*)(hb + off) = w;
            s += (v[i][0] * v[i][0] + v[i][1] * v[i][1]) + (v[i][2] * v[i][2] + v[i][3] * v[i][3]);
            mx = fmaxf(fmaxf(mx, fmaxf(__builtin_fabsf(v[i][0]), __builtin_fabsf(v[i][1]))), fmaxf(__builtin_fabsf(v[i][2]), __builtin_fabsf(v[i][3])));
        }
        s = wave_sum(s);
#pragma unroll
        for (int o = 32; o >= 1; o >>= 1) mx = fmaxf(mx, __shfl_xor(mx, o));
        const float qs = mx > 0.f ? 127.0f / mx : 0.f;
#pragma unroll
        for (int i = 0; i < 8; ++i) *(unsigned*)(h8 + (size_t)row * DM + (i * 64 + lane) * 4) = pk4_i8(v[i][0] * qs, v[i][1] * qs, v[i][2] * qs, v[i][3] * qs);
        if (lane < 32) part[(size_t)row * 32 + lane] = (lane == 0) ? s : 0.f;
        const float rstd = rsqrtf(s * (1.0f / DM) + RMS_EPS);
        if (lane == 0) { C.at<float>(WS_RSTD)[row] = rstd; C.at<float>(WS_RSA)[row] = rstd * (mx * (1.0f / 127.0f)); C.at<unsigned>(WS_AMAX)[row] = 0u; C.at<unsigned>(WS_AMAX2)[row] = 0u; }
    }
    const int* pos = (const int*)C.in[1]; float* rc = C.at<float>(WS_ROPEC); float* rs = C.at<float>(WS_ROPES);
    for (int i = C.wg * NTHREADS + tid; i < MTOK * 32; i += C.G * NTHREADS) {
        const int m = i >> 5, j = i & 31;
        const float inv = 1.0f / powf(10000.0f, (float)(2 * j) * (1.0f / 64.0f));
        const float ang = (float)pos[m] * inv;
        const double ad = (double)ang; const double n = rint(ad * 0.15915494309189535); const float red = (float)(ad - n * 6.283185307179586);
        rc[i] = cosf(red); rs[i] = sinf(red);
    }
}

__device__ __forceinline__ void rstd_pass(const Ctx& C) {
    const int tid = opaque_tid();
    const float* part = C.at<float>(WS_PARTH); float* rstd = C.at<float>(WS_RSTD);
    for (int row = C.wg * 128 + (tid >> 2); row < MTOK; row += C.G * 128) {
        const float* p = part + (size_t)row * 32 + (tid & 3) * 8;
        const f32x4 a = *(const f32x4*)p, b = *(const f32x4*)(p + 4);
        float sm = ((a[0] + a[1]) + (a[2] + a[3])) + ((b[0] + b[1]) + (b[2] + b[3]));
        sm += dpp_mov<0xB1>(sm); sm += dpp_mov<0x4E>(sm);
        if ((tid & 3) == 0) rstd[row] = rsqrtf(sm * (1.0f / DM) + RMS_EPS);
    }
}

__device__ __forceinline__ void quant_pass(const Ctx& C) {
    const int tid = opaque_tid(), lane = tid & 63, wv = tid >> 6;
    const bf16_t* hb = C.at<bf16_t>(WS_HB); unsigned char* h8 = C.at<unsigned char>(WS_H8); float* rsa = C.at<float>(WS_RSA);
    for (int row0 = (C.wg * 8 + wv) * 2; row0 < MTOK; row0 += C.G * 16) {
        u32x4 w[2][4];
#pragma unroll
        for (int r = 0; r < 2; ++r)
#pragma unroll
            for (int i = 0; i < 4; ++i) w[r][i] = *(const u32x4*)(hb + (size_t)(row0 + r) * DM + (i * 64 + lane) * 8);
#pragma unroll
        for (int r = 0; r < 2; ++r) {
            float v[4][8]; float s = 0.f, mx = 0.f;
#pragma unroll
            for (int i = 0; i < 4; ++i) {
                v[i][0] = __uint_as_float(w[r][i].x << 16); v[i][1] = __uint_as_float(w[r][i].x & 0xffff0000u); v[i][2] = __uint_as_float(w[r][i].y << 16); v[i][3] = __uint_as_float(w[r][i].y & 0xffff0000u);
                v[i][4] = __uint_as_float(w[r][i].z << 16); v[i][5] = __uint_as_float(w[r][i].z & 0xffff0000u); v[i][6] = __uint_as_float(w[r][i].w << 16); v[i][7] = __uint_as_float(w[r][i].w & 0xffff0000u);
#pragma unroll
                for (int e = 0; e < 8; ++e) { s += v[i][e] * v[i][e]; mx = fmaxf(mx, __builtin_fabsf(v[i][e])); }
            }
            s = wave_sum_fast(s);
#pragma unroll
            for (int o = 32; o >= 1; o >>= 1) mx = fmaxf(mx, __shfl_xor(mx, o));
            const float qs = mx > 0.f ? 127.0f / mx : 0.f;
#pragma unroll
            for (int i = 0; i < 4; ++i) { u32x2 q; q.x = pk4_i8(v[i][0] * qs, v[i][1] * qs, v[i][2] * qs, v[i][3] * qs); q.y = pk4_i8(v[i][4] * qs, v[i][5] * qs, v[i][6] * qs, v[i][7] * qs);
                *(u32x2*)(h8 + (size_t)(row0 + r) * DM + (i * 64 + lane) * 8) = q; }
            if (lane == 0) rsa[row0 + r] = rsqrtf(s * (1.0f / DM) + RMS_EPS) * (mx * (1.0f / 127.0f));
        }
    }
}

__device__ __forceinline__ void actq_pass(const Ctx& C, size_t amax_off, size_t amax_other, const float* wmax) {
    const int tid = opaque_tid(), lane = tid & 63, wv = tid >> 6, pc = lane & 3;
    const bf16_t* act = C.at<bf16_t>(WS_ACT); unsigned char* a8 = C.at<unsigned char>(WS_ACT8);
    for (int item = C.wg; item < (MTOK / 256) * 2; item += C.G) {
        const int pm = item >> 1, hk = item & 1;
        int rr[2]; float qs[2];
#pragma unroll
        for (int sg = 0; sg < 2; ++sg) {
            rr[sg] = wv * 32 + sg * 16 + (lane >> 2); const int row = pm * 256 + rr[sg];
            const float mx = __uint_as_float(C.at<unsigned>(amax_off)[row]);
            qs[sg] = mx > 0.f ? 127.0f / mx : 0.f;
            if (hk == 0 && pc == 0) {
                const float rs = C.at<float>(WS_RSA)[row] * (*wmax * (1.0f / 127.0f));
                C.at<float>(WS_ASC)[row] = mx * (1.0f / 127.0f) * (rs * rs * 0.35355339059327373f); C.at<unsigned>(amax_other)[row] = 0u; }
        }
#pragma nounroll
        for (int kt0 = hk * (DFF / 128); kt0 < (hk + 1) * (DFF / 128); kt0 += 4) {
            u32x4 w[4][2][2];
#pragma unroll
            for (int t = 0; t < 4; ++t)
#pragma unroll
                for (int jh = 0; jh < 2; ++jh)
#pragma unroll
                    for (int sg = 0; sg < 2; ++sg) w[t][jh][sg] = __builtin_nontemporal_load((const u32x4*)(act + ((((size_t)pm * (DFF / 64) + kt0 + t) * 2 + jh) * 256 + rr[sg]) * 32 + pc * 8));
#pragma unroll
            for (int t = 0; t < 4; ++t) {
                const int kt = kt0 + t;
                unsigned char* blk = a8 + (((size_t)pm * (DFF / 128) + (kt >> 1)) * 2 + (kt & 1)) * (256 * 64);
#pragma unroll
                for (int sg = 0; sg < 2; ++sg)
#pragma unroll
                    for (int jh = 0; jh < 2; ++jh) {
                        const u32x4 x = w[t][jh][sg]; const float q = qs[sg];
                        u32x2 o;
                        o.x = pk4_i8(__uint_as_float(x.x << 16) * q, __uint_as_float(x.x & 0xffff0000u) * q, __uint_as_float(x.y << 16) * q, __uint_as_float(x.y & 0xffff0000u) * q);
                        o.y = pk4_i8(__uint_as_float(x.z << 16) * q, __uint_as_float(x.z & 0xffff0000u) * q, __uint_as_float(x.w << 16) * q, __uint_as_float(x.w & 0xffff0000u) * q);
                        *(u32x2*)(blk + rr[sg] * 64 + jh * 32 + pc * 8) = o;
                    }
            }
        }
    }
}

__device__ __forceinline__ void prep_phase(const Ctx& C, int l) {
    const int tid = opaque_tid(), lane = tid & 63, wv = __builtin_amdgcn_readfirstlane(tid >> 6);
    const bf16_t* P = C.at<bf16_t>(WS_P);
    LAS bf16_t* Lin = (LAS bf16_t*)C.lds;
    LAS float* Lout = (LAS float*)(C.lds + 8192);
    const float* mu = C.fin(13) + l * 1696;
    const int c = tid;
    const float w0 = C.fin(14)[l * BW + c], a0 = C.fin(16)[l * BW + c], kkc = C.fin(19)[l * BW + c], kac = C.fin(20)[l * BW + c];
    const float mur = mu[c], muk = mu[512 + c], muv = mu[1024 + c];
    const float rkc = C.fin(21)[l * BW + c];
    const float cw0 = C.fin(24)[l * 1536 + c], cw1 = C.fin(24)[l * 1536 + 512 + c], cw2 = C.fin(24)[l * 1536 + 1024 + c], gn = C.fin(25)[l * BW + c];
    const int n = lane & 15, kg = lane >> 4;
#pragma nounroll
    for (int item = C.wg; item < MTOK / 16; item += C.G) {
        const int tid = opaque_tid(), lane = tid & 63, c = tid, n = lane & 15, kg = lane >> 4;
        const int b = item >> 7, t0 = (item & 127) * 16;
        const size_t m0 = (size_t)b * SEQ + t0;
        bf16x8 bfr[4][5];
        {
            const bf16_t* Ub = C.at<bf16_t>(WS_LORA) + (size_t)(wv * 64 + n) * 160 + kg * 8;
#pragma unroll
            for (int nt = 0; nt < 4; ++nt)
#pragma unroll
                for (int ks = 0; ks < 5; ++ks) bfr[nt][ks] = *(const bf16x8*)(Ub + nt * 16 * 160 + ks * 32);
        }
        for (int e = tid; e < 2560; e += NTHREADS) {
            const int tt = e / 160, j = e - tt * 160, col = 2368 + j;
            const float cur = bf2f(P[(m0 + tt) * NINP + col]);
            const float prev = (t0 + tt > 0) ? bf2f(P[(m0 + tt - 1) * NINP + col]) : 0.f;
            float xs = cur + (prev - cur) * mu[1536 + j];
            if (j < 32) xs = tanhf(xs); else if (j >= 64) xs = sigmoid_fast(xs);
            Lin[tt * 168 + j] = f2bf(xs);
        }
        __syncthreads();
        {
            bf16x8 af[5];
#pragma unroll
            for (int ks = 0; ks < 5; ++ks) af[ks] = *(const LAS bf16x8*)(Lin + n * 168 + ks * 32 + kg * 8);
#pragma unroll
            for (int nt = 0; nt < 4; ++nt) {
                const f32x4 z = {0.f, 0.f, 0.f, 0.f};
                const f32x4 cw = __builtin_amdgcn_mfma_f32_16x16x32_bf16(af[0], bfr[nt][0], z, 0, 0, 0);
                const f32x4 ca = __builtin_amdgcn_mfma_f32_16x16x32_bf16(af[1], bfr[nt][1], z, 0, 0, 0);
                f32x4 cg = __builtin_amdgcn_mfma_f32_16x16x32_bf16(af[2], bfr[nt][2], z, 0, 0, 0);
                cg = __builtin_amdgcn_mfma_f32_16x16x32_bf16(af[3], bfr[nt][3], cg, 0, 0, 0);
                cg = __builtin_amdgcn_mfma_f32_16x16x32_bf16(af[4], bfr[nt][4], cg, 0, 0, 0);
                const int ch = wv * 64 + nt * 16 + n;
#pragma unroll
                for (int j = 0; j < 4; ++j) { const int tok = kg * 4 + j;
                    Lout[tok * 512 + ch] = cw[j]; Lout[8192 + tok * 512 + ch] = ca[j]; Lout[16384 + tok * 512 + ch] = cg[j]; }
            }
        }
        __syncthreads();
        unsigned tA[8], tB[8], tK[8], tR[8], tV[8]; float PCv;
        {
            float pr = 0.f, pk = 0.f, pv = 0.f, um2 = 0.f, um1 = 0.f;
            if (t0 > 0) { const bf16_t* pp = P + (m0 - 1) * NINP + c; pr = bf2f(pp[PB0]); pk = bf2f(pp[PB0 + 512]); pv = bf2f(pp[PB0 + 1024]);
                um1 = bf2f(pp[PC0 + 512]) * bf2f(pp[PC0 + 1024]); const bf16_t* p2 = pp - NINP; um2 = bf2f(p2[PC0 + 512]) * bf2f(p2[PC0 + 1024]); }
            bf16_t* Gp = C.at<bf16_t>(WS_G) + m0 * BW + c;
            bf16_t* Bvp = C.at<bf16_t>(WS_BV) + m0 * BW + c;
            bf16_t* Y = C.at<bf16_t>(WS_Y) + m0 * DM + 1536 + c;
            float Pc = 1.0f;
            float sA[2], sB[2], sK[2], sR[2], sV[2];
#pragma unroll
            for (int hb8 = 0; hb8 < 2; ++hb8) {
                bf16_t raw[8][6];
#pragma unroll
                for (int i = 0; i < 8; ++i) { const bf16_t* pp = P + (m0 + hb8 * 8 + i) * NINP + c;
                    raw[i][0] = pp[PB0]; raw[i][1] = pp[PB0 + 512]; raw[i][2] = pp[PB0 + 1024]; raw[i][3] = pp[PC0]; raw[i][4] = pp[PC0 + 512]; raw[i][5] = pp[PC0 + 1024]; }
#pragma unroll
                for (int i = 0; i < 8; ++i) {
                    const int tt = hb8 * 8 + i;
                    const float cr = bf2f(raw[i][0]), ck = bf2f(raw[i][1]), cv = bf2f(raw[i][2]);
                    const float r = cr + (pr - cr) * mur, k = ck + (pk - ck) * muk, v = cv + (pv - cv) * muv;
                    pr = cr; pk = ck; pv = cv;
                    const float decay = __builtin_amdgcn_exp2f(-0.6065306597126334f * 1.4426950408889634f * sigmoid_fast(w0 + Lout[tt * 512 + c]));
                    const float a = sigmoid_fast(a0 + Lout[8192 + tt * 512 + c]);
                    float kk = k * kkc;
                    const float ss = wave_sum_fast(kk * kk);
                    kk = kk * __builtin_amdgcn_rsqf(fmaxf(ss, 1e-24f));
                    const float kmod = k * (1.0f + (a - 1.0f) * kac);
                    const float bonus = wave_sum_fast(r * kmod * rkc);
                    Bvp[(size_t)tt * BW] = f2bf(bonus * v);
                    Gp[(size_t)tt * BW] = f2bf(Lout[16384 + tt * 512 + c]);
                    const float Pprev = Pc; Pc = Pc * decay; const float invP = __builtin_amdgcn_rcpf(Pc);
                    sA[i & 1] = -kk * Pprev; sB[i & 1] = kk * a * invP; sK[i & 1] = kmod * invP; sR[i & 1] = r * Pc; sV[i & 1] = v;
                    if (i & 1) { tA[tt >> 1] = cvt_pk_bf16(sA[0], sA[1]); tB[tt >> 1] = cvt_pk_bf16(sB[0], sB[1]); tK[tt >> 1] = cvt_pk_bf16(sK[0], sK[1]); tR[tt >> 1] = cvt_pk_bf16(sR[0], sR[1]); tV[tt >> 1] = cvt_pk_bf16(sV[0], sV[1]); }
                    const float bg = bf2f(raw[i][3]), u = bf2f(raw[i][4]) * bf2f(raw[i][5]);
                    const float yv = cw0 * um2 + cw1 * um1 + cw2 * u;
                    um2 = um1; um1 = u;
                    const float z = bg * yv;
                    const float s2 = wave_sum_fast(z * z);
                    Y[(size_t)tt * DM] = f2bf(z * __builtin_amdgcn_rsqf(s2 * (1.0f / 64.0f) + RMS_EPS) * gn);
                }
            }
            PCv = Pc;
        }
        {
            const int tt = tid >> 5, i = tid & 31; const size_t m = m0 + tt;
            const unsigned pr2 = *(const unsigned*)(P + m * NINP + 768 + 2 * i);
            const float x1 = __uint_as_float(pr2 << 16), x2 = __uint_as_float(pr2 & 0xffff0000u);
            const float cs = C.at<float>(WS_ROPEC)[m * 32 + i], sn = C.at<float>(WS_ROPES)[m * 32 + i];
            *(unsigned*)(C.at<bf16_t>(WS_KR) + m * 64 + 2 * i) = cvt_pk_bf16(x1 * cs - x2 * sn, x1 * sn + x2 * cs);
        }
        __syncthreads();
        {
            LAS unsigned char* HB = C.lds + 8192 + wv * 16384;
            LAS bf16_t* tl = (LAS bf16_t*)HB;
            LAS float* mats = (LAS float*)(HB + 8192);
#pragma unroll
            for (int p2 = 0; p2 < 8; ++p2) {
                tl[(2 * p2) * 64 + lane] = (bf16_t)(tA[p2] & 0xffffu); tl[(2 * p2 + 1) * 64 + lane] = (bf16_t)(tA[p2] >> 16);
                tl[1024 + (2 * p2) * 64 + lane] = (bf16_t)(tB[p2] & 0xffffu); tl[1024 + (2 * p2 + 1) * 64 + lane] = (bf16_t)(tB[p2] >> 16);
                tl[2048 + (2 * p2) * 64 + lane] = (bf16_t)(tK[p2] & 0xffffu); tl[2048 + (2 * p2 + 1) * 64 + lane] = (bf16_t)(tK[p2] >> 16);
                tl[3072 + (2 * p2) * 64 + lane] = (bf16_t)(tR[p2] & 0xffffu); tl[3072 + (2 * p2 + 1) * 64 + lane] = (bf16_t)(tR[p2] >> 16);
            }
            {
                bf16x8 fa[2], fb[2], fk[2], fr[2];
#pragma unroll
                for (int ks = 0; ks < 2; ++ks) { const int o = n * 64 + ks * 32 + kg * 8;
                    fa[ks] = *(const LAS bf16x8*)(tl + o); fb[ks] = *(const LAS bf16x8*)(tl + 1024 + o); fk[ks] = *(const LAS bf16x8*)(tl + 2048 + o); fr[ks] = *(const LAS bf16x8*)(tl + 3072 + o); }
                const f32x4 z = {0.f, 0.f, 0.f, 0.f};
                f32x4 gN = __builtin_amdgcn_mfma_f32_16x16x32_bf16(fb[0], fa[0], z, 0, 0, 0); gN = __builtin_amdgcn_mfma_f32_16x16x32_bf16(fb[1], fa[1], gN, 0, 0, 0);
                f32x4 gM = __builtin_amdgcn_mfma_f32_16x16x32_bf16(fk[0], fa[0], z, 0, 0, 0); gM = __builtin_amdgcn_mfma_f32_16x16x32_bf16(fk[1], fa[1], gM, 0, 0, 0);
                f32x4 gB = __builtin_amdgcn_mfma_f32_16x16x32_bf16(fb[0], fr[0], z, 0, 0, 0); gB = __builtin_amdgcn_mfma_f32_16x16x32_bf16(fb[1], fr[1], gB, 0, 0, 0);
                f32x4 gK = __builtin_amdgcn_mfma_f32_16x16x32_bf16(fk[0], fr[0], z, 0, 0, 0); gK = __builtin_amdgcn_mfma_f32_16x16x32_bf16(fk[1], fr[1], gK, 0, 0, 0);
#pragma unroll
                for (int j = 0; j < 4; ++j) { const int i = 4 * kg + j; if (!(i < n)) { gN[j] = 0.f; gM[j] = 0.f; } if (!(i <= n)) { gB[j] = 0.f; gK[j] = 0.f; } }
                *(LAS f32x4*)(mats + n * 16 + 4 * kg) = gN; *(LAS f32x4*)(mats + 256 + n * 16 + 4 * kg) = gM;
                *(LAS f32x4*)(mats + 512 + n * 16 + 4 * kg) = gB; *(LAS f32x4*)(mats + 768 + n * 16 + 4 * kg) = gK;
            }
            float Tr[16], TEr[16];
#pragma unroll
            for (int t = 0; t < 16; ++t) {
                float nr[16];
#pragma unroll
                for (int q4 = 0; q4 < 4; ++q4) { const f32x4 x = *(const LAS f32x4*)(mats + t * 16 + 4 * q4); nr[4 * q4] = x[0]; nr[4 * q4 + 1] = x[1]; nr[4 * q4 + 2] = x[2]; nr[4 * q4 + 3] = x[3]; }
                float acc = (n == t) ? 1.0f : 0.0f;
#pragma unroll
                for (int s2 = 0; s2 < t; ++s2) acc += Tr[s2] * nr[s2];
                Tr[t] = acc;
                asm volatile("" ::: "memory");
            }
#pragma unroll
            for (int t = 0; t < 16; ++t) {
                float er[16];
#pragma unroll
                for (int q4 = 0; q4 < 4; ++q4) { const f32x4 x = *(const LAS f32x4*)(mats + 512 + t * 16 + 4 * q4); er[4 * q4] = x[0]; er[4 * q4 + 1] = x[1]; er[4 * q4 + 2] = x[2]; er[4 * q4 + 3] = x[3]; }
                float acc = 0.f;
#pragma unroll
                for (int s2 = 0; s2 <= t; ++s2) acc += Tr[s2] * er[s2];
                TEr[t] = acc;
                asm volatile("" ::: "memory");
            }
            LAS float* Tt = mats + 1024; LAS float* TEt = mats + 1280;
#pragma unroll
            for (int t = 0; t < 16; ++t) { Tt[t * 16 + n] = Tr[t]; TEt[t * 16 + n] = TEr[t]; }
            float Mr[16];
#pragma unroll
            for (int s2 = 0; s2 < 16; ++s2) Mr[s2] = mats[256 + s2 * 16 + n];
            unsigned char* CBg = C.ws + WS_SCAN + ((size_t)(b * 8 + wv) * (SEQ / 16) + (t0 >> 4)) * CB_BYTES;
            bf16_t* WAg = (bf16_t*)(CBg + CB_WA); bf16_t* QAg = (bf16_t*)(CBg + CB_QA); bf16_t* MTg = (bf16_t*)(CBg + CB_MT); bf16_t* Q2g = (bf16_t*)(CBg + CB_Q2);
            const int wks = lane >> 5, wq = (lane >> 2) & 3, we = 4 * ((lane >> 4) & 1) + (lane & 3);
#pragma unroll
            for (int t = 0; t < 16; ++t) {
                float trw[16], tew[16];
#pragma unroll
                for (int q4 = 0; q4 < 4; ++q4) { const f32x4 x = *(const LAS f32x4*)(Tt + t * 16 + 4 * q4), y = *(const LAS f32x4*)(TEt + t * 16 + 4 * q4);
                    trw[4 * q4] = x[0]; trw[4 * q4 + 1] = x[1]; trw[4 * q4 + 2] = x[2]; trw[4 * q4 + 3] = x[3]; tew[4 * q4] = y[0]; tew[4 * q4 + 1] = y[1]; tew[4 * q4 + 2] = y[2]; tew[4 * q4 + 3] = y[3]; }
                float w1 = 0.f, q1 = (t & 1) ? __uint_as_float(tR[t >> 1] & 0xffff0000u) : __uint_as_float(tR[t >> 1] << 16), mtv = 0.f, q2v = mats[768 + t * 16 + n];
#pragma unroll
                for (int s2 = 0; s2 <= t; ++s2) { const float as = (s2 & 1) ? __uint_as_float(tA[s2 >> 1] & 0xffff0000u) : __uint_as_float(tA[s2 >> 1] << 16);
                    w1 += as * trw[s2]; q1 += as * tew[s2]; mtv += Mr[s2] * trw[s2]; q2v += Mr[s2] * tew[s2]; }
                const int wi = ((wks * 16 + t) * 4 + wq) * 8 + we;
                WAg[wi] = f2bf(w1); QAg[wi] = f2bf(q1);
                if (lane < 16) { MTg[t * 16 + lane] = f2bf(mtv); Q2g[t * 16 + lane] = f2bf(q2v); }
                asm volatile("" ::: "memory");
            }
            {
                u32x4* BKg = (u32x4*)(CBg + CB_BK + lane * 64);
#pragma unroll
                for (int g4 = 0; g4 < 4; ++g4) {
                    const float b0 = __uint_as_float(tB[2 * g4] << 16) * PCv, b1 = __uint_as_float(tB[2 * g4] & 0xffff0000u) * PCv, b2 = __uint_as_float(tB[2 * g4 + 1] << 16) * PCv, b3 = __uint_as_float(tB[2 * g4 + 1] & 0xffff0000u) * PCv;
                    const float k0 = __uint_as_float(tK[2 * g4] << 16) * PCv, k1 = __uint_as_float(tK[2 * g4] & 0xffff0000u) * PCv, k2 = __uint_as_float(tK[2 * g4 + 1] << 16) * PCv, k3 = __uint_as_float(tK[2 * g4 + 1] & 0xffff0000u) * PCv;
                    u32x4 w; w.x = cvt_pk_bf16(b0, b1); w.y = cvt_pk_bf16(b2, b3); w.z = cvt_pk_bf16(k0, k1); w.w = cvt_pk_bf16(k2, k3);
                    BKg[g4] = w;
                }
                ((float*)(CBg + CB_PC))[lane] = PCv;
                u32x4* VTg = (u32x4*)(CBg + CB_VT + lane * 32);
                VTg[0] = (u32x4){tV[0], tV[1], tV[2], tV[3]}; VTg[1] = (u32x4){tV[4], tV[5], tV[6], tV[7]};
            }
        }
        __syncthreads();
    }
}

constexpr int SC_GRP = 2, SC_STG = SC_GRP * CB_BYTES;
constexpr int SC_YB = SC_GRP * 16 * 64;
struct ScanPostConst { f32x4 gain0, gain1, bias0, bias1; };
struct ScanPostIn { u32x4 bw, gw; };
__device__ __forceinline__ ScanPostIn scan_post_load(const bf16_t* Bvp, const bf16_t* Gp, size_t tok0, int tl0, int lane) {
    const int tl = tl0 + (lane >> 3), q = lane & 7; const size_t tok = tok0 + tl; ScanPostIn r;
    r.bw = *(const u32x4*)(Bvp + tok * BW + q * 8); r.gw = *(const u32x4*)(Gp + tok * BW + q * 8);
    return r;
}
__device__ __forceinline__ f32x4 bf4_lo(const u32x4& w) { return (f32x4){__uint_as_float(w.x << 16), __uint_as_float(w.x & 0xffff0000u), __uint_as_float(w.y << 16), __uint_as_float(w.y & 0xffff0000u)}; }
__device__ __forceinline__ f32x4 bf4_hi(const u32x4& w) { return (f32x4){__uint_as_float(w.z << 16), __uint_as_float(w.z & 0xffff0000u), __uint_as_float(w.w << 16), __uint_as_float(w.w & 0xffff0000u)}; }
__device__ __forceinline__ void scan_post(LAS float* yb, const ScanPostIn& I, bf16_t* Yp, size_t tok0, int tl0, int lane, const ScanPostConst& K) {
    const int tl = tl0 + (lane >> 3), q = lane & 7; const size_t tok = tok0 + tl;
    const f32x4 y0 = *(const LAS f32x4*)(yb + tl * 64 + q * 8), y1 = *(const LAS f32x4*)(yb + tl * 64 + q * 8 + 4);
    const f32x4 ys = y0 + y1;
    const float mean = red8((ys[0] + ys[1]) + (ys[2] + ys[3])) * (1.0f / 64.0f);
    const f32x4 d0 = y0 - mean, d1 = y1 - mean;
    const f32x4 dq = d0 * d0 + d1 * d1;
    const float var = red8((dq[0] + dq[1]) + (dq[2] + dq[3])) * (1.0f / 64.0f);
    const float rstd = __builtin_amdgcn_rsqf(var + 64e-5f);
    const f32x4 o0 = (d0 * rstd * K.gain0 + K.bias0 + bf4_lo(I.bw)) * bf4_lo(I.gw), o1 = (d1 * rstd * K.gain1 + K.bias1 + bf4_hi(I.bw)) * bf4_hi(I.gw);
    u32x4 w; w.x = cvt_pk_bf16(o0[0], o0[1]); w.y = cvt_pk_bf16(o0[2], o0[3]); w.z = cvt_pk_bf16(o1[0], o1[1]); w.w = cvt_pk_bf16(o1[2], o1[3]);
    *(u32x4*)(Yp + tok * DM + q * 8) = w;
}
__device__ __forceinline__ void scan_unit(const Ctx& C, int l, int bh) {
    const int tid = opaque_tid(), lane = tid & 63, wv = __builtin_amdgcn_readfirstlane(tid >> 6);
    LAS unsigned char* stg = C.lds;
    LAS float* ybuf = (LAS float*)(C.lds + 2 * SC_STG);
    const unsigned char* src = C.ws + WS_SCAN + (size_t)bh * (SEQ / 16) * CB_BYTES;
    const int b = bh >> 3, h = bh & 7;
    constexpr int NGRP = SEQ / 16 / SC_GRP;
    for (int i = tid; i < SC_STG / 16; i += NTHREADS) *(LAS u32x4*)(stg + i * 16) = *(const u32x4*)(src + (size_t)i * 16);
    __syncthreads();
    if (wv < 4) {
        const int vq = lane & 15, q = lane >> 4;
        f32x4 S[4];
#pragma unroll
        for (int m = 0; m < 4; ++m) S[m] = (f32x4){0.f, 0.f, 0.f, 0.f};
        const bf16x8 zf = {0, 0, 0, 0, 0, 0, 0, 0};
#pragma nounroll
        for (int g = 0; g < NGRP; ++g) {
            LAS unsigned char* sb = stg + (g & 1) * SC_STG;
            LAS float* yb = ybuf + (g & 1) * SC_YB;
#pragma unroll
            for (int cc = 0; cc < SC_GRP; ++cc) {
                LAS unsigned char* cb = sb + cc * CB_BYTES;
                const bf16x8 wa0 = *(const LAS bf16x8*)(cb + CB_WA + ((0 * 16 + vq) * 4 + q) * 16), wa1 = *(const LAS bf16x8*)(cb + CB_WA + ((1 * 16 + vq) * 4 + q) * 16);
                const bf16x8 qa0 = *(const LAS bf16x8*)(cb + CB_QA + ((0 * 16 + vq) * 4 + q) * 16), qa1 = *(const LAS bf16x8*)(cb + CB_QA + ((1 * 16 + vq) * 4 + q) * 16);
                const int qc = q & 1;
                bf16x8 mtf = *(const LAS bf16x8*)(cb + CB_MT + vq * 32 + qc * 16), q2f = *(const LAS bf16x8*)(cb + CB_Q2 + vq * 32 + qc * 16);
                bf16x8 bvf = *(const LAS bf16x8*)(cb + CB_VT + (16 * wv + vq) * 32 + qc * 16);
                if (q >= 2) { mtf = zf; q2f = zf; bvf = zf; }
                const u32x2 vpart = *(const LAS u32x2*)(cb + CB_VT + (16 * wv + vq) * 32 + q * 8);
                bf16x8 bk[4]; f32x4 pc[4];
#pragma unroll
                for (int m = 0; m < 4; ++m) { bk[m] = *(const LAS bf16x8*)(cb + CB_BK + ((16 * m + vq) * 4 + q) * 16); pc[m] = *(const LAS f32x4*)(cb + CB_PC + (16 * m + 4 * q) * 4); }
                bf16x8 bh[2], bl[2];
#pragma unroll
                for (int ks = 0; ks < 2; ++ks) {
                    const f32x4 s0 = S[2 * ks], s1 = S[2 * ks + 1];
                    u32x4 hp; hp.x = cvt_pk_bf16(s0[0], s0[1]); hp.y = cvt_pk_bf16(s0[2], s0[3]); hp.z = cvt_pk_bf16(s1[0], s1[1]); hp.w = cvt_pk_bf16(s1[2], s1[3]);
                    const float l0 = s0[0] - __uint_as_float(hp.x << 16), l1 = s0[1] - __uint_as_float(hp.x & 0xffff0000u), l2 = s0[2] - __uint_as_float(hp.y << 16), l3 = s0[3] - __uint_as_float(hp.y & 0xffff0000u);
                    const float l4 = s1[0] - __uint_as_float(hp.z << 16), l5 = s1[1] - __uint_as_float(hp.z & 0xffff0000u), l6 = s1[2] - __uint_as_float(hp.w << 16), l7 = s1[3] - __uint_as_float(hp.w & 0xffff0000u);
                    u32x4 lp; lp.x = cvt_pk_bf16(l0, l1); lp.y = cvt_pk_bf16(l2, l3); lp.z = cvt_pk_bf16(l4, l5); lp.w = cvt_pk_bf16(l6, l7);
                    bh[ks] = __builtin_bit_cast(bf16x8, hp); bl[ks] = __builtin_bit_cast(bf16x8, lp);
                }
                const f32x4 z = {0.f, 0.f, 0.f, 0.f};
                f32x4 U = __builtin_amdgcn_mfma_f32_16x16x32_bf16(mtf, bvf, z, 0, 0, 0);
                U = __builtin_amdgcn_mfma_f32_16x16x32_bf16(wa0, bl[0], U, 0, 0, 0); U = __builtin_amdgcn_mfma_f32_16x16x32_bf16(wa1, bl[1], U, 0, 0, 0);
                U = __builtin_amdgcn_mfma_f32_16x16x32_bf16(wa0, bh[0], U, 0, 0, 0); U = __builtin_amdgcn_mfma_f32_16x16x32_bf16(wa1, bh[1], U, 0, 0, 0);
                f32x4 Yt = __builtin_amdgcn_mfma_f32_16x16x32_bf16(q2f, bvf, z, 0, 0, 0);
                Yt = __builtin_amdgcn_mfma_f32_16x16x32_bf16(qa0, bl[0], Yt, 0, 0, 0); Yt = __builtin_amdgcn_mfma_f32_16x16x32_bf16(qa1, bl[1], Yt, 0, 0, 0);
                Yt = __builtin_amdgcn_mfma_f32_16x16x32_bf16(qa0, bh[0], Yt, 0, 0, 0); Yt = __builtin_amdgcn_mfma_f32_16x16x32_bf16(qa1, bh[1], Yt, 0, 0, 0);
                u32x4 up; up.x = cvt_pk_bf16(U[0], U[1]); up.y = cvt_pk_bf16(U[2], U[3]); up.z = vpart.x; up.w = vpart.y;
                const bf16x8 bu = __builtin_bit_cast(bf16x8, up);
#pragma unroll
                for (int m = 0; m < 4; ++m) S[m] = __builtin_amdgcn_mfma_f32_16x16x32_bf16(bk[m], bu, S[m] * pc[m], 0, 0, 0);
#pragma unroll
                for (int j = 0; j < 4; ++j) yb[(cc * 16 + 4 * q + j) * 64 + 16 * wv + vq] = Yt[j];
            }
            __syncthreads();
        }
    } else {
        const int hw = wv - 4, ht = tid - 256;
        ScanPostConst PC;
        { const int o = l * BW + h * 64 + (lane & 7) * 8;
          PC.gain0 = *(const f32x4*)(C.fin(22) + o); PC.gain1 = *(const f32x4*)(C.fin(22) + o + 4); PC.bias0 = *(const f32x4*)(C.fin(23) + o); PC.bias1 = *(const f32x4*)(C.fin(23) + o + 4); }
        const bf16_t* Gp = C.at<bf16_t>(WS_G) + (size_t)b * SEQ * BW + h * 64;
        const bf16_t* Bvp = C.at<bf16_t>(WS_BV) + (size_t)b * SEQ * BW + h * 64;
        bf16_t* Yp = C.at<bf16_t>(WS_Y) + (size_t)b * SEQ * DM + 1024 + h * 64;
        constexpr int NL = (SC_STG / 16 + 255) / 256;
        u32x4 tmp[4][NL]; ScanPostIn pin[4];
#define SCH_LOAD(gg, set) do { if ((gg) < NGRP) { const unsigned char* s2_ = src + (size_t)(gg) * SC_STG; \
            _Pragma("unroll") for (int i = 0; i < NL; ++i) { const int o_ = (ht + 256 * i) * 16; if (o_ < SC_STG) tmp[set][i] = *(const u32x4*)(s2_ + o_); } } } while (0)
#define SCH_STORE(gg, set) do { if ((gg) < NGRP) { LAS unsigned char* d2_ = stg + ((gg) & 1) * SC_STG; \
            _Pragma("unroll") for (int i = 0; i < NL; ++i) { const int o_ = (ht + 256 * i) * 16; if (o_ < SC_STG) *(LAS u32x4*)(d2_ + o_) = tmp[set][i]; } } } while (0)
#define SCH_PLOAD(gg, set) do { if ((gg) < NGRP) pin[set] = scan_post_load(Bvp, Gp, (size_t)(gg) * (SC_GRP * 16), hw * 8, lane); } while (0)
#define SCH_POST(gg, set) do { if ((gg) >= 0) scan_post(ybuf + ((gg) & 1) * SC_YB, pin[set], Yp, (size_t)(gg) * (SC_GRP * 16), hw * 8, lane, PC); } while (0)
#define SCH_ITER(g_, k) do { SCH_STORE((g_) + 1, ((k) + 1) & 3); SCH_LOAD((g_) + 4, (k)); SCH_PLOAD((g_) + 2, ((k) + 2) & 3); SCH_POST((g_) - 1, ((k) + 3) & 3); __syncthreads(); } while (0)
        SCH_LOAD(1, 1); SCH_LOAD(2, 2); SCH_LOAD(3, 3); SCH_PLOAD(0, 0); SCH_PLOAD(1, 1);
#pragma nounroll
        for (int g = 0; g < NGRP; g += 4) { SCH_ITER(g, 0); SCH_ITER(g + 1, 1); SCH_ITER(g + 2, 2); SCH_ITER(g + 3, 3); }
        SCH_POST(NGRP - 1, (NGRP - 1) & 3);
#undef SCH_LOAD
#undef SCH_STORE
#undef SCH_PLOAD
#undef SCH_POST
#undef SCH_ITER
    }
    __syncthreads();
}

constexpr int KSTR = 400, VSTR = 320;
constexpr int KBUF = 64 * KSTR, VBUF = 64 * VSTR;
constexpr int ASTG = KBUF + VBUF;
struct AttnDma { unsigned off[6]; unsigned strd[6]; };
__device__ __forceinline__ void attn_dma_init(AttnDma& D, size_t tk, int h, int w, int lane) {
#pragma unroll
    for (int i = 0; i < 6; ++i) {
        const int wi = w + 8 * i, ci = wi * 64 + lane; size_t off; unsigned st = 64u * NKV * 2u;
        if (ci < 1600) { const int r = ci / 25, ch = ci - r * 25;
            if (ch < 16) off = ((tk + r) * NKV + h * 256 + ch * 8) * 2;
            else if (ch < 24) { off = (size_t)MTOK * NKV * 2 + ((tk + r) * 64 + (ch - 16) * 8) * 2; st = 64u * 64u * 2u; }
            else off = ((tk + r) * NKV + h * 256) * 2; }
        else { const int cv = ci - 1600, r = cv / 20, ch = cv - r * 20;
            off = ((tk + r) * NKV + h * 256 + 128 + (ch < 16 ? ch : 0) * 8) * 2; }
        D.off[i] = (unsigned)off; D.strd[i] = st;
    }
}
__device__ __forceinline__ void attn_dma_issue(LAS unsigned char* lds, const bf16_t* KV, AttnDma& D, int stg, int w) {
    const char* kvb = (const char*)KV;
#pragma unroll
    for (int i = 0; i < 6; ++i) {
        const int wi = w + 8 * i;
        if (wi < 45) __builtin_amdgcn_global_load_lds((const unsigned*)(kvb + D.off[i]), (LAS unsigned*)(lds + stg * ASTG + wi * 1024), 16, 0, 0);
        D.off[i] += D.strd[i];
    }
}
template <int CUR>
__device__ __forceinline__ void attn_tile(LAS unsigned char* lds, const bf16_t* KV, AttnDma& dma, int j, int ntiles, int mytiles, int w, int hh, int qi, int kaddr, int vaddr,
                                          const bf16x8 (&qf)[12], f32x16 (&o)[4], float& mrun, float& lrun) {
    if (j + 1 < ntiles) attn_dma_issue(lds, KV, dma, CUR ^ 1, w);
    if (j < mytiles) {
        f32x16 sc[2];
#pragma unroll
        for (int kb = 0; kb < 2; ++kb) {
#pragma unroll
            for (int i = 0; i < 16; ++i) sc[kb][i] = 0.f;
#pragma unroll
            for (int s = 0; s < 12; ++s) {
                const bf16x8 a = *(const LAS bf16x8*)(lds + CUR * ASTG + kaddr + kb * 32 * KSTR + s * 32);
                sc[kb] = __builtin_amdgcn_mfma_f32_32x32x16_bf16(a, qf[s], sc[kb], 0, 0, 0);
            }
        }
        if (j == mytiles - 1) {
#pragma unroll
            for (int kb = 0; kb < 2; ++kb)
#pragma unroll
                for (int i = 0; i < 16; ++i) { const int key = j * 64 + kb * 32 + (i & 3) + 8 * (i >> 2) + 4 * hh; if (key > qi) sc[kb][i] = -INFINITY; }
        }
        float mx = sc[0][0];
#pragma unroll
        for (int kb = 0; kb < 2; ++kb)
#pragma unroll
            for (int i = 0; i < 16; ++i) mx = fmaxf(mx, sc[kb][i]);
        mx = fmaxf(mx, __shfl_xor(mx, 32));
        const bool bump = mx > mrun + 8.0f;
        const float mnew = bump ? mx : mrun;
        if (__builtin_amdgcn_ballot_w64(bump) != 0ull) {
            const float alpha = __builtin_amdgcn_exp2f(mrun - mnew);
            lrun *= alpha;
#pragma unroll
            for (int d = 0; d < 4; ++d)
#pragma unroll
                for (int i = 0; i < 16; ++i) o[d][i] *= alpha;
        }
        mrun = mnew;
        f32x2 ps2 = {0.f, 0.f}; const f32x2 mn2 = {mnew, mnew};
#pragma unroll
        for (int kb = 0; kb < 2; ++kb)
#pragma unroll
            for (int i = 0; i < 16; i += 2) { const f32x2 dlt = (f32x2){sc[kb][i], sc[kb][i + 1]} - mn2; f32x2 p; p.x = __builtin_amdgcn_exp2f(dlt.x); p.y = __builtin_amdgcn_exp2f(dlt.y); sc[kb][i] = p.x; sc[kb][i + 1] = p.y; ps2 += p; }
        lrun += ps2.x + ps2.y;
        bf16x8 pfr[4];
#pragma unroll
        for (int g = 0; g < 4; ++g) { const int kb = g >> 1, s2 = g & 1;
            u32x4 pk; pk.x = cvt_pk_bf16(sc[kb][8 * s2 + 0], sc[kb][8 * s2 + 1]); pk.y = cvt_pk_bf16(sc[kb][8 * s2 + 2], sc[kb][8 * s2 + 3]);
            pk.z = cvt_pk_bf16(sc[kb][8 * s2 + 4], sc[kb][8 * s2 + 5]); pk.w = cvt_pk_bf16(sc[kb][8 * s2 + 6], sc[kb][8 * s2 + 7]);
            pfr[g] = __builtin_bit_cast(bf16x8, pk); }
        const unsigned vb = (unsigned)(size_t)(lds + CUR * ASTG) + (unsigned)vaddr;
        s16x4 RA[8], RB[8];
#define ATT_TR8(R, G) asm volatile("ds_read_b64_tr_b16 %0, %8 offset:%9\n\tds_read_b64_tr_b16 %1, %8 offset:%10\n\tds_read_b64_tr_b16 %2, %8 offset:%11\n\tds_read_b64_tr_b16 %3, %8 offset:%12\n\t" \
                                   "ds_read_b64_tr_b16 %4, %8 offset:%13\n\tds_read_b64_tr_b16 %5, %8 offset:%14\n\tds_read_b64_tr_b16 %6, %8 offset:%15\n\tds_read_b64_tr_b16 %7, %8 offset:%16" \
            : "=&v"(R[0]), "=&v"(R[1]), "=&v"(R[2]), "=&v"(R[3]), "=&v"(R[4]), "=&v"(R[5]), "=&v"(R[6]), "=&v"(R[7]) \
            : "v"(vb), "n"((G) * 16 * VSTR), "n"((G) * 16 * VSTR + 8 * VSTR), "n"((G) * 16 * VSTR + 64), "n"((G) * 16 * VSTR + 64 + 8 * VSTR), \
              "n"((G) * 16 * VSTR + 128), "n"((G) * 16 * VSTR + 128 + 8 * VSTR), "n"((G) * 16 * VSTR + 192), "n"((G) * 16 * VSTR + 192 + 8 * VSTR))
#define ATT_TRWAIT(R, N) asm volatile("s_waitcnt lgkmcnt(" #N ")" : "+v"(R[0]), "+v"(R[1]), "+v"(R[2]), "+v"(R[3]), "+v"(R[4]), "+v"(R[5]), "+v"(R[6]), "+v"(R[7]))
#define ATT_PV(R, G) do { _Pragma("unroll") for (int d = 0; d < 4; ++d) { const bf16x8 vf = __builtin_shufflevector(R[2 * d], R[2 * d + 1], 0, 1, 2, 3, 4, 5, 6, 7); \
            o[d] = __builtin_amdgcn_mfma_f32_32x32x16_bf16(vf, pfr[G], o[d], 0, 0, 0); } } while (0)
        ATT_TR8(RA, 0);
        ATT_TR8(RB, 1); ATT_TRWAIT(RA, 8); ATT_PV(RA, 0);
        ATT_TR8(RA, 2); ATT_TRWAIT(RB, 8); ATT_PV(RB, 1);
        ATT_TR8(RB, 3); ATT_TRWAIT(RA, 8); ATT_PV(RA, 2);
        ATT_TRWAIT(RB, 0); ATT_PV(RB, 3);
#undef ATT_TR8
#undef ATT_TRWAIT
#undef ATT_PV
    }
    asm volatile("s_waitcnt vmcnt(0)" ::: "memory");
    __builtin_amdgcn_s_barrier();
}
__device__ __forceinline__ void attn_unit(const Ctx& C, int l, int b, int h, int qb) {
    const int tid = opaque_tid(), lane = tid & 63, w = __builtin_amdgcn_readfirstlane(tid >> 6), ql = lane & 31, hh = lane >> 5;
    LAS unsigned char* lds = C.lds;
    const int q0 = qb * 256;
    const size_t tok0 = (size_t)b * SEQ;
    const bf16_t* KV = C.at<bf16_t>(WS_KV);
    static_assert(WS_KR == WS_KV + (size_t)MTOK * NKV * 2, "kr must follow kv");
    static_assert((size_t)MTOK * NKV * 2 + (size_t)MTOK * 64 * 2 < 0xffffffffull, "32-bit DMA offsets");
    AttnDma dma; attn_dma_init(dma, tok0, h, w, lane);
    attn_dma_issue(lds, KV, dma, 0, w);
    bf16x8 qf[12];
    {
        const bf16_t* qp = C.at<bf16_t>(WS_Q) + (tok0 + q0 + w * 32 + ql) * NQ + h * QKD + hh * 8;
#pragma unroll
        for (int s = 0; s < 12; ++s) qf[s] = *(const bf16x8*)(qp + 16 * s);
    }
    f32x16 o[4];
#pragma unroll
    for (int d = 0; d < 4; ++d)
#pragma unroll
        for (int i = 0; i < 16; ++i) o[d][i] = 0.f;
    float mrun = -1e30f, lrun = 0.f;
    const int ntiles = 4 * qb + 4, mytiles = 4 * qb + (w >> 1) + 1;
    asm volatile("s_waitcnt vmcnt(0)" ::: "memory");
    __syncthreads();
    const int qi = q0 + w * 32 + ql;
    const int kaddr = ql * KSTR + hh * 16;
    const int vaddr = KBUF + (4 * hh + ((lane & 15) >> 2)) * VSTR + (16 * ((lane >> 4) & 1) + 4 * (lane & 3)) * 2;
#pragma nounroll
    for (int j = 0; j < ntiles; j += 2) {
        attn_tile<0>(lds, KV, dma, j, ntiles, mytiles, w, hh, qi, kaddr, vaddr, qf, o, mrun, lrun);
        attn_tile<1>(lds, KV, dma, j + 1, ntiles, mytiles, w, hh, qi, kaddr, vaddr, qf, o, mrun, lrun);
    }
    __syncthreads();
    const float ltot = lrun + __shfl_xor(lrun, 32);
    const float inv = 1.0f / ltot;
    float ss = 0.f;
#pragma unroll
    for (int d = 0; d < 4; ++d)
#pragma unroll
        for (int i = 0; i < 16; ++i) { o[d][i] *= inv; ss += o[d][i] * o[d][i]; }
    ss += __shfl_xor(ss, 32);
    const float rn = rsqrtf(ss * (1.0f / 128.0f) + RMS_EPS);
    const float* gn = C.fin(12) + l * 1024 + h * 128;
    bf16_t* yp = C.at<bf16_t>(WS_Y) + (tok0 + q0 + w * 32 + ql) * DM + h * 128;
#pragma unroll
    for (int d = 0; d < 4; ++d)
#pragma unroll
        for (int g4 = 0; g4 < 4; ++g4) {
            const int dd = 32 * d + 8 * g4 + 4 * hh;
            const f32x4 gv = *(const f32x4*)(gn + dd);
            u32x2 wv2; wv2.x = cvt_pk_bf16(o[d][4 * g4 + 0] * rn * gv[0], o[d][4 * g4 + 1] * rn * gv[1]); wv2.y = cvt_pk_bf16(o[d][4 * g4 + 2] * rn * gv[2], o[d][4 * g4 + 3] * rn * gv[3]);
            *(u32x2*)(yp + dd) = wv2;
        }
}

__device__ __forceinline__ void phase_final(const Ctx& C) {
    const int tid = opaque_tid(), lane = tid & 63, wv = tid >> 6;
    const float* part = C.at<float>(WS_PARTH); const float* gn = C.fin(31); const bf16_t* hb = C.at<bf16_t>(WS_HB);
    for (int row = C.wg * 8 + wv; row < MTOK; row += C.G * 8) {
        const float rs = rsqrtf(sum_part<32>(part + (size_t)row * 32) * (1.0f / DM) + RMS_EPS);
#pragma unroll
        for (int i = 0; i < 4; ++i) {
            const int col = (i * 64 + lane) * 8; const size_t off = (size_t)row * DM + col;
            const u32x4 w = *(const u32x4*)(hb + off); const f32x4 g0 = *(const f32x4*)(gn + col), g1 = *(const f32x4*)(gn + col + 4);
            const f32x4 v0 = {__uint_as_float(w.x << 16), __uint_as_float(w.x & 0xffff0000u), __uint_as_float(w.y << 16), __uint_as_float(w.y & 0xffff0000u)};
            const f32x4 v1 = {__uint_as_float(w.z << 16), __uint_as_float(w.z & 0xffff0000u), __uint_as_float(w.w << 16), __uint_as_float(w.w & 0xffff0000u)};
            *(f32x4*)(C.out + off) = v0 * rs * g0; *(f32x4*)(C.out + off + 4) = v1 * rs * g1;
        }
    }
}

constexpr int N_PHASES = 2 + 9 * DEPTH;
__global__ void __launch_bounds__(NTHREADS, 2) fwd_kernel(Args args) {
    extern __shared__ __attribute__((aligned(16))) unsigned char lds_raw[];
    Ctx C0; C0.in = args.in; C0.out = args.out; C0.ws = args.ws; C0.lds = (LAS unsigned char*)lds_raw; C0.G = gridDim.x; C0.wg = blockIdx.x;
    volatile LAS unsigned* misc = (volatile LAS unsigned*)(C0.lds + LDS_MISC);
    if (threadIdx.x < 16) misc[threadIdx.x] = 0u;
    __syncthreads();
    const int lo = args.ph_lo, hi = args.ph_hi;
    constexpr bool one_launch = !MK_MULTI;
    XcdBarrier bar; bar.bar = (unsigned*)(C0.ws + WS_CTL); bar.x = 0; bar.st = misc;
    if (hi - lo > 1) bar = xcd_barrier_post((unsigned*)(C0.ws + WS_CTL), misc);
#define IN(k) (lo <= (k) && (k) < hi)
#define SEAM(k) do { if (IN((k) + 1)) { xcd_barrier(bar); if (REP(10)) xcd_barrier(bar); } } while (0)

    if (IN(0)) { if (!SKIP(0)) {
#pragma nounroll
        for (int rep = 0; rep <= REP(12); ++rep) { phase_prologue(C0.fresh()); phase_convert(C0.fresh(), 0, bar); } } SEAM(0); }

    for (int it = 0; it < 3 * DEPTH; ++it) {
        const int l = it / 3, kind = it - 3 * l;
        const int pb = 1 + 9 * l;
        if (kind != 1) {
            const int id = pb + (kind == 0 ? 0 : 6);
            if (IN(id)) {
                const Ctx C = C0.fresh();
                pg8::Gemm g{C.at<bf16_t>(WS_H8), C.at<bf16_t>(kind == 0 ? WS_W1GU : WS_W2GU), MTOK, 2 * DFF, DM / 2, DM / 2, 0};
                pg8::StaticOrder S; S.init(MTOK, 2 * DFF, C.G, C.wg, MK_WGM_GU);
                EpiGU E{C.at<bf16_t>(WS_ACT), C.at<float>(WS_PARTH), C.at<float>(WS_RSA), C.at<float>(WS_CTL + CW_WMAX) + l * 2 + (kind == 0 ? 0 : 1), C.at<unsigned>(kind == 0 ? WS_AMAX : WS_AMAX2)};
#pragma nounroll
                for (int rep = 0; rep <= REP(1); ++rep)
                if (!SKIP(1)) pg8::gemm_phase<EpiGU, REP(8)>(C.lds, g, S, E, E);
                xcd_barrier(bar); actq_pass(C0.fresh(), kind == 0 ? WS_AMAX : WS_AMAX2, kind == 0 ? WS_AMAX2 : WS_AMAX, C0.at<float>(WS_CTL + CW_WMAX) + l * 2 + (kind == 0 ? 0 : 1));
                SEAM(id);
            }
        }
        {
            const int id = pb + (kind == 0 ? 1 : (kind == 1 ? 5 : 7));
            if (IN(id)) {
                const Ctx C = C0.fresh();
                pg8::StaticOrder S; S.init(MTOK, DM, C.G, C.wg, MK_WGM_RES);
                const float* basef = (it == 0) ? C.fin(0) : nullptr;
                if (kind == 1) {
                    pg8::Gemm g{C.at<bf16_t>(WS_Y), C.at<bf16_t>(WS_WOUT), MTOK, DM, DM, DM, 0};
                    EpiResT<false> E{basef, C.at<bf16_t>(WS_HB), C.at<float>(WS_PARTH), 1.0f, nullptr, nullptr};
                    if (!SKIP(2)) pg8::gemm_phase<EpiResT<false>>(C.lds, g, S, E, E);
                } else {
                    pg8::Gemm g{C.at<bf16_t>(WS_ACT8), C.at<bf16_t>(kind == 0 ? WS_W1D : WS_W2D), MTOK, DM, DFF / 2, 64, 1};
                    EpiResT<true> E{basef, C.at<bf16_t>(WS_HB), C.at<float>(WS_PARTH), 0.5f, C.at<float>(WS_ASC), C.at<float>(WS_CTL + CW_WMAX) + 8 + l * 2 + (kind == 0 ? 0 : 1)};
#pragma nounroll
                    for (int rep = 0; rep <= REP(2); ++rep)
                    if (!SKIP(2)) pg8::gemm_phase<EpiResT<true>>(C.lds, g, S, E, E);
                }
                if (one_launch && it != 3 * DEPTH - 1) { xcd_barrier(bar); if (kind == 0) rstd_pass(C0.fresh()); else quant_pass(C0.fresh()); }
                SEAM(id);
            }
        }
        if (kind == 0) {
            if (IN(pb + 2)) {
                const Ctx C = C0.fresh();
                pg8::Gemm g{C.at<bf16_t>(WS_HB), C.at<bf16_t>(WS_WIN), MTOK, NINP, DM, DM, 0};
                pg8::StaticOrder S; S.init(MTOK, NINP, C.G, C.wg, MK_WGM_WIN);
                EpiScale<0> E{C.at<bf16_t>(WS_P), NINP, C.at<float>(WS_PARTH), 1.0f / DM, 1.0f, C.at<float>(WS_PARTQ), C.at<float>(WS_PARTKV), nullptr, nullptr, one_launch ? C.at<float>(WS_RSTD) : nullptr};
#pragma nounroll
                for (int rep = 0; rep <= REP(3); ++rep)
                if (!SKIP(3)) pg8::gemm_phase<EpiScale<0>>(C.lds, g, S, E, E);
                SEAM(pb + 2);
            }
            if (IN(pb + 3)) {
                {
                    const Ctx C = C0.fresh();
                    pg8::Gemm g{C.at<bf16_t>(WS_P), C.at<bf16_t>(WS_WUQ), MTOK, NQ, QL, NINP, 0};
                    pg8::StaticOrder S; S.init(MTOK, NQ, C.G, C.wg);
                    EpiScale<2> E{C.at<bf16_t>(WS_Q), NQ, C.at<float>(WS_PARTQ), 1.0f / QL, 0.07216878364870322f * 1.4426950408889634f, nullptr, nullptr, C.at<float>(WS_ROPEC), C.at<float>(WS_ROPES), nullptr};
#pragma nounroll
                    for (int rep = 0; rep <= REP(4); ++rep)
                    if (!SKIP(4)) pg8::gemm_phase<EpiScale<2>>(C.lds, g, S, E, E);
                }
                {
                    const Ctx C = C0.fresh();
                    pg8::Gemm g{C.at<bf16_t>(WS_P) + QL, C.at<bf16_t>(WS_WUKV), MTOK, NKV, KVL, NINP, 0};
                    pg8::StaticOrder S; S.init(MTOK, NKV, C.G, C.wg);
                    EpiScale<1> E{C.at<bf16_t>(WS_KV), NKV, C.at<float>(WS_PARTKV), 1.0f / KVL, 1.0f, nullptr, nullptr, nullptr, nullptr, nullptr};
#pragma nounroll
                    for (int rep = 0; rep <= REP(4); ++rep)
                    if (!SKIP(5)) pg8::gemm_phase<EpiScale<1>>(C.lds, g, S, E, E);
                }
#pragma nounroll
                for (int rep = 0; rep <= REP(5); ++rep)
                if (!SKIP(6)) prep_phase(C0.fresh(), l);
                SEAM(pb + 3);
            }
            if (IN(pb + 4)) {
                unsigned* qctr = (unsigned*)(C0.fresh().ws + WS_CTL + CW_QUEUE) + 64 * l;
                if (REP(6)) { if ((int)C0.wg < 128) scan_unit(C0.fresh(), l, C0.wg); xcd_barrier(bar); }
                if (REP(7)) { for (int pi = C0.wg; pi < 1024; pi += C0.G) { const int bh = pi & 127, qb = (pi >> 7) & 1 ? (pi >> 8) : 7 - (pi >> 8); attn_unit(C0.fresh(), l, bh >> 3, bh & 7, qb); } xcd_barrier(bar); }
#pragma nounroll
                for (int rep = 0; rep <= REP(11); ++rep, qctr += 256)
                for (;;) {
                    if (threadIdx.x == 0) misc[4] = xb_add(qctr, 1u);
                    __syncthreads();
                    const int item = (int)misc[4];
                    __syncthreads();
                    if (item >= 128 + 1024) break;
                    if (item < 128) { if (!SKIP(7)) scan_unit(C0.fresh(), l, item); }
                    else { const int idx = item - 128, bh = idx & 127, qb = 7 - (idx >> 7);
                        if (!SKIP(8)) attn_unit(C0.fresh(), l, bh >> 3, bh & 7, qb); }
                }
                SEAM(pb + 4);
            }
        }
        if (kind == 2) {
            if (IN(pb + 8)) { if (l + 1 < DEPTH && !SKIP(9)) { phase_convert(C0.fresh(), l + 1, bar); if (REP(0)) phase_convert(C0.fresh(), l + 1, bar); } SEAM(pb + 8); }
        }
    }
    if (IN(N_PHASES - 1) && !SKIP(10)) {
#pragma nounroll
        for (int rep = 0; rep <= REP(12); ++rep) phase_final(C0.fresh()); }
#undef IN
#undef SEAM
}

extern "C" void kernel_launch(void* const* d_in, const int* in_sizes, int n_in, void* d_out, int out_size, void* d_ws, size_t ws_size, hipStream_t stream) {
    static int grid = 0;
    if (grid == 0) {
        if (n_in != 32 || out_size != MTOK * DM || ws_size < WS_END) { fprintf(stderr, "kernel_launch: unexpected shapes (n_in %d, out %d, ws %zu, need %zu)\n", n_in, out_size, ws_size, (size_t)WS_END); grid = -1; return; }
        int dev = 0, cus = 0, per_cu = 0;
        if (hipGetDevice(&dev) != hipSuccess || hipDeviceGetAttribute(&cus, hipDeviceAttributeMultiprocessorCount, dev) != hipSuccess) { grid = -1; return; }
        if (hipFuncSetAttribute((const void*)fwd_kernel, hipFuncAttributeMaxDynamicSharedMemorySize, LDS_BYTES) != hipSuccess) { fprintf(stderr, "kernel_launch: hipFuncSetAttribute failed\n"); grid = -1; return; }
        if (hipOccupancyMaxActiveBlocksPerMultiprocessor(&per_cu, (const void*)fwd_kernel, NTHREADS, LDS_BYTES) != hipSuccess || per_cu < 1) { fprintf(stderr, "kernel_launch: occupancy query says %d\n", per_cu); }
        (void)hipGetLastError();
        grid = cus;
    }
    if (grid < 0) return;
    (void)hipMemsetAsync((char*)d_ws + WS_CTL, 0, ZERO_BYTES, stream);
    Args a{};
    for (int i = 0; i < 32; ++i) a.in[i] = d_in[i];
    a.out = (float*)d_out; a.ws = (unsigned char*)d_ws;
#if MK_MULTI
    for (int p = 0; p < N_PHASES; ++p) { a.ph_lo = p; a.ph_hi = p + 1; hipLaunchKernelGGL(fwd_kernel, dim3(grid), dim3(NTHREADS), LDS_BYTES, stream, a); }
#else
    a.ph_lo = 0; a.ph_hi = N_PHASES;
    hipLaunchKernelGGL(fwd_kernel, dim3(grid), dim3(NTHREADS), LDS_BYTES, stream, a);
#endif
}
```
